# Optimizing an MI355X kernel written in HIP

```python
import jax, jax.numpy as jnp
from jax import lax
import numpy as np

D_MODEL = 1024
BATCH = 4
SEQ = 4096
DEPTH = 2
DEC_BATCH = 8
DEC_SEQ = 64
PAST_LEN = 4096

CHUNK = 64
P_DIM = 256
EPS = 1e-6
NEG = -1e30
HA = 4
DK_A = 128
DV_A = 256
GATE_RANK = 16
GATE_TAU = 16.0
WA_K = HA * DK_A
WA_V = HA * DV_A
HB = 16
DH_B = 64
LEFT_CHUNKS = 8
WINDOW = LEFT_CHUNKS * CHUNK
BAND = (LEFT_CHUNKS + 1) * CHUNK
MAX_REL = 128
WB = HB * DH_B
IN_SIZES = (WA_K, WA_K, WA_V, GATE_RANK, WA_V, WB, WB, WB, WB, D_MODEL, D_MODEL)
N_IN = 2 * WA_K + 2 * WA_V + GATE_RANK + 4 * WB + 2 * D_MODEL

kernel_name = 'hybrid_gla_chunkband_stream_step'


def _rmsnorm(x, g):
    xf = x.astype(jnp.float32)
    y = xf * lax.rsqrt(jnp.mean(xf * xf, axis=-1, keepdims=True) + EPS)
    return (y * g.astype(jnp.float32)).astype(x.dtype)


def _split_cols(z):
    offsets = [int(o) for o in np.cumsum(IN_SIZES)[:-1]]
    return jnp.split(z, offsets, axis=-1)


def _gla_block(q, k, v, lg, s0):
    q, k, v, lg = (a.astype(jnp.float32) for a in (q, k, v, lg))
    s0 = s0.astype(jnp.float32)
    L = q.shape[1]
    b = jnp.cumsum(lg, axis=1)
    causal = jnp.tril(jnp.ones((L, L), dtype=bool))
    diff = b[:, :, None] - b[:, None, :]
    decay = jnp.exp(jnp.where(causal[None, :, :, None, None], diff, -jnp.inf))
    attn = jnp.einsum('bihd,bjhd,bijhd->bhij', q, k, decay)
    o = jnp.einsum('bhij,bjhv->bihv', attn, v)
    o = o + jnp.einsum('bihd,bhdv->bihv', q * jnp.exp(b), s0)
    b_last = b[:, -1]
    k_dec = k * jnp.exp(b_last[:, None] - b)
    s1 = jnp.exp(b_last)[..., None] * s0 + jnp.einsum('bjhd,bjhv->bhdv', k_dec, v)
    return o, s1


def _gla_prompt(q, k, v, lg):
    B, T, H, DK = q.shape
    DV = v.shape[-1]
    NC = T // CHUNK

    def to_chunks(a):
        return jnp.moveaxis(a.reshape(B, NC, CHUNK, H, a.shape[-1]), 1, 0)

    def step(s, blk):
        qc, kc, vc, lc = blk
        o, s = _gla_block(qc, kc, vc, lc, s)
        return s, o

    s0 = jnp.zeros((B, H, DK, DV), jnp.float32)
    s, o = lax.scan(step, s0, (to_chunks(q), to_chunks(k), to_chunks(v), to_chunks(lg)))
    return jnp.moveaxis(o, 0, 1).reshape(B, T, H, DV), s


def _band_prompt(q, k, v, bias_tab):
    B, T, H, D = q.shape
    NC = T // CHUNK
    pad = jnp.zeros((B, WINDOW, H, D), k.dtype)
    kp = jnp.concatenate([pad, k], axis=1)
    vp = jnp.concatenate([pad, v], axis=1)
    qc = jnp.moveaxis(q.reshape(B, NC, CHUNK, H, D), 1, 0)
    rel = WINDOW + jnp.arange(CHUNK)[:, None] - jnp.arange(BAND)[None, :]
    bias = bias_tab[:, jnp.clip(rel, -MAX_REL, MAX_REL) + MAX_REL].astype(jnp.float32)
    scale = D ** -0.5

    def one_chunk(args):
        n, qn = args
        kn = lax.dynamic_slice_in_dim(kp, n * CHUNK, BAND, axis=1)
        vn = lax.dynamic_slice_in_dim(vp, n * CHUNK, BAND, axis=1)
        s = jnp.einsum('bihd,bjhd->bhij', qn, kn).astype(jnp.float32) * scale + bias
        valid = n * CHUNK + jnp.arange(BAND) >= WINDOW
        s = jnp.where(valid[None, None, None, :], s, NEG)
        pr = jax.nn.softmax(s, axis=-1).astype(vn.dtype)
        return jnp.einsum('bhij,bjhd->bihd', pr, vn)

    o = lax.map(one_chunk, (jnp.arange(NC), qc))
    return jnp.moveaxis(o, 0, 1).reshape(B, T, H, D)


def _band_sample(q, k_new, v_new, k_cache, v_cache, bias_tab):
    S = q.shape[1]
    Lc = k_cache.shape[1]
    kk = jnp.concatenate([k_cache.astype(k_new.dtype), k_new], axis=1)
    vv = jnp.concatenate([v_cache.astype(v_new.dtype), v_new], axis=1)
    qpos = PAST_LEN + jnp.arange(S)
    kpos = jnp.concatenate([PAST_LEN - Lc + jnp.arange(Lc), PAST_LEN + jnp.arange(S)])
    rel = qpos[:, None] - kpos[None, :]
    bias = bias_tab[:, jnp.clip(rel, -MAX_REL, MAX_REL) + MAX_REL].astype(jnp.float32)
    s = jnp.einsum('bihd,bjhd->bhij', q, kk).astype(jnp.float32) * (q.shape[-1] ** -0.5) + bias
    pr = jax.nn.softmax(s, axis=-1).astype(vv.dtype)
    return jnp.einsum('bhij,bjhd->bihd', pr, vv)


def _layer(x, p, s0, kc, vc, lw, prompt):
    (norm_g, w_in, w_gate_up, b_gate, gla_norm_g, q_norm_g, k_norm_g, rel_bias,
     w_branch_a, w_branch_b, w_out, ple_norm_g, w_ple_gate, w_ple) = lw
    B, T, _ = x.shape
    h = _rmsnorm(x, norm_g)
    z = h @ w_in
    qa, ka, va, ra, ga, qb, kb, vb, gb, mga, mgb = _split_cols(z)

    qa = qa.reshape(B, T, HA, DK_A) * (DK_A ** -0.5)
    ka = ka.reshape(B, T, HA, DK_A)
    va = va.reshape(B, T, HA, DV_A)
    lg = jax.nn.log_sigmoid((ra @ w_gate_up + b_gate).astype(jnp.float32)) / GATE_TAU
    lg = lg.reshape(B, T, HA, DK_A)
    if prompt:
        oa, sa = _gla_prompt(qa, ka, va, lg)
    else:
        oa, sa = _gla_block(qa, ka, va, lg, s0)
    oa = _rmsnorm(oa.astype(x.dtype), gla_norm_g).reshape(B, T, WA_V)
    ya = (oa * jax.nn.silu(ga)) @ w_branch_a

    qb = _rmsnorm(qb.reshape(B, T, HB, DH_B), q_norm_g)
    kb = _rmsnorm(kb.reshape(B, T, HB, DH_B), k_norm_g)
    vb = vb.reshape(B, T, HB, DH_B)
    if prompt:
        ob = _band_prompt(qb, kb, vb, rel_bias)
        keep = min(WINDOW, T)
        kbuf = kb[:, T - keep:]
        vbuf = vb[:, T - keep:]
    else:
        ob = _band_sample(qb, kb, vb, kc, vc, rel_bias)
        Lc = kc.shape[1]
        kbuf = jnp.concatenate([kc.astype(kb.dtype), kb], axis=1)[:, -Lc:]
        vbuf = jnp.concatenate([vc.astype(vb.dtype), vb], axis=1)[:, -Lc:]
    yb = (ob.reshape(B, T, WB) * jax.nn.silu(gb)) @ w_branch_b

    m = jax.nn.sigmoid(mga) * ya + jax.nn.sigmoid(mgb) * yb
    x = x + m @ w_out
    x = x + jax.nn.sigmoid(_rmsnorm(x, ple_norm_g) @ w_ple_gate) * (p @ w_ple)
    return x, sa.astype(x.dtype), kbuf, vbuf


def setup_inputs(seed: int = 0) -> dict:
    key = jax.random.key(seed)
    ks = jax.random.split(key, 24)
    L_WIN = min(WINDOW, PAST_LEN)
    f32 = jnp.float32
    nrm = lambda k, shape, s=1.0: (jax.random.normal(k, shape, f32) * s)
    return {
        'x_prompt': nrm(ks[0], (BATCH, SEQ, D_MODEL)),
        'x_sample': nrm(ks[1], (DEC_BATCH, DEC_SEQ, D_MODEL)),
        'state_gla': nrm(ks[2], (DEPTH, DEC_BATCH, HA, DK_A, DV_A)),
        'cache_band_k': nrm(ks[3], (DEPTH, DEC_BATCH, L_WIN, HB, DH_B)),
        'cache_band_v': nrm(ks[4], (DEPTH, DEC_BATCH, L_WIN, HB, DH_B)),
        'p_prompt': nrm(ks[5], (DEPTH, BATCH, SEQ, P_DIM)),
        'p_sample': nrm(ks[6], (DEPTH, DEC_BATCH, DEC_SEQ, P_DIM)),
        'norm_g': 1.0 + nrm(ks[7], (DEPTH, D_MODEL), 0.02),
        'w_in': nrm(ks[8], (DEPTH, D_MODEL, N_IN), D_MODEL ** -0.5),
        'w_gate_up': nrm(ks[9], (DEPTH, GATE_RANK, WA_K), GATE_RANK ** -0.5),
        'b_gate': nrm(ks[10], (DEPTH, WA_K), 0.01),
        'gla_norm_g': 1.0 + nrm(ks[11], (DEPTH, DV_A), 0.02),
        'q_norm_g': 1.0 + nrm(ks[12], (DEPTH, DH_B), 0.02),
        'k_norm_g': 1.0 + nrm(ks[13], (DEPTH, DH_B), 0.02),
        'rel_bias': nrm(ks[14], (DEPTH, HB, 2 * MAX_REL + 1), 0.1),
        'w_branch_a': nrm(ks[15], (DEPTH, WA_V, D_MODEL), WA_V ** -0.5),
        'w_branch_b': nrm(ks[16], (DEPTH, WB, D_MODEL), WB ** -0.5),
        'w_out': nrm(ks[17], (DEPTH, D_MODEL, D_MODEL), D_MODEL ** -0.5),
        'ple_norm_g': 1.0 + nrm(ks[18], (DEPTH, D_MODEL), 0.02),
        'w_ple_gate': nrm(ks[19], (DEPTH, D_MODEL, D_MODEL), D_MODEL ** -0.5),
        'w_ple': nrm(ks[20], (DEPTH, P_DIM, D_MODEL), P_DIM ** -0.5),
    }


def reference(x_prompt, x_sample, state_gla, cache_band_k, cache_band_v, p_prompt, p_sample,
              norm_g, w_in, w_gate_up, b_gate, gla_norm_g, q_norm_g, k_norm_g, rel_bias,
              w_branch_a, w_branch_b, w_out, ple_norm_g, w_ple_gate, w_ple):
    xp = x_prompt
    xs = x_sample
    sp_list, kp_list, vp_list = [], [], []
    ss_list, ksl, vsl = [], [], []
    for i in range(DEPTH):
        lw = (norm_g[i], w_in[i], w_gate_up[i], b_gate[i], gla_norm_g[i], q_norm_g[i],
              k_norm_g[i], rel_bias[i], w_branch_a[i], w_branch_b[i], w_out[i],
              ple_norm_g[i], w_ple_gate[i], w_ple[i])
        xp, sp, kbp, vbp = _layer(xp, p_prompt[i], None, None, None, lw, True)
        xs, ss, kbs, vbs = _layer(xs, p_sample[i], state_gla[i], cache_band_k[i],
                                  cache_band_v[i], lw, False)
        sp_list.append(sp); kp_list.append(kbp); vp_list.append(vbp)
        ss_list.append(ss); ksl.append(kbs); vsl.append(vbs)
    new_state_gla_prompt = jnp.stack(sp_list)
    new_band_k_prompt = jnp.stack(kp_list)
    new_band_v_prompt = jnp.stack(vp_list)
    new_state_gla_sample = jnp.stack(ss_list)
    new_band_k_sample = jnp.stack(ksl)
    new_band_v_sample = jnp.stack(vsl)
    return (xp, xs, new_state_gla_prompt, new_band_k_prompt, new_band_v_prompt,
            new_state_gla_sample, new_band_k_sample, new_band_v_sample)
```

```cpp
#include <hip/hip_runtime.h>
#include <hip/hip_cooperative_groups.h>
#include <cstdio>
#include <cstdint>
namespace cg = cooperative_groups;
namespace pg8 {
#define PG8_LAS __attribute__((address_space(3)))
typedef unsigned short bf16_t;
typedef short bf16x8 __attribute__((ext_vector_type(8)));
typedef float f32x4 __attribute__((ext_vector_type(4)));
typedef unsigned u32x4 __attribute__((ext_vector_type(4)));
constexpr int BM = 256, BK = 64, HALF = 128, HTB = HALF * BK * 2  , STAGE_BYTES = 8 * HTB, NXCD = 8, WGM = 8;

__host__ __device__ __forceinline__ int lds_byte(int r, int c) { const int st = (r >> 4) * 2 + (c >> 5), rr = r & 15, cc = c & 31, ob = rr * 64 + cc * 2; return st * 1024 + (ob ^ (((ob >> 9) & 1) << 5)); }
__host__ __device__ __forceinline__ void stage_rc(int b, int& R, int& C) { const int st = b / 1024, sb = b % 1024, swz = sb ^ (((sb >> 9) & 1) << 5); R = (st >> 1) * 16 + swz / 64; C = (st & 1) * 32 + (swz % 64) / 2; }
__host__ __device__ __forceinline__ int perm32(int rho) { const int n = rho >> 4, i = rho & 15; return 8 * (i >> 2) + 4 * n + (i & 3); }

struct Unit { int pm, pn; };
struct Gemm { const bf16_t* A; const bf16_t* Bt; int M, N, K; };

struct StaticOrder {
    int nM, nN, nwg, G, c;
    __host__ __device__ void init(int M, int N, int G_, int c_) { nM = M / BM; nN = N / BM; nwg = nM * nN; G = G_; c = c_; }
    __host__ __device__ bool next(int i, Unit& u) const {
        const long L = (long)i * G + c; if (L >= nwg) return false;
        int wgid = (int)L; { const int q = nwg / NXCD, r = nwg % NXCD, xcd = wgid % NXCD, off = wgid / NXCD; wgid = (xcd < r ? xcd * (q + 1) : r * (q + 1) + (xcd - r) * q) + off; }
        const int nig = WGM * nN, gid = wgid / nig, fm = gid * WGM, gsz = (nM - fm) < WGM ? (nM - fm) : WGM;
        u.pm = fm + ((wgid % nig) % gsz); u.pn = (wgid % nig) / gsz; return true;
    }
    __device__ __forceinline__ void a_ready(const Unit&) const {}
    __device__ __forceinline__ void done(const Unit&) const {}
};
__device__ __forceinline__ unsigned cvt_pk_bf16(float lo, float hi) { unsigned r; asm volatile("v_cvt_pk_bf16_f32 %0, %1, %2" : "=v"(r) : "v"(lo), "v"(hi)); return r; }
template <class Epi, class Sched, bool ALIGN_EPI = false, bool SP2 = false>
__device__ __forceinline__ void gemm_phase(PG8_LAS unsigned char* lds, const Gemm g, const Sched& S, const Epi& E) {
    int tid_ = threadIdx.x; asm volatile("" : "+v"(tid_));
    const int tid = tid_, wid = __builtin_amdgcn_readfirstlane(tid >> 6), lane = tid & 63, wr = wid >> 2, wc = wid & 3, fr = lane & 15, fq = lane >> 4;
    const int K = g.K, nt = K / BK;
    unsigned voffA[2], voffB[2];
#pragma unroll
    for (int i = 0; i < 2; ++i) { int R, C; stage_rc(tid * 16 + i * 8192, R, C); const int Rb = Epi::PERM ? ((R & ~31) + perm32(R & 31)) : R;
        voffA[i] = (unsigned)(R * K + C) * 2u; voffB[i] = (unsigned)(Rb * K + C) * 2u; }
    const size_t kstep = (size_t)(BK * 2);
    const size_t hstep = (size_t)HALF * K * 2;
    const size_t tstep = 2 * hstep;
    const unsigned ldsw = (unsigned)wid * 1024u;
    const int aoff = lds_byte(wr * 64 + fr, fq * 8), boff = lds_byte(wc * 32 + fr, fq * 8);
#define PG8_SA(b, h) (((b) * 2 + (h)) * HTB)
#define PG8_SB(b, h) ((4 + (b) * 2 + (h)) * HTB)
#define PG8_STAGE(bufoff, gbase, voff) do { _Pragma("unroll") for (int _i = 0; _i < 2; ++_i) \
        __builtin_amdgcn_global_load_lds((const unsigned*)((const char*)(gbase) + (voff)[_i]), (PG8_LAS unsigned*)(lds + (bufoff) + ldsw + _i * 8192), 16, 0, 0); } while (0)
#define PG8_LDA(dst, b, h) do { _Pragma("unroll") for (int m = 0; m < 4; ++m) _Pragma("unroll") for (int k = 0; k < 2; ++k) dst[m][k] = *(const PG8_LAS bf16x8*)(lds + PG8_SA(b, h) + aoff + m * 2048 + k * 1024); } while (0)
#define PG8_LDB(dst, b, h) do { _Pragma("unroll") for (int n = 0; n < 2; ++n) _Pragma("unroll") for (int k = 0; k < 2; ++k) dst[n][k] = *(const PG8_LAS bf16x8*)(lds + PG8_SB(b, h) + boff + n * 2048 + k * 1024); } while (0)
#define PG8_MMA(ai, bj, At, Bt) do { __builtin_amdgcn_s_setprio(1); _Pragma("unroll") for (int m = 0; m < 4; ++m) _Pragma("unroll") for (int n = 0; n < 2; ++n) _Pragma("unroll") for (int k = 0; k < 2; ++k) \
        acc[ai][bj][m][n] = __builtin_amdgcn_mfma_f32_16x16x32_bf16(Bt[n][k], At[m][k], acc[ai][bj][m][n], 0, 0, 0); __builtin_amdgcn_s_setprio(0); } while (0)
#define PG8_WAIT_V(n) asm volatile("s_waitcnt vmcnt(" #n ")" ::: "memory")
#define PG8_WAIT_L(n) asm volatile("s_waitcnt lgkmcnt(" #n ")" ::: "memory")
#define PG8_BAR __builtin_amdgcn_s_barrier()
#define PG8_SCHED __builtin_amdgcn_sched_barrier(0)
    Unit cur, nxt; int ui = 0;
    if (!S.next(0, cur)) return;
    f32x4 acc[2][2][4][2];
#pragma unroll
    for (int a = 0; a < 2; ++a)
#pragma unroll
        for (int b = 0; b < 2; ++b)
#pragma unroll
            for (int m = 0; m < 4; ++m)
#pragma unroll
                for (int n = 0; n < 2; ++n) acc[a][b][m][n] = (f32x4){0.f, 0.f, 0.f, 0.f};
    bf16x8 At[4][2], B0[2][2], B1[2][2];
    const char* cA = (const char*)g.A + (size_t)cur.pm * tstep; const char* cB = (const char*)g.Bt + (size_t)cur.pn * tstep;
    S.a_ready(cur);
    if constexpr (SP2) {
        PG8_STAGE(PG8_SB(0, 0), cB, voffB); PG8_STAGE(PG8_SB(0, 1), cB + hstep, voffB); PG8_STAGE(PG8_SA(0, 0), cA, voffA); PG8_STAGE(PG8_SA(0, 1), cA + hstep, voffA);
        if (wr == 1) PG8_BAR;
        PG8_WAIT_V(2); PG8_BAR;
        PG8_STAGE(PG8_SB(1, 0), cB + kstep, voffB); PG8_STAGE(PG8_SA(1, 0), cA + kstep, voffA); PG8_STAGE(PG8_SB(1, 1), cB + hstep + kstep, voffB);
        PG8_WAIT_V(6); PG8_BAR;
    } else {
        PG8_STAGE(PG8_SB(0, 0), cB, voffB); PG8_STAGE(PG8_SA(0, 0), cA, voffA); PG8_STAGE(PG8_SB(0, 1), cB + hstep, voffB); PG8_STAGE(PG8_SA(0, 1), cA + hstep, voffA);
        if (wr == 1) PG8_BAR;
        PG8_WAIT_V(4); PG8_BAR;
        PG8_STAGE(PG8_SB(1, 0), cB + kstep, voffB); PG8_STAGE(PG8_SA(1, 0), cA + kstep, voffA); PG8_STAGE(PG8_SB(1, 1), cB + hstep + kstep, voffB);
        PG8_WAIT_V(6); PG8_BAR;
    }
    for (;;) {
        const bool has_next = S.next(ui + 1, nxt);
        const char* nA = has_next ? (const char*)g.A + (size_t)nxt.pm * tstep : cA; const char* nB = has_next ? (const char*)g.Bt + (size_t)nxt.pn * tstep : cB;
        for (int t = 0; t < nt; t += 2) {
            const bool last = (t == nt - 2);
            const char* a1 = cA + (size_t)(t + 1) * kstep;
            const char* a2 = last ? nA : cA + (size_t)(t + 2) * kstep; const char* b2 = last ? nB : cB + (size_t)(t + 2) * kstep;
            const char* a3 = a2 + kstep; const char* b3 = b2 + kstep;
            if (last && has_next) S.a_ready(nxt);
            if constexpr (SP2) {
            PG8_LDB(B0, 0, 0); PG8_LDB(B1, 0, 1); PG8_SCHED; PG8_LDA(At, 0, 0); PG8_STAGE(PG8_SA(1, 1), a1 + hstep, voffA);
            PG8_WAIT_V(8); PG8_WAIT_L(0); PG8_BAR; PG8_MMA(0, 0, At, B0); PG8_MMA(0, 1, At, B1); PG8_BAR; PG8_SCHED;
            PG8_LDA(At, 0, 1); PG8_STAGE(PG8_SB(0, 0), b2, voffB); PG8_STAGE(PG8_SB(0, 1), b2 + hstep, voffB); PG8_STAGE(PG8_SA(0, 0), a2, voffA);
            PG8_WAIT_V(8); PG8_WAIT_L(0); PG8_BAR; PG8_MMA(1, 0, At, B0); PG8_MMA(1, 1, At, B1); PG8_BAR; PG8_SCHED;
            PG8_LDB(B0, 1, 0); PG8_LDB(B1, 1, 1); PG8_SCHED; PG8_LDA(At, 1, 0); PG8_STAGE(PG8_SA(0, 1), a2 + hstep, voffA);
            PG8_WAIT_V(8); PG8_WAIT_L(0); PG8_BAR; PG8_MMA(0, 0, At, B0); PG8_MMA(0, 1, At, B1); PG8_BAR; PG8_SCHED;
            PG8_LDA(At, 1, 1); PG8_STAGE(PG8_SB(1, 0), b3, voffB); PG8_STAGE(PG8_SB(1, 1), b3 + hstep, voffB); PG8_STAGE(PG8_SA(1, 0), a3, voffA);
            PG8_WAIT_V(8); PG8_WAIT_L(0); PG8_BAR; PG8_MMA(1, 0, At, B0); PG8_MMA(1, 1, At, B1); PG8_BAR; PG8_SCHED;
            } else {
            PG8_LDB(B0, 0, 0); PG8_SCHED; PG8_LDA(At, 0, 0); PG8_STAGE(PG8_SA(1, 1), a1 + hstep, voffA);
            PG8_WAIT_L(8); PG8_BAR; PG8_WAIT_L(0); PG8_MMA(0, 0, At, B0); PG8_BAR; PG8_SCHED;
            PG8_LDB(B1, 0, 1); PG8_STAGE(PG8_SB(0, 0), b2, voffB);
            PG8_BAR; PG8_WAIT_L(0); PG8_MMA(0, 1, At, B1); PG8_BAR;
            PG8_LDA(At, 0, 1); PG8_STAGE(PG8_SA(0, 0), a2, voffA);
            PG8_BAR; PG8_WAIT_L(0); PG8_MMA(1, 0, At, B0); PG8_BAR; PG8_SCHED;
            PG8_STAGE(PG8_SB(0, 1), b2 + hstep, voffB);
            PG8_WAIT_V(6); PG8_BAR; PG8_MMA(1, 1, At, B1); PG8_BAR;
            PG8_LDB(B0, 1, 0); PG8_SCHED; PG8_LDA(At, 1, 0); PG8_STAGE(PG8_SA(0, 1), a2 + hstep, voffA);
            PG8_WAIT_L(8); PG8_BAR; PG8_WAIT_L(0); PG8_MMA(0, 0, At, B0); PG8_BAR; PG8_SCHED;
            PG8_LDB(B1, 1, 1); PG8_STAGE(PG8_SB(1, 0), b3, voffB);
            PG8_BAR; PG8_WAIT_L(0); PG8_MMA(0, 1, At, B1); PG8_BAR;
            PG8_LDA(At, 1, 1); PG8_STAGE(PG8_SA(1, 0), a3, voffA);
            PG8_BAR; PG8_WAIT_L(0); PG8_MMA(1, 0, At, B0); PG8_BAR; PG8_SCHED;
            PG8_STAGE(PG8_SB(1, 1), b3 + hstep, voffB);
            PG8_WAIT_V(6); PG8_BAR; PG8_MMA(1, 1, At, B1); PG8_BAR;
            }
        }
        if constexpr (ALIGN_EPI) { if (wr == 0) PG8_BAR; }
        if constexpr (!Epi::AFTER_DRAIN) { E(acc, cur, wr, wc, fr, fq); S.done(cur); }
        if (!has_next) break;
#pragma unroll
        for (int a = 0; a < 2; ++a)
#pragma unroll
            for (int b = 0; b < 2; ++b)
#pragma unroll
                for (int m = 0; m < 4; ++m)
#pragma unroll
                    for (int n = 0; n < 2; ++n) acc[a][b][m][n] = (f32x4){0.f, 0.f, 0.f, 0.f};
        cur = nxt; cA = nA; cB = nB; ++ui;
        if constexpr (ALIGN_EPI) { if (wr == 1) PG8_BAR; }
    }
    PG8_WAIT_V(0);
    if constexpr (!ALIGN_EPI) { if (wr == 0) PG8_BAR; }
    PG8_BAR;
    if constexpr (Epi::AFTER_DRAIN) { E.fused(acc, cur, wr, wc, fr, fq, lds, wid, lane); S.done(cur); }
#undef PG8_SA
#undef PG8_SB
#undef PG8_STAGE
#undef PG8_LDA
#undef PG8_LDB
#undef PG8_MMA
#undef PG8_WAIT_V
#undef PG8_WAIT_L
#undef PG8_BAR
#undef PG8_SCHED
}
}

#define DI __device__ __forceinline__
#define LAS __attribute__((address_space(3)))
typedef unsigned short bf16_t;
typedef short bf16x8 __attribute__((ext_vector_type(8)));
typedef short s16x4 __attribute__((ext_vector_type(4)));
typedef float f32x4 __attribute__((ext_vector_type(4)));
typedef unsigned u32x4 __attribute__((ext_vector_type(4)));
typedef unsigned u32x2 __attribute__((ext_vector_type(2)));

constexpr int DM = 1024, MP = 16384, MS = 512, MT = MP + MS;
constexpr int NPC = 256, NCH = 264;
constexpr float EPS = 1e-6f, LOG2E = 1.4426950408889634f;
constexpr int NWIN_T = 37;
constexpr int NTHREADS = 512;
constexpr int LDS_BYTES = 147456;

constexpr size_t MiB = 1u << 20;
constexpr size_t SLOT = 33 * MiB;
constexpr size_t WS_MSH = 65536;
constexpr size_t WS_SQ1 = 1 * MiB, WS_SQ2 = 5 * MiB / 2, WS_RA = 4 * MiB, WS_DC = 6 * MiB, WS_WSM = 7 * MiB, WSM_LAYER = 17 * MiB / 2;
constexpr size_t WS_WIN = 24 * MiB, WS_PB = 43 * MiB, WS_XB = 60 * MiB, WS_OV = 93 * MiB, WS_AX = WS_OV + 5 * SLOT, WS_END = WS_AX + 6 * MiB;
constexpr size_t O_Y = 0, O_SP = 17301504, O_KP = 18350080, O_VP = 22544384, O_SS = 26738688, O_KS = 28835840, O_VS = 37224448;


typedef const __attribute__((address_space(4))) unsigned char* kargp_t;
DI kargp_t kbase() { kargp_t k = (kargp_t)__builtin_amdgcn_kernarg_segment_ptr(); asm volatile("" : "+s"(k)); return k; }
DI const float* kin(int i) { return *(const float* const __attribute__((address_space(4)))*)(kbase() + 8 * i); }
DI float* kout() { return *(float* const __attribute__((address_space(4)))*)(kbase() + 168); }
DI unsigned char* kws() { return *(unsigned char* const __attribute__((address_space(4)))*)(kbase() + 176); }
DI int kph_lo() { return *(const __attribute__((address_space(4))) int*)(kbase() + 184); }
DI int kph_hi() { return *(const __attribute__((address_space(4))) int*)(kbase() + 188); }
DI int otid() { int t = threadIdx.x; asm volatile("" : "+v"(t)); return t; }
DI float bflo(unsigned w) { return __uint_as_float(w << 16); }
DI float bfhi(unsigned w) { return __uint_as_float(w & 0xffff0000u); }
DI float bf2f(bf16_t b) { return __uint_as_float(((unsigned)b) << 16); }
typedef float f32x2_t __attribute__((ext_vector_type(2))); typedef __bf16 bf16x2_t __attribute__((ext_vector_type(2)));
DI unsigned pk2(float lo, float hi) { f32x2_t v = {lo, hi}; bf16x2_t r = __builtin_convertvector(v, bf16x2_t); return __builtin_bit_cast(unsigned, r); }
DI float sigm(float x) { return __builtin_amdgcn_rcpf(1.f + __expf(-x)); }
DI float silu(float x) { return x * sigm(x); }
DI float row_rstd(const float* sq, int row) {
    const f32x4* p = (const f32x4*)(sq + (size_t)row * 16); const f32x4 a = p[0], b = p[1], c = p[2], d = p[3];
    const float s = (((a.x + a.y) + (a.z + a.w)) + ((b.x + b.y) + (b.z + b.w))) + (((c.x + c.y) + (c.z + c.w)) + ((d.x + d.y) + (d.z + d.w)));
    return rsqrtf(s * (1.f / 1024.f) + EPS);
}
DI u32x4 pack8(const float* v) { u32x4 w; w.x = pk2(v[0], v[1]); w.y = pk2(v[2], v[3]); w.z = pk2(v[4], v[5]); w.w = pk2(v[6], v[7]); return w; }
DI void unpack8(u32x4 w, float* v) { v[0] = bflo(w.x); v[1] = bfhi(w.x); v[2] = bflo(w.y); v[3] = bfhi(w.y); v[4] = bflo(w.z); v[5] = bfhi(w.z); v[6] = bflo(w.w); v[7] = bfhi(w.w); }

enum { T_QA = 0, T_KA, T_VA, T_GA, T_RA, T_QB, T_KB, T_VB, T_GB, T_MGA, T_MGB };
struct EpiIn {
    static constexpr bool PERM = false, AFTER_DRAIN = false;
    int tile0, L; unsigned char* ws; float* out; const float *qg, *kg;
    template <int TYPE> DI void run(const pg8::f32x4 (&acc)[2][2][4][2], int pm, int tcol, int wr, int wc, int fr, int fq) const {
        constexpr size_t doff = TYPE == T_QA ? WS_OV + 2 * SLOT : TYPE == T_KA ? WS_OV + 2 * SLOT + (size_t)MT * 1024 : TYPE == T_VA ? WS_OV + SLOT : TYPE == T_GA ? WS_OV : TYPE == T_QB ? WS_OV + SLOT : TYPE == T_KB ? WS_OV + 2 * SLOT
                              : TYPE == T_VB ? WS_OV + 3 * SLOT : TYPE == T_GB ? WS_OV + 4 * SLOT : TYPE == T_MGA ? WS_OV + SLOT : WS_OV + 2 * SLOT;
        constexpr bool ANX = TYPE == T_QB || TYPE == T_KB || TYPE == T_VB || TYPE == T_GB || TYPE == T_MGA || TYPE == T_MGB;
        constexpr size_t aoff = WS_AX + (TYPE == T_QB ? 0 : TYPE == T_KB ? 1 : TYPE == T_VB ? 2 : TYPE == T_GB ? 3 : TYPE == T_MGA ? 4 : 5) * MiB;
        const bool srow = ANX && pm >= MP / 256;
        bf16_t* dst = (bf16_t*)(ws + (srow ? aoff : doff)); const int rsub = srow ? MP : 0; const float* sq = (const float*)(ws + WS_SQ2); float* RA = (float*)(ws + WS_RA);
        float* okp = out + (TYPE == T_KB ? O_KP : O_VP) + (size_t)L * 4 * 512 * 1024; float* oks = out + (TYPE == T_KB ? O_KS : O_VS) + (size_t)L * 8 * 512 * 1024;
        const int ld = (TYPE == T_QA || TYPE == T_KA) ? 512 : 1024;
        float gq[2][8];
        if (TYPE == T_QB || TYPE == T_KB) {
            const float* g = TYPE == T_QB ? qg : kg;
#pragma unroll
            for (int bj = 0; bj < 2; ++bj)
#pragma unroll
                for (int k = 0; k < 8; ++k) gq[bj][k] = g[32 * bj + 8 * fq + k] * (TYPE == T_QB ? 0.125f * LOG2E : 1.f);
        }
#pragma unroll
        for (int ai = 0; ai < 2; ++ai)
#pragma unroll
            for (int m = 0; m < 4; ++m) {
                const int row = pm * 256 + ai * 128 + wr * 64 + m * 16 + fr;
                const float rs = row_rstd(sq, row);
                float v[2][8];
#pragma unroll
                for (int bj = 0; bj < 2; ++bj)
#pragma unroll
                    for (int n = 0; n < 2; ++n)
#pragma unroll
                        for (int e = 0; e < 4; ++e) v[bj][4 * n + e] = acc[ai][bj][m][n][e] * rs;
                if (TYPE == T_RA) {
                    if (wc == 0 && fq < 2) { float* p = RA + (size_t)row * 16 + 8 * fq; *(f32x4*)p = (f32x4){v[0][0], v[0][1], v[0][2], v[0][3]}; *(f32x4*)(p + 4) = (f32x4){v[0][4], v[0][5], v[0][6], v[0][7]}; }
                    continue;
                }
                if (TYPE == T_QB || TYPE == T_KB) {
                    float ss = 0.f;
#pragma unroll
                    for (int bj = 0; bj < 2; ++bj)
#pragma unroll
                        for (int k = 0; k < 8; ++k) ss += v[bj][k] * v[bj][k];
                    ss += __shfl_xor(ss, 16); ss += __shfl_xor(ss, 32);
                    const float r = rsqrtf(ss * (1.f / 64.f) + EPS);
#pragma unroll
                    for (int bj = 0; bj < 2; ++bj)
#pragma unroll
                        for (int k = 0; k < 8; ++k) v[bj][k] *= r * gq[bj][k];
                }
                float* bo = nullptr;
                if (TYPE == T_KB || TYPE == T_VB) {
                    if (row < MP) { const int t = row & 4095; if (t >= 3584) bo = okp + ((size_t)(row >> 12) * 512 + (t - 3584)) * 1024; }
                    else { const int rr = row - MP; bo = oks + ((size_t)(rr >> 6) * 512 + 448 + (rr & 63)) * 1024; }
                }
#pragma unroll
                for (int bj = 0; bj < 2; ++bj) {
                    const int col = tcol * 256 + 64 * wc + 32 * bj + 8 * fq;
                    if (TYPE == T_QA) {
#pragma unroll
                        for (int k = 0; k < 8; ++k) v[bj][k] *= 0.08838834764831845f;
                    }
                    if (TYPE == T_GA || TYPE == T_GB) {
#pragma unroll
                        for (int k = 0; k < 8; ++k) v[bj][k] = silu(v[bj][k]);
                    }
                    if (TYPE == T_MGA || TYPE == T_MGB) {
#pragma unroll
                        for (int k = 0; k < 8; ++k) v[bj][k] = sigm(v[bj][k]);
                    }
                    if ((TYPE == T_KB || TYPE == T_VB) && bo) { *(f32x4*)(bo + col) = (f32x4){v[bj][0], v[bj][1], v[bj][2], v[bj][3]}; *(f32x4*)(bo + col + 4) = (f32x4){v[bj][4], v[bj][5], v[bj][6], v[bj][7]}; }
                    if (TYPE == T_VA) {
                        bf16_t* p = dst + ((size_t)((row >> 6) * 4 + tcol) * 256 + 64 * wc + 32 * bj + 8 * fq) * 64 + (row & 63);
#pragma unroll
                        for (int k = 0; k < 8; k += 2) { const unsigned w = pk2(v[bj][k], v[bj][k + 1]); p[k * 64] = (bf16_t)w; p[(k + 1) * 64] = (bf16_t)(w >> 16); }
                    } else if (TYPE == T_VB) {
                        bf16_t* p = dst + ((size_t)(((row - rsub) >> 6) * 16 + tcol * 4 + wc) * 64 + 32 * bj + 8 * fq) * 64 + (row & 63);
#pragma unroll
                        for (int k = 0; k < 8; k += 2) { const unsigned w = pk2(v[bj][k], v[bj][k + 1]); p[k * 64] = (bf16_t)w; p[(k + 1) * 64] = (bf16_t)(w >> 16); }
                    } else
                    *(u32x4*)(dst + (size_t)(row - rsub) * ld + col) = pack8(v[bj]);
                }
                asm volatile("" ::: "memory");
            }
    }
    DI void operator()(const pg8::f32x4 (&acc)[2][2][4][2], const pg8::Unit& u, int wr, int wc, int fr, int fq) const {
        asm volatile("" : "+v"(fr), "+v"(fq));
        const int gt = tile0 + u.pn;
        if (gt < 2) run<T_QA>(acc, u.pm, gt, wr, wc, fr, fq);
        else if (gt < 4) run<T_KA>(acc, u.pm, gt - 2, wr, wc, fr, fq);
        else if (gt < 8) run<T_VA>(acc, u.pm, gt - 4, wr, wc, fr, fq);
        else if (gt < 12) run<T_GA>(acc, u.pm, gt - 8, wr, wc, fr, fq);
        else if (gt == 12) run<T_RA>(acc, u.pm, 0, wr, wc, fr, fq);
        else if (gt < 17) run<T_QB>(acc, u.pm, gt - 13, wr, wc, fr, fq);
        else if (gt < 21) run<T_KB>(acc, u.pm, gt - 17, wr, wc, fr, fq);
        else if (gt < 25) run<T_VB>(acc, u.pm, gt - 21, wr, wc, fr, fq);
        else if (gt < 29) run<T_GB>(acc, u.pm, gt - 25, wr, wc, fr, fq);
        else if (gt < 33) run<T_MGA>(acc, u.pm, gt - 29, wr, wc, fr, fq);
        else run<T_MGB>(acc, u.pm, gt - 33, wr, wc, fr, fq);
    }
};
#define EPI_ROWS_BEGIN _Pragma("unroll") for (int ai = 0; ai < 2; ++ai) _Pragma("unroll") for (int m = 0; m < 4; ++m) { asm volatile("" ::: "memory"); const int row = u.pm * 256 + ai * 128 + wr * 64 + m * 16 + fr;
#define EPI_COLS_BEGIN _Pragma("unroll") for (int bj = 0; bj < 2; ++bj) { const int col = u.pn * 256 + 64 * wc + 32 * bj + 8 * fq; float v[8]; \
    _Pragma("unroll") for (int n = 0; n < 2; ++n) _Pragma("unroll") for (int e = 0; e < 4; ++e) v[4 * n + e] = acc[ai][bj][m][n][e];
struct EpiYA {
    static constexpr bool PERM = false, AFTER_DRAIN = false; bf16_t* G; int dry; bf16_t* Gs;
    DI void operator()(const pg8::f32x4 (&acc)[2][2][4][2], const pg8::Unit& u, int wr, int wc, int fr, int fq) const {
        asm volatile("" : "+v"(fr), "+v"(fq));
        EPI_ROWS_BEGIN EPI_COLS_BEGIN
            bf16_t* p = G + (size_t)row * 1024 + col; float g[8]; unpack8(*(const u32x4*)p, g);
#pragma unroll
            for (int k = 0; k < 8; ++k) v[k] *= g[k];
            if (!dry) *(u32x4*)p = pack8(v);
        } }
    }
    DI void mini(int row, int col, f32x4 s) const {
        bf16_t* p = Gs + (size_t)(row - MP) * 1024 + col; const u32x2 g = *(const u32x2*)p;
        u32x2 w; w.x = pk2(s.x * bflo(g.x), s.y * bfhi(g.x)); w.y = pk2(s.z * bflo(g.y), s.w * bfhi(g.y)); if (!dry) *(u32x2*)p = w;
    }
};
struct EpiYB {
    static constexpr bool PERM = false, AFTER_DRAIN = false; const bf16_t* YA; bf16_t* G; int dry; const bf16_t* YAs; bf16_t* Gs;
    DI void operator()(const pg8::f32x4 (&acc)[2][2][4][2], const pg8::Unit& u, int wr, int wc, int fr, int fq) const {
        asm volatile("" : "+v"(fr), "+v"(fq));
        EPI_ROWS_BEGIN EPI_COLS_BEGIN
            bf16_t* p = G + (size_t)row * 1024 + col; float g[8], ya[8]; unpack8(*(const u32x4*)p, g); unpack8(*(const u32x4*)(YA + (size_t)row * 1024 + col), ya);
#pragma unroll
            for (int k = 0; k < 8; ++k) v[k] = ya[k] + v[k] * g[k];
            if (!dry) *(u32x4*)p = pack8(v);
        } }
    }
    DI void mini(int row, int col, f32x4 s) const {
        bf16_t* p = Gs + (size_t)(row - MP) * 1024 + col; const u32x2 g = *(const u32x2*)p, y = *(const u32x2*)(YAs + (size_t)(row - MP) * 1024 + col);
        u32x2 w; w.x = pk2(bflo(y.x) + s.x * bflo(g.x), bfhi(y.x) + s.y * bfhi(g.x)); w.y = pk2(bflo(y.y) + s.z * bflo(g.y), bfhi(y.y) + s.w * bfhi(g.y)); if (!dry) *(u32x2*)p = w;
    }
};
struct EpiOut {
    static constexpr bool PERM = false, AFTER_DRAIN = false; const float* xp; const float* xs; float* out; bf16_t* xb; float* sq; int dry;
    DI void operator()(const pg8::f32x4 (&acc)[2][2][4][2], const pg8::Unit& u, int wr, int wc, int fr, int fq) const {
        asm volatile("" : "+v"(fr), "+v"(fq));
        EPI_ROWS_BEGIN
            const float* base = row < MP ? xp + (size_t)row * 1024 : xs + (size_t)(row - MP) * 1024; float ss = 0.f;
            EPI_COLS_BEGIN
                const f32x4 b0 = *(const f32x4*)(base + col), b1 = *(const f32x4*)(base + col + 4);
                v[0] += b0.x; v[1] += b0.y; v[2] += b0.z; v[3] += b0.w; v[4] += b1.x; v[5] += b1.y; v[6] += b1.z; v[7] += b1.w;
#pragma unroll
                for (int k = 0; k < 8; ++k) ss += v[k] * v[k];
                if (!dry) { float* o = out + (size_t)row * 1024 + col; *(f32x4*)o = (f32x4){v[0], v[1], v[2], v[3]}; *(f32x4*)(o + 4) = (f32x4){v[4], v[5], v[6], v[7]};
                *(u32x4*)(xb + (size_t)row * 1024 + col) = pack8(v); }
            }
            ss += __shfl_xor(ss, 16); ss += __shfl_xor(ss, 32);
            if (fq == 0 && !dry) sq[(size_t)row * 16 + 4 * u.pn + wc] = ss;
        }
    }
    DI void mini(int row, int col, f32x4 s) const {
        const float* base = row < MP ? xp + (size_t)row * 1024 : xs + (size_t)(row - MP) * 1024; const f32x4 b0 = *(const f32x4*)(base + col);
        const f32x4 x = s + b0; float ss = (x.x * x.x + x.y * x.y) + (x.z * x.z + x.w * x.w);
        ss += __shfl_xor(ss, 1); ss += __shfl_xor(ss, 2); ss += __shfl_xor(ss, 4); ss += __shfl_xor(ss, 8);
        if (!dry) { *(f32x4*)(out + (size_t)row * 1024 + col) = x; u32x2 w; w.x = pk2(x.x, x.y); w.y = pk2(x.z, x.w); *(u32x2*)(xb + (size_t)row * 1024 + col) = w;
            if ((col & 63) == 0) sq[(size_t)row * 16 + (col >> 6)] = ss; }
    }
};
struct EpiP {
    static constexpr bool PERM = false, AFTER_DRAIN = false; float* PT; int dry;
    DI void operator()(const pg8::f32x4 (&acc)[2][2][4][2], const pg8::Unit& u, int wr, int wc, int fr, int fq) const {
        asm volatile("" : "+v"(fr), "+v"(fq));
        EPI_ROWS_BEGIN EPI_COLS_BEGIN
            if (!dry) { float* o = PT + (size_t)row * 1024 + col; *(f32x4*)o = (f32x4){v[0], v[1], v[2], v[3]}; *(f32x4*)(o + 4) = (f32x4){v[4], v[5], v[6], v[7]}; }
        } }
    }
    DI void mini(int row, int col, f32x4 s) const { if (!dry) *(f32x4*)(PT + (size_t)row * 1024 + col) = s; }
};
struct EpiGate {
    static constexpr bool PERM = false, AFTER_DRAIN = false; const float* sq1; const float* PT; float* out; bf16_t* xb; float* sq2; int dry;
    DI void operator()(const pg8::f32x4 (&acc)[2][2][4][2], const pg8::Unit& u, int wr, int wc, int fr, int fq) const {
        asm volatile("" : "+v"(fr), "+v"(fq));
        EPI_ROWS_BEGIN
            const float rs = row_rstd(sq1, row); float ss = 0.f;
            EPI_COLS_BEGIN
                float* o = out + (size_t)row * 1024 + col; const float* pt = PT + (size_t)row * 1024 + col;
                const f32x4 b0 = *(const f32x4*)o, b1 = *(const f32x4*)(o + 4), p0 = *(const f32x4*)pt, p1 = *(const f32x4*)(pt + 4);
                const float xb_[8] = {b0.x, b0.y, b0.z, b0.w, b1.x, b1.y, b1.z, b1.w}, pp[8] = {p0.x, p0.y, p0.z, p0.w, p1.x, p1.y, p1.z, p1.w};
#pragma unroll
                for (int k = 0; k < 8; ++k) { v[k] = xb_[k] + sigm(v[k] * rs) * pp[k]; ss += v[k] * v[k]; }
                if (!dry) { *(f32x4*)o = (f32x4){v[0], v[1], v[2], v[3]}; *(f32x4*)(o + 4) = (f32x4){v[4], v[5], v[6], v[7]};
                *(u32x4*)(xb + (size_t)row * 1024 + col) = pack8(v); }
            }
            ss += __shfl_xor(ss, 16); ss += __shfl_xor(ss, 32);
            if (fq == 0 && !dry) sq2[(size_t)row * 16 + 4 * u.pn + wc] = ss;
        }
    }
    DI void mini(int row, int col, f32x4 s) const {
        const float rs = row_rstd(sq1, row); float* o = out + (size_t)row * 1024 + col; const f32x4 b0 = *(const f32x4*)o, p0 = *(const f32x4*)(PT + (size_t)row * 1024 + col);
        f32x4 x; x.x = b0.x + sigm(s.x * rs) * p0.x; x.y = b0.y + sigm(s.y * rs) * p0.y; x.z = b0.z + sigm(s.z * rs) * p0.z; x.w = b0.w + sigm(s.w * rs) * p0.w;
        float ss = (x.x * x.x + x.y * x.y) + (x.z * x.z + x.w * x.w);
        ss += __shfl_xor(ss, 1); ss += __shfl_xor(ss, 2); ss += __shfl_xor(ss, 4); ss += __shfl_xor(ss, 8);
        if (!dry) { *(f32x4*)o = x; u32x2 w; w.x = pk2(x.x, x.y); w.y = pk2(x.z, x.w); *(u32x2*)(xb + (size_t)row * 1024 + col) = w;
            if ((col & 63) == 0) sq2[(size_t)row * 16 + (col >> 6)] = ss; }
    }
};

struct OrderG {
    pg8::StaticOrder S; int G, c;
    DI void init(int G_, int c_) { S.init(MP, 13 * 256, G_, c_); G = G_; c = c_; }
    DI bool next(int i, pg8::Unit& u) const { if (S.next(i, u)) return true; const long s = (long)i * G + c - 64 * 13; if (s >= 2 * NWIN_T) return false; u.pm = 64 + (int)(s / NWIN_T); u.pn = (int)(s % NWIN_T); return true; }
    DI void a_ready(const pg8::Unit&) const {}
    DI void done(const pg8::Unit&) const {}
};
struct OrderM {
    pg8::StaticOrder S;
    DI void init(int G_, int c_) { S.init(MP, 1024, G_, c_); }
    DI bool next(int i, pg8::Unit& u) const { pg8::Unit v; if (!S.next(i >> 1, v)) return false; u.pm = v.pm; u.pn = 4 * (i & 1) + v.pn; return true; }
    DI void a_ready(const pg8::Unit&) const {}
    DI void done(const pg8::Unit&) const {}
};
template <class Epi> DI void run_gemm_m(LAS unsigned char* lds, const bf16_t* A, const bf16_t* Bt, const Epi& E) {
    int K = 1024; asm volatile("" : "+s"(K));
    pg8::Gemm g{A, Bt, MP, 8 * 256, K}; OrderM S; S.init((int)gridDim.x, (int)blockIdx.x);
    pg8::gemm_phase<Epi, OrderM, true, true>(lds, g, S, E);
}
template <class Epi> DI void run_gemm_g(LAS unsigned char* lds, const bf16_t* A, const bf16_t* Bt, const Epi& E) {
    int K = 1024; asm volatile("" : "+s"(K));
    pg8::Gemm g{A, Bt, MT, NWIN_T * 256, K}; OrderG S; S.init((int)gridDim.x, (int)blockIdx.x);
    pg8::gemm_phase<Epi, OrderG, true, true>(lds, g, S, E);
}
template <class Epi> DI void run_gemm(LAS unsigned char* lds, const bf16_t* A, const bf16_t* Bt, int M, int N, int K, const Epi& E) {
    asm volatile("" : "+s"(K), "+s"(N));
    pg8::Gemm g{A, Bt, M, N, K}; pg8::StaticOrder S; S.init(M, N, (int)gridDim.x, (int)blockIdx.x);
    pg8::gemm_phase<Epi, pg8::StaticOrder, true, true>(lds, g, S, E);
}

template <int K, class Epi> DI void mini_gemm(LAS unsigned char* lds, const bf16_t* A, const bf16_t* Wt, const Epi& E) {
    const int tid = otid(), lane = tid & 63, wave = __builtin_amdgcn_readfirstlane(tid >> 6), r = lane & 15, q = lane >> 4;
    constexpr int KW = K / 8;
    for (int mt = blockIdx.x; mt < 256; mt += gridDim.x) {
        const int row0 = 32 * (mt >> 4), cb = mt & 15, tile = cb >> 2, wcp = cb & 3, k0 = wave * KW;
        f32x4 acc[4][2];
#pragma unroll
        for (int ct = 0; ct < 4; ++ct) { acc[ct][0] = (f32x4){0.f, 0.f, 0.f, 0.f}; acc[ct][1] = (f32x4){0.f, 0.f, 0.f, 0.f}; }
#pragma unroll
        for (int ks = 0; ks < KW / 32; ++ks) {
            bf16x8 af[2], wf[4];
#pragma unroll
            for (int rt = 0; rt < 2; ++rt) af[rt] = *(const bf16x8*)(A + (size_t)(row0 + 16 * rt + r) * K + k0 + 32 * ks + 8 * q);
#pragma unroll
            for (int ct = 0; ct < 4; ++ct) { const int x = 16 * ct + r, p = 128 * (x >> 5) + 32 * wcp + 16 * ((x >> 2) & 1) + 4 * ((x >> 3) & 3) + (x & 3);
                wf[ct] = *(const bf16x8*)(Wt + (size_t)(tile * 256 + p) * K + k0 + 32 * ks + 8 * q); }
#pragma unroll
            for (int ct = 0; ct < 4; ++ct)
#pragma unroll
                for (int rt = 0; rt < 2; ++rt) acc[ct][rt] = __builtin_amdgcn_mfma_f32_16x16x32_bf16(wf[ct], af[rt], acc[ct][rt], 0, 0, 0);
        }
        LAS float* part = (LAS float*)lds + wave * (32 * 68);
#pragma unroll
        for (int ct = 0; ct < 4; ++ct)
#pragma unroll
            for (int rt = 0; rt < 2; ++rt) *(LAS f32x4*)(part + (16 * rt + r) * 68 + 16 * ct + 4 * q) = acc[ct][rt];
        __syncthreads();
        { const int row = tid >> 4, c4 = (tid & 15) * 4; f32x4 s = (f32x4){0.f, 0.f, 0.f, 0.f};
#pragma unroll
          for (int w = 0; w < 8; ++w) s += *(const LAS f32x4*)((const LAS float*)lds + w * (32 * 68) + row * 68 + c4);
          E.mini(MP + row0 + row, 64 * cb + c4, s); }
        __syncthreads();
    }
}

struct Args { const float* in[21]; float* out; unsigned char* ws; int ph_lo, ph_hi; };
static_assert(sizeof(Args) == 192, "Args layout (kin/kout/kws offsets)");
enum { I_XP = 0, I_XS, I_STATE, I_CK, I_CV, I_PP, I_PS, I_NORMG, I_WIN, I_WGU, I_BG, I_GLAG, I_QG, I_KG, I_RELB, I_WA, I_WB, I_WO, I_PLEG, I_WPG, I_WPLE };

DI void transpose_item(const float* W, int ldw, int srccol0, int nvalid, const float* gain, bf16_t* WT, int K, int rowbase, int k0, LAS float* scr, int lane) {
#pragma unroll 16
    for (int i = 0; i < 32; ++i) { const int kk = 2 * i + (lane >> 5), c = lane & 31;
        float w = 0.f; if (c < nvalid) w = W[(size_t)(k0 + kk) * ldw + srccol0 + c]; if (gain) w *= gain[k0 + kk];
        scr[kk * 33 + c] = w; }
    asm volatile("s_waitcnt lgkmcnt(0)" ::: "memory");
    const int c8 = lane & 7;
#pragma unroll
    for (int j = 0; j < 4; ++j) { const int n = (lane >> 3) + 8 * j; const LAS float* s = scr + (8 * c8) * 33 + n;
        u32x4 o; o.x = pk2(s[0 * 33], s[1 * 33]); o.y = pk2(s[2 * 33], s[3 * 33]); o.z = pk2(s[4 * 33], s[5 * 33]); o.w = pk2(s[6 * 33], s[7 * 33]);
        const int prow = 16 * ((n >> 2) & 1) + 4 * (n >> 3) + (n & 3);
        *(u32x4*)(WT + (size_t)(rowbase + prow) * K + k0 + 8 * c8) = o; }
    asm volatile("s_waitcnt lgkmcnt(0)" ::: "memory");
}
DI int win_src(int t, int& nvalid) {
    nvalid = 256;
    if (t < 2) return t * 256; if (t < 4) return 512 + (t - 2) * 256; if (t < 8) return 1024 + (t - 4) * 256; if (t < 12) return 2064 + (t - 8) * 256;
    if (t == 12) { nvalid = 16; return 2048; }
    if (t < 17) return 3088 + (t - 13) * 256; if (t < 21) return 4112 + (t - 17) * 256; if (t < 25) return 5136 + (t - 21) * 256; if (t < 29) return 6160 + (t - 25) * 256;
    if (t < 33) return 7184 + (t - 29) * 256; return 8208 + (t - 33) * 256;
}
DI void transpose_generic(const float* W, int ldw, int K, int ntile, bool is_win, const float* gain, bf16_t* WT, int item, LAS float* scr, int lane) {
    const int nkb = K / 64; const int kb = item % nkb, nb = (item / nkb) & 7, t = item / (nkb * 8);
    int nvalid = 256, src = t * 256; if (is_win) src = win_src(t, nvalid);
    int nv = nvalid - 32 * nb; nv = nv < 0 ? 0 : (nv > 32 ? 32 : nv);
    transpose_item(W, ldw, src + 32 * nb, nv, gain, WT, K, t * 256 + 128 * (nb & 1) + 32 * (nb >> 1), kb * 64, scr, lane);
}
constexpr int WIN_ITEMS = NWIN_T * 8 * 16, SQ_ITEMS = 4 * 8 * 16, PLE_ITEMS = 4 * 8 * 4;
constexpr int N_IN = 9232;
DI void prep_win(const Args& a, int L, int gw, int ngw, LAS float* scr, int lane) {
    bf16_t* WT = (bf16_t*)(kws() + WS_WIN);
    for (int it = gw; it < WIN_ITEMS; it += ngw) transpose_generic(kin(I_WIN) + (size_t)L * 1024 * N_IN, N_IN, 1024, NWIN_T, true, kin(I_NORMG) + L * 1024, WT, it, scr, lane);
}
DI bf16_t* wsm(const Args& a, int L, int which) { return (bf16_t*)(kws() + WS_WSM + (size_t)L * WSM_LAYER + (size_t)which * 2 * MiB); }
DI void prep_small(const Args& a, int gw, int ngw, LAS float* scr, int lane) {
    constexpr int PER_L = 4 * SQ_ITEMS + PLE_ITEMS;
    for (int it = gw; it < 2 * PER_L; it += ngw) {
        const int L = it / PER_L; int r = it % PER_L;
        if (r < SQ_ITEMS) { transpose_generic(kin(I_WA) + (size_t)L * 1048576, 1024, 1024, 4, false, nullptr, wsm(a, L, 0), r, scr, lane); continue; } r -= SQ_ITEMS;
        if (r < SQ_ITEMS) { transpose_generic(kin(I_WB) + (size_t)L * 1048576, 1024, 1024, 4, false, nullptr, wsm(a, L, 1), r, scr, lane); continue; } r -= SQ_ITEMS;
        if (r < SQ_ITEMS) { transpose_generic(kin(I_WO) + (size_t)L * 1048576, 1024, 1024, 4, false, nullptr, wsm(a, L, 2), r, scr, lane); continue; } r -= SQ_ITEMS;
        if (r < SQ_ITEMS) { transpose_generic(kin(I_WPG) + (size_t)L * 1048576, 1024, 1024, 4, false, kin(I_PLEG) + L * 1024, wsm(a, L, 3), r, scr, lane); continue; } r -= SQ_ITEMS;
        transpose_generic(kin(I_WPLE) + (size_t)L * 262144, 1024, 256, 4, false, nullptr, wsm(a, L, 4), r, scr, lane);
    }
}
DI float wave_sum(float v) {
#pragma unroll
    for (int o = 1; o < 64; o <<= 1) v += __shfl_xor(v, o);
    return v;
}
DI void prep_shift(int gw, int lane) {
    if (gw < 32) { const int L = gw >> 4, h = gw & 15;
        float mq = fabsf(kin(I_QG)[L * 64 + lane]), mk = fabsf(kin(I_KG)[L * 64 + lane]), mb = 0.f;
        for (int i = lane; i < 257; i += 64) mb = fmaxf(mb, fabsf(kin(I_RELB)[((size_t)L * 16 + h) * 257 + i]));
#pragma unroll
        for (int o = 1; o < 64; o <<= 1) { mq = fmaxf(mq, __shfl_xor(mq, o)); mk = fmaxf(mk, __shfl_xor(mk, o)); mb = fmaxf(mb, __shfl_xor(mb, o)); }
        if (lane == 0) ((float*)(kws() + WS_MSH))[gw] = (8.f * mq * mk + mb) * LOG2E; }
}
DI void prep_rows(const Args& a, int gw, int ngw, int lane) {
    bf16_t* XB = (bf16_t*)(kws() + WS_XB); float* SQ2 = (float*)(kws() + WS_SQ2);
    const float* xp = kin(I_XP); const float* xs = kin(I_XS);
    for (int row0 = gw; row0 < MT; row0 += 4 * ngw) {
        f32x4 v[4][4];
#pragma unroll
        for (int u = 0; u < 4; ++u) { const int row = row0 + u * ngw; if (row < MT) { const float* x = row < MP ? xp + (size_t)row * 1024 : xs + (size_t)(row - MP) * 1024;
#pragma unroll
            for (int j = 0; j < 4; ++j) v[u][j] = ((const f32x4*)x)[lane + 64 * j]; } }
#pragma unroll
        for (int u = 0; u < 4; ++u) { const int row = row0 + u * ngw; if (row < MT) { float s = 0.f;
#pragma unroll
            for (int j = 0; j < 4; ++j) s += (v[u][j].x * v[u][j].x + v[u][j].y * v[u][j].y) + (v[u][j].z * v[u][j].z + v[u][j].w * v[u][j].w);
            s = wave_sum(s);
            if (lane < 16) SQ2[(size_t)row * 16 + lane] = lane == 0 ? s : 0.f;
#pragma unroll
            for (int j = 0; j < 4; ++j) { u32x2 w; w.x = pk2(v[u][j].x, v[u][j].y); w.y = pk2(v[u][j].z, v[u][j].w); ((u32x2*)(XB + (size_t)row * 1024))[lane + 64 * j] = w; } } }
    }
}
DI void prep_misc(const Args& a, int gtid, int ngt) {
    bf16_t* PB = (bf16_t*)(kws() + WS_PB);
    const float* pp = kin(I_PP); const float* ps = kin(I_PS);
    for (int i0 = gtid; i0 < 2 * MT * 32; i0 += 4 * ngt) {
        f32x4 p0[4], p1[4];
#pragma unroll
        for (int k = 0; k < 4; ++k) { const int i = i0 + k * ngt; if (i < 2 * MT * 32) { const int c8 = i & 31, row = (i >> 5) % MT, L = (i >> 5) / MT;
            const float* src = row < MP ? pp + ((size_t)L * MP + row) * 256 + c8 * 8 : ps + ((size_t)L * MS + (row - MP)) * 256 + c8 * 8; p0[k] = *(const f32x4*)src; p1[k] = *(const f32x4*)(src + 4); } }
#pragma unroll
        for (int k = 0; k < 4; ++k) { const int i = i0 + k * ngt; if (i < 2 * MT * 32) { const int c8 = i & 31, row = (i >> 5) % MT, L = (i >> 5) / MT;
            u32x4 w; w.x = pk2(p0[k].x, p0[k].y); w.y = pk2(p0[k].z, p0[k].w); w.z = pk2(p1[k].x, p1[k].y); w.w = pk2(p1[k].z, p1[k].w);
            *(u32x4*)(PB + ((size_t)L * MT + row) * 256 + c8 * 8) = w; } }
    }
    constexpr int PER = 448 * 1024 / 4;
    const float* ck = kin(I_CK); const float* cv = kin(I_CV); float* out = kout();
    for (int i0 = gtid; i0 < 32 * PER; i0 += 8 * ngt) {
        f32x4 v[8];
#pragma unroll
        for (int k = 0; k < 8; ++k) { const int i = i0 + k * ngt; if (i < 32 * PER) { const int lb = i / PER, r = i % PER, kv = lb >> 4, l_b = lb & 15;
            v[k] = *((const f32x4*)((kv ? cv : ck) + (size_t)l_b * 512 * 1024 + 64 * 1024) + r); } }
#pragma unroll
        for (int k = 0; k < 8; ++k) { const int i = i0 + k * ngt; if (i < 32 * PER) { const int lb = i / PER, r = i % PER, kv = lb >> 4, l_b = lb & 15;
            *((f32x4*)(out + (kv ? O_VS : O_KS) + (size_t)l_b * 512 * 1024) + r) = v[k]; } }
    }
}

DI void gla_prep(const Args& a, int L, int c, int h, LAS float* totp, LAS float* ra_s, float (&b)[16], float& blast) {
    const int tid = otid(), d = tid & 127, jq = __builtin_amdgcn_readfirstlane(tid >> 7);
    if (tid < 256) *(LAS f32x4*)(ra_s + tid * 4) = *(const f32x4*)((const float*)(kws() + WS_RA) + (size_t)c * 64 * 16 + tid * 4);
    const float* wg = kin(I_WGU) + (size_t)L * 16 * 512 + h * 128 + d; float w[16];
#pragma unroll
    for (int r = 0; r < 16; ++r) w[r] = wg[r * 512];
    const float bg = kin(I_BG)[L * 512 + h * 128 + d];
    __syncthreads();
    float run = 0.f;
#pragma unroll
    for (int jj = 0; jj < 16; ++jj) {
        const LAS f32x4* rp = (const LAS f32x4*)(ra_s + (16 * jq + jj) * 16); const f32x4 r0 = rp[0], r1 = rp[1], r2 = rp[2], r3 = rp[3];
        float r = bg;
        r += r0.x * w[0]; r += r0.y * w[1]; r += r0.z * w[2]; r += r0.w * w[3]; r += r1.x * w[4]; r += r1.y * w[5]; r += r1.z * w[6]; r += r1.w * w[7];
        r += r2.x * w[8]; r += r2.y * w[9]; r += r2.z * w[10]; r += r2.w * w[11]; r += r3.x * w[12]; r += r3.y * w[13]; r += r3.z * w[14]; r += r3.w * w[15];
        const float lg = (fminf(r, 0.f) - __logf(1.f + __expf(-fabsf(r)))) * (1.f / 16.f);
        run += lg; b[jj] = run;
    }
    totp[jq * 128 + d] = run;
    __syncthreads();
    const float t0 = totp[d], t1 = totp[128 + d], t2 = totp[256 + d], t3 = totp[384 + d];
    const float off = jq == 0 ? 0.f : jq == 1 ? t0 : jq == 2 ? t0 + t1 : t0 + t1 + t2;
    blast = (t0 + t1) + (t2 + t3);
#pragma unroll
    for (int jj = 0; jj < 16; ++jj) b[jj] += off;
    if (jq == 0) totp[512 + d] = blast;
}
DI bf16x8 lds16(const LAS unsigned char* p) { return *(const LAS bf16x8*)p; }
DI s16x4 lds8(const LAS unsigned char* p) { return *(const LAS s16x4*)p; }
DI void vt_load(const bf16_t* VT, u32x4 (&vr)[4]) {
    const int tid = otid();
#pragma unroll
    for (int k = 0; k < 4; ++k) vr[k] = *(const u32x4*)(VT + (size_t)(tid + 512 * k) * 8);
}
DI void vt_store(const u32x4 (&vr)[4], LAS unsigned char* vt) {
    const int tid = otid();
#pragma unroll
    for (int k = 0; k < 4; ++k) { const int i = tid + 512 * k; *(LAS u32x4*)(vt + ((i >> 3) * 72 + (i & 7) * 8) * 2) = vr[k]; }
}
constexpr int GA_KT = 0, GA_VT = 18432, GA_TOT = 55296;
DI void gla_a_phase(const Args& a, int L, LAS unsigned char* lds, int item_lo, int item_hi, int first_wg) {
    const int tid = otid(), lane = tid & 63, wave = __builtin_amdgcn_readfirstlane(tid >> 6), r = lane & 15, q = lane >> 4;
    const bf16_t* KA = (const bf16_t*)(kws() + WS_OV + 2 * SLOT) + (size_t)MT * 512; const bf16_t* VA = (const bf16_t*)(kws() + WS_OV + 1 * SLOT);
    bf16_t* ST = (bf16_t*)(kws() + WS_OV + 3 * SLOT); float* DC = (float*)(kws() + WS_DC);
    LAS float* totp = (LAS float*)(lds + GA_TOT);
    int wg0_ = (int)blockIdx.x - first_wg; if (wg0_ < 0) wg0_ += (int)gridDim.x;
    for (int item = item_lo + wg0_; item < item_hi; item += gridDim.x) {
        const int c = item >> 2, h = item & 3;
        const int d = tid & 127, jq = tid >> 7;
        bf16_t kraw[16]; u32x4 vr[4];
#pragma unroll
        for (int jj = 0; jj < 16; ++jj) kraw[jj] = KA[((size_t)c * 64 + 16 * jq + jj) * 512 + h * 128 + d];
        vt_load(VA + (size_t)(c * 4 + h) * 16384, vr);
        float b[16], blast; gla_prep(a, L, c, h, totp, (LAS float*)(lds + GA_VT), b, blast);
        { float kd[16];
#pragma unroll
          for (int jj = 0; jj < 16; ++jj) kd[jj] = bf2f(kraw[jj]) * __expf(blast - b[jj]);
          LAS u32x4* o = (LAS u32x4*)(lds + GA_KT + (d * 72 + 16 * jq) * 2); o[0] = pack8(kd); o[1] = pack8(kd + 8); }
        if (jq == 0) DC[(size_t)item * 128 + d] = __expf(blast);
        vt_store(vr, lds + GA_VT);
        __syncthreads();
        f32x4 acc[8][2];
#pragma unroll
        for (int dt = 0; dt < 8; ++dt) { acc[dt][0] = (f32x4){0.f, 0.f, 0.f, 0.f}; acc[dt][1] = (f32x4){0.f, 0.f, 0.f, 0.f}; }
#pragma unroll
        for (int s = 0; s < 2; ++s) {
            bf16x8 bv[2];
#pragma unroll
            for (int vt = 0; vt < 2; ++vt) bv[vt] = lds16(lds + GA_VT + ((32 * wave + 16 * vt + r) * 72 + 32 * s + 8 * q) * 2);
#pragma unroll
            for (int dt = 0; dt < 8; ++dt) { const bf16x8 ak = lds16(lds + GA_KT + ((16 * dt + r) * 72 + 32 * s + 8 * q) * 2);
#pragma unroll
                for (int vt = 0; vt < 2; ++vt) acc[dt][vt] = __builtin_amdgcn_mfma_f32_16x16x32_bf16(ak, bv[vt], acc[dt][vt], 0, 0, 0); }
        }
        if (c < NPC) {
#pragma unroll
            for (int vt = 0; vt < 2; ++vt)
#pragma unroll
                for (int dt = 0; dt < 8; ++dt) { u32x2 w; w.x = pk2(acc[dt][vt][0], acc[dt][vt][1]); w.y = pk2(acc[dt][vt][2], acc[dt][vt][3]);
                    *(u32x2*)(ST + (size_t)item * 32768 + (32 * wave + 16 * vt + r) * 128 + 16 * dt + 4 * q) = w; }
        } else {
            const int bb = c - NPC; const size_t so = (((size_t)L * 8 + bb) * 4 + h) * 32768;
            const float* s0 = kin(I_STATE) + so; float* s1 = kout() + O_SS + so;
#pragma unroll
            for (int dt = 0; dt < 8; ++dt)
#pragma unroll
                for (int e = 0; e < 4; ++e) { const int dd = 16 * dt + 4 * q + e; const float dc = __expf(totp[512 + dd]);
#pragma unroll
                    for (int vt = 0; vt < 2; ++vt) { const int v = 32 * wave + 16 * vt + r; s1[dd * 256 + v] = dc * s0[dd * 256 + v] + acc[dt][vt][e]; } }
        }
        __syncthreads();
    }
}
DI void gla_scan_phase(const Args& a, int L, int dry) {
    bf16_t* ST = (bf16_t*)(kws() + WS_OV + 3 * SLOT); const float* DC = (const float*)(kws() + WS_DC);
    const int ngt = gridDim.x * NTHREADS;
    for (int gt = blockIdx.x * NTHREADS + otid(); gt < 16 * 8192; gt += ngt) {
        const int bh = gt >> 13, e4 = gt & 8191, bb = bh >> 2, h = bh & 3, d = (4 * e4) & 127, v = (4 * e4) >> 7;
        float run[4] = {0.f, 0.f, 0.f, 0.f};
        for (int n0 = 0; n0 < 64; n0 += 8) {
            u32x2 cur[8]; f32x4 dc[8];
#pragma unroll
            for (int k = 0; k < 8; ++k) { const size_t it = (size_t)(bb * 64 + n0 + k) * 4 + h; cur[k] = *(const u32x2*)(ST + it * 32768 + 4 * e4); dc[k] = *(const f32x4*)(DC + it * 128 + d); }
#pragma unroll
            for (int k = 0; k < 8; ++k) { const size_t it = (size_t)(bb * 64 + n0 + k) * 4 + h;
                u32x2 w; w.x = pk2(run[0], run[1]); w.y = pk2(run[2], run[3]); if (!dry || run[0] == 1.2345e30f) *(u32x2*)(ST + it * 32768 + 4 * e4) = w;
                run[0] = dc[k].x * run[0] + bflo(cur[k].x); run[1] = dc[k].y * run[1] + bfhi(cur[k].x); run[2] = dc[k].z * run[2] + bflo(cur[k].y); run[3] = dc[k].w * run[3] + bfhi(cur[k].y); }
        }
        float* o = kout() + O_SP + (((size_t)L * 4 + bb) * 4 + h) * 32768;
#pragma unroll
        for (int e = 0; e < 4; ++e) if (!dry || run[e] == 1.2345e30f) o[(d + e) * 256 + v] = run[e];
    }
}
constexpr int GC_QS = 0, GC_KS = 17408, GC_VT = 34816, GC_SS = 71680, GC_TOT = 141312, GC_RED = 143872;
DI void gla_c_phase(const Args& a, int L, LAS unsigned char* lds, int dry, int item_lo, int item_hi, int first_wg) {
    const int tid = otid(), lane = tid & 63, wave = __builtin_amdgcn_readfirstlane(tid >> 6), r = lane & 15, q = lane >> 4, it = wave & 3, vh = wave >> 2;
    const bf16_t* QA = (const bf16_t*)(kws() + WS_OV + 2 * SLOT); const bf16_t* KA = QA + (size_t)MT * 512; const bf16_t* VA = (const bf16_t*)(kws() + WS_OV + 1 * SLOT);
    bf16_t* SGA = (bf16_t*)(kws() + WS_OV); const bf16_t* ST = (const bf16_t*)(kws() + WS_OV + 3 * SLOT);
    LAS float* totp = (LAS float*)(lds + GC_TOT); LAS float* red = (LAS float*)(lds + GC_RED);
    const float* gg = kin(I_GLAG) + L * 256;
    int wg0_ = (int)blockIdx.x - first_wg; if (wg0_ < 0) wg0_ += (int)gridDim.x;
    for (int item = item_lo + wg0_; item < item_hi; item += gridDim.x) {
        const int c = item >> 2, h = item & 3;
        const int d = tid & 127, jq = tid >> 7;
        bf16_t qraw[16], kraw[16]; u32x4 vr[4], sr[8];
#pragma unroll
        for (int jj = 0; jj < 16; ++jj) { const size_t g = ((size_t)c * 64 + 16 * jq + jj) * 512 + h * 128 + d; qraw[jj] = QA[g]; kraw[jj] = KA[g]; }
        vt_load(VA + (size_t)(c * 4 + h) * 16384, vr);
        if (c < NPC) { const bf16_t* s = ST + (size_t)item * 32768;
#pragma unroll
            for (int k = 0; k < 8; ++k) sr[k] = *(const u32x4*)(s + (size_t)(tid + 512 * k) * 8); }
        float b[16], blast; gla_prep(a, L, c, h, totp, (LAS float*)(lds + GC_SS), b, blast);
#pragma unroll
        for (int jj = 0; jj < 16; ++jj) { const int j = 16 * jq + jj; const float eb = __expf(b[jj]);
            ((LAS bf16_t*)(lds + GC_QS))[j * 136 + d] = (bf16_t)pk2(bf2f(qraw[jj]) * eb, 0.f);
            ((LAS bf16_t*)(lds + GC_KS))[j * 136 + d] = (bf16_t)pk2(bf2f(kraw[jj]) * __builtin_amdgcn_rcpf(eb), 0.f); }
        vt_store(vr, lds + GC_VT);
        if (c < NPC) {
#pragma unroll
            for (int k = 0; k < 8; ++k) { const int i = tid + 512 * k, v = i >> 4, c8 = i & 15; *(LAS u32x4*)(lds + GC_SS + (v * 136 + c8 * 8) * 2) = sr[k]; }
        } else {
            const float* s0 = kin(I_STATE) + ((((size_t)L * 8 + (c - NPC)) * 4 + h) * 32768);
            for (int i = tid; i < 8192; i += NTHREADS) { const int dd = i & 127, v4 = i >> 7; const f32x4 s = *(const f32x4*)(s0 + dd * 256 + v4 * 4); LAS bf16_t* o = (LAS bf16_t*)(lds + GC_SS) + (v4 * 4) * 136 + dd;
                o[0] = (bf16_t)pk2(s.x, 0.f); o[136] = (bf16_t)pk2(s.y, 0.f); o[272] = (bf16_t)pk2(s.z, 0.f); o[408] = (bf16_t)pk2(s.w, 0.f); }
        }
        __syncthreads();
        bf16_t* orow = SGA + ((size_t)c * 64 + 16 * it + r) * 1024 + h * 256;
        u32x2 gate[8];
#pragma unroll
        for (int vt = 0; vt < 8; ++vt) gate[vt] = *(const u32x2*)(orow + 128 * vh + 16 * vt + 4 * q);
        bf16x8 bq[4];
#pragma unroll
        for (int ks = 0; ks < 4; ++ks) bq[ks] = lds16(lds + GC_QS + ((16 * it + r) * 136 + 32 * ks + 8 * q) * 2);
        f32x4 at[4];
#pragma unroll
        for (int jt = 0; jt < 4; ++jt) { at[jt] = (f32x4){0.f, 0.f, 0.f, 0.f};
            if (jt <= it) {
#pragma unroll
                for (int ks = 0; ks < 4; ++ks) at[jt] = __builtin_amdgcn_mfma_f32_16x16x32_bf16(lds16(lds + GC_KS + ((16 * jt + r) * 136 + 32 * ks + 8 * q) * 2), bq[ks], at[jt], 0, 0, 0);
                if (jt == it) {
#pragma unroll
                    for (int e = 0; e < 4; ++e) if (4 * q + e > r) at[jt][e] = 0.f;
                } } }
        bf16x8 bp[2];
#pragma unroll
        for (int s = 0; s < 2; ++s) { u32x4 w; w.x = pk2(at[2 * s][0], at[2 * s][1]); w.y = pk2(at[2 * s][2], at[2 * s][3]); w.z = pk2(at[2 * s + 1][0], at[2 * s + 1][1]); w.w = pk2(at[2 * s + 1][2], at[2 * s + 1][3]); bp[s] = __builtin_bit_cast(bf16x8, w); }
        f32x4 o[8];
#pragma unroll
        for (int vt = 0; vt < 8; ++vt) { o[vt] = (f32x4){0.f, 0.f, 0.f, 0.f}; const int v = 128 * vh + 16 * vt + r;
#pragma unroll
            for (int s = 0; s < 2; ++s) if (2 * s <= it) { const s16x4 lo = lds8(lds + GC_VT + (v * 72 + 32 * s + 4 * q) * 2), hi = lds8(lds + GC_VT + (v * 72 + 32 * s + 16 + 4 * q) * 2);
                const bf16x8 av = __builtin_shufflevector(lo, hi, 0, 1, 2, 3, 4, 5, 6, 7); o[vt] = __builtin_amdgcn_mfma_f32_16x16x32_bf16(av, bp[s], o[vt], 0, 0, 0); }
#pragma unroll
            for (int ks = 0; ks < 4; ++ks) o[vt] = __builtin_amdgcn_mfma_f32_16x16x32_bf16(lds16(lds + GC_SS + (v * 136 + 32 * ks + 8 * q) * 2), bq[ks], o[vt], 0, 0, 0); }
        float ss = 0.f;
#pragma unroll
        for (int vt = 0; vt < 8; ++vt) ss += (o[vt][0] * o[vt][0] + o[vt][1] * o[vt][1]) + (o[vt][2] * o[vt][2] + o[vt][3] * o[vt][3]);
        ss += __shfl_xor(ss, 16); ss += __shfl_xor(ss, 32);
        if (q == 0) red[vh * 64 + 16 * it + r] = ss;
        __syncthreads();
        const float rstd = rsqrtf((red[16 * it + r] + red[64 + 16 * it + r]) * (1.f / 256.f) + EPS);
#pragma unroll
        for (int vt = 0; vt < 8; ++vt) { const int v = 128 * vh + 16 * vt + 4 * q; const u32x2 g = gate[vt]; const f32x4 gn = *(const f32x4*)(gg + v);
            u32x2 w; w.x = pk2(o[vt][0] * rstd * gn.x * bflo(g.x), o[vt][1] * rstd * gn.y * bfhi(g.x)); w.y = pk2(o[vt][2] * rstd * gn.z * bflo(g.y), o[vt][3] * rstd * gn.w * bfhi(g.y));
            if (!dry || rstd == 1.2345e30f) *(u32x2*)(orow + v) = w; }
        __syncthreads();
    }
}

constexpr int AT_KS = 0, AT_VT = 36864, AT_BIAS = 73728, AT_BUF = 18432;
template <bool SAMPLE> DI void attn_load_k(int L, const bf16_t* KB, const float* ck, int bb, int n, int t, int hh, int sj, int sdq, u32x4& w0, u32x4& w1) {
    if (SAMPLE && t < 8) { const float* s = ck + (((size_t)L * 8 + bb) * 512 + t * 64 + sj) * 1024 + hh * 64 + 16 * sdq;
        const f32x4 f0 = *(const f32x4*)s, f1 = *(const f32x4*)(s + 4), f2 = *(const f32x4*)(s + 8), f3 = *(const f32x4*)(s + 12);
        w0.x = pk2(f0.x, f0.y); w0.y = pk2(f0.z, f0.w); w0.z = pk2(f1.x, f1.y); w0.w = pk2(f1.z, f1.w); w1.x = pk2(f2.x, f2.y); w1.y = pk2(f2.z, f2.w); w1.z = pk2(f3.x, f3.y); w1.w = pk2(f3.z, f3.w);
    } else { const size_t krow = SAMPLE ? (size_t)bb * 64 + sj : (size_t)bb * 4096 + (n - 8 + t) * 64 + sj; const bf16_t* s = KB + krow * 1024 + hh * 64 + 16 * sdq; w0 = *(const u32x4*)s; w1 = *(const u32x4*)(s + 8); }
}
template <bool SAMPLE> DI void attn_load_v(int L, const bf16_t* VBT, const float* cv, int bb, int n, int t, int hh, int tid, u32x4& w0, u32x4& w1) {
    if (SAMPLE && t < 8) { const int sj2 = tid & 63, dq2 = (tid >> 6) & 3; const float* s = cv + (((size_t)L * 8 + bb) * 512 + t * 64 + sj2) * 1024 + hh * 64 + 16 * dq2;
        const f32x4 f0 = *(const f32x4*)s, f1 = *(const f32x4*)(s + 4), f2 = *(const f32x4*)(s + 8), f3 = *(const f32x4*)(s + 12);
        w0.x = pk2(f0.x, f0.y); w0.y = pk2(f0.z, f0.w); w0.z = pk2(f1.x, f1.y); w0.w = pk2(f1.z, f1.w); w1.x = pk2(f2.x, f2.y); w1.y = pk2(f2.z, f2.w); w1.z = pk2(f3.x, f3.y); w1.w = pk2(f3.z, f3.w);
    } else { const int cc = SAMPLE ? bb : bb * 64 + (n - 8 + t); const bf16_t* s = VBT + ((size_t)cc * 16 + hh) * 4096 + (size_t)(tid & 255) * 8; w0 = *(const u32x4*)s; w1 = *(const u32x4*)(s + 2048); }
}
template <bool SAMPLE> DI void attn_item(const Args& a, int L, LAS unsigned char* lds, int dry, int item, bool stage_bias) {
    const int tid = otid(), lane = tid & 63, wave = __builtin_amdgcn_readfirstlane(tid >> 6), r = lane & 15, q = lane >> 4, g = wave >> 2, it = wave & 3;
    const bf16_t* QB = (const bf16_t*)(kws() + (SAMPLE ? WS_AX : WS_OV + 1 * SLOT)); const bf16_t* KB = (const bf16_t*)(kws() + (SAMPLE ? WS_AX + 1 * MiB : WS_OV + 2 * SLOT));
    const bf16_t* VB = (const bf16_t*)(kws() + (SAMPLE ? WS_AX + 2 * MiB : WS_OV + 3 * SLOT)); const bf16_t* GBs = (const bf16_t*)(kws() + (SAMPLE ? WS_AX + 3 * MiB : WS_OV + 4 * SLOT));
    bf16_t* SGB = (bf16_t*)(kws() + WS_OV + 4 * SLOT);
    const float* ck = kin(I_CK); const float* cv = kin(I_CV);
    LAS float* bias_s = (LAS float*)(lds + AT_BIAS);
    const int sg = tid >> 8, sj = (tid >> 2) & 63, sdq = tid & 3;
    const int c = item >> 3, hp = item & 7, h = 2 * hp + g;
    const int bb = SAMPLE ? c - NPC : c >> 6, n = SAMPLE ? 8 : c & 63, t0 = n >= 8 ? 0 : 8 - n;
    if (stage_bias) { const float* msh = (const float*)(kws() + WS_MSH) + L * 16 + 2 * hp;
    for (int i = tid; i < 2 * 257; i += NTHREADS) { const int g2 = i / 257, idx = i % 257; bias_s[g2 * 260 + idx] = kin(I_RELB)[((size_t)L * 16 + 2 * hp + g2) * 257 + idx] * LOG2E - msh[g2]; } }
    const size_t qrow = (size_t)c * 64 + 16 * it + r, qrl = SAMPLE ? qrow - MP : qrow;
    bf16x8 qf[2];
#pragma unroll
    for (int ks = 0; ks < 2; ++ks) qf[ks] = *(const bf16x8*)(QB + qrl * 1024 + h * 64 + 32 * ks + 8 * q);
    const int qi = 16 * it + r;
    bf16_t* orow = SGB + qrow * 1024 + h * 64;
    float l_run = 0.f;
    f32x4 o[4];
#pragma unroll
    for (int dt = 0; dt < 4; ++dt) o[dt] = (f32x4){0.f, 0.f, 0.f, 0.f};
    u32x4 k0, k1, v0, v1;
#define ATT_LOADT(T_) do { attn_load_k<SAMPLE>(L, KB, ck, bb, n, (T_), 2 * hp + sg, sj, sdq, k0, k1); attn_load_v<SAMPLE>(L, VB, cv, bb, n, (T_), 2 * hp + sg, tid, v0, v1); } while (0)
#define ATT_WRITE(T_, BUF_) do { const int bo_ = (BUF_) * AT_BUF; \
        LAS u32x4* ok = (LAS u32x4*)(lds + AT_KS + bo_ + ((sg * 64 + sj) * 72 + 16 * sdq) * 2); ok[0] = k0; ok[1] = k1; \
        if (SAMPLE && (T_) < 8) { const int sj2 = tid & 63, dq2 = (tid >> 6) & 3; LAS bf16_t* ov = (LAS bf16_t*)(lds + AT_VT + bo_) + (sg * 64 + 16 * dq2) * 72 + sj2; \
            ov[0] = (bf16_t)v0.x; ov[72] = (bf16_t)(v0.x >> 16); ov[144] = (bf16_t)v0.y; ov[216] = (bf16_t)(v0.y >> 16); ov[288] = (bf16_t)v0.z; ov[360] = (bf16_t)(v0.z >> 16); ov[432] = (bf16_t)v0.w; ov[504] = (bf16_t)(v0.w >> 16); \
            ov[576] = (bf16_t)v1.x; ov[648] = (bf16_t)(v1.x >> 16); ov[720] = (bf16_t)v1.y; ov[792] = (bf16_t)(v1.y >> 16); ov[864] = (bf16_t)v1.z; ov[936] = (bf16_t)(v1.z >> 16); ov[1008] = (bf16_t)v1.w; ov[1080] = (bf16_t)(v1.w >> 16); \
        } else { const int p0 = tid & 255, p1 = p0 + 256; \
            *(LAS u32x4*)(lds + AT_VT + bo_ + ((sg * 64 + (p0 >> 3)) * 72 + (p0 & 7) * 8) * 2) = v0; *(LAS u32x4*)(lds + AT_VT + bo_ + ((sg * 64 + (p1 >> 3)) * 72 + (p1 & 7) * 8) * 2) = v1; } } while (0)
    ATT_LOADT(t0);
    ATT_WRITE(t0, 0);
    if (t0 + 1 < 9) ATT_LOADT(t0 + 1);
    __syncthreads();
#pragma unroll 1
    for (int t = t0; t < 9; ++t) {
        const int cb = (t - t0) & 1;
        if (t + 1 < 9) { ATT_WRITE(t + 1, cb ^ 1); if (t + 2 < 9) ATT_LOADT(t + 2); }
        const LAS unsigned char* kb_ = lds + AT_KS + cb * AT_BUF; const LAS unsigned char* vb_ = lds + AT_VT + cb * AT_BUF;
        f32x4 sc[4];
#pragma unroll
        for (int jt = 0; jt < 4; ++jt) { f32x4 acc = (f32x4){0.f, 0.f, 0.f, 0.f};
#pragma unroll
            for (int ks = 0; ks < 2; ++ks) acc = __builtin_amdgcn_mfma_f32_16x16x32_bf16(lds16(kb_ + ((g * 64 + 16 * jt + r) * 72 + 32 * ks + 8 * q) * 2), qf[ks], acc, 0, 0, 0);
            sc[jt] = acc; }
        if (t >= 6) {
#pragma unroll
            for (int jt = 0; jt < 4; ++jt)
#pragma unroll
                for (int e = 0; e < 4; ++e) { int rel = 512 + qi - (64 * t + 16 * jt + 4 * q + e); rel = rel > 128 ? 128 : rel; rel = rel < -128 ? -128 : rel; sc[jt][e] += bias_s[g * 260 + rel + 128]; }
        } else { const float bfar = bias_s[g * 260 + 256];
#pragma unroll
            for (int jt = 0; jt < 4; ++jt) sc[jt] = sc[jt] + bfar;
        }
        float ps = 0.f;
#pragma unroll
        for (int jt = 0; jt < 4; ++jt)
#pragma unroll
            for (int e = 0; e < 4; ++e) { const float p = __builtin_amdgcn_exp2f(sc[jt][e]); sc[jt][e] = p; ps += p; }
        l_run += ps;
#pragma unroll
        for (int s = 0; s < 2; ++s) {
            u32x4 w; w.x = pk2(sc[2 * s][0], sc[2 * s][1]); w.y = pk2(sc[2 * s][2], sc[2 * s][3]); w.z = pk2(sc[2 * s + 1][0], sc[2 * s + 1][1]); w.w = pk2(sc[2 * s + 1][2], sc[2 * s + 1][3]);
            const bf16x8 bp = __builtin_bit_cast(bf16x8, w);
#pragma unroll
            for (int dt = 0; dt < 4; ++dt) { const LAS unsigned char* vp = vb_ + ((g * 64 + 16 * dt + r) * 72 + 32 * s + 4 * q) * 2;
                const s16x4 lo = lds8(vp), hi = lds8(vp + 32); const bf16x8 av = __builtin_shufflevector(lo, hi, 0, 1, 2, 3, 4, 5, 6, 7);
                o[dt] = __builtin_amdgcn_mfma_f32_16x16x32_bf16(av, bp, o[dt], 0, 0, 0); }
        }
        __syncthreads();
    }
#undef ATT_LOADT
#undef ATT_WRITE
    l_run += __shfl_xor(l_run, 16); l_run += __shfl_xor(l_run, 32);
    const float inv = __builtin_amdgcn_rcpf(l_run);
#pragma unroll
    for (int dt = 0; dt < 4; ++dt) { const int dd = 16 * dt + 4 * q; const u32x2 gv = *(const u32x2*)(GBs + qrl * 1024 + h * 64 + dd);
        u32x2 w; w.x = pk2(o[dt][0] * inv * bflo(gv.x), o[dt][1] * inv * bfhi(gv.x)); w.y = pk2(o[dt][2] * inv * bflo(gv.y), o[dt][3] * inv * bfhi(gv.y));
        if (!dry || inv == 1.2345e30f) *(u32x2*)(orow + dd) = w; }
}
DI void attn_phase(const Args& a, int L, LAS unsigned char* lds, int dry, int item_lo, int item_hi, int first_wg) {
    int wg0_ = (int)blockIdx.x - first_wg; if (wg0_ < 0) wg0_ += (int)gridDim.x;
    int prev_hp = -1;
    for (int item = item_lo + wg0_; item < item_hi; item += gridDim.x) { const bool sb = (item & 7) != prev_hp; prev_hp = item & 7;
        if ((item >> 3) >= NPC) attn_item<true>(a, L, lds, dry, item, sb); else attn_item<false>(a, L, lds, dry, item, sb); }
}

#define XB_TMO      128
#define XB_XCNT(j)  (256  + 64 * (j))
#define XB_XSUB(j)  (1280 + 64 * (j))
#define XB_XGEN(j)  (2304 + 64 * (j))
#define XB_TOP      3328
#define XB_TOPGEN   3392
#define XCD_BAR_WORDS 3456
#define XB_SPIN_CAP (1u << 18)

__device__ __forceinline__ unsigned xb_ld(unsigned* p)              { return __hip_atomic_load(p, __ATOMIC_RELAXED, __HIP_MEMORY_SCOPE_AGENT); }
__device__ __forceinline__ unsigned xb_add(unsigned* p, unsigned v) { return __hip_atomic_fetch_add(p, v, __ATOMIC_RELAXED, __HIP_MEMORY_SCOPE_AGENT); }
__device__ __forceinline__ unsigned xb_xcc_id() { return (unsigned)__builtin_amdgcn_s_getreg((3 << 11) | 20) & 0xFu; }
#define XB_SPIN(cond, bar) do { unsigned _sp = 0; while (cond) { __builtin_amdgcn_s_sleep(1); \
    if ((++_sp & 255u) == 0u) { if (xb_ld(&(bar)[XB_TMO])) break; if (_sp > XB_SPIN_CAP) { atomicAdd(&(bar)[XB_TMO], 1u); break; } } } } while (0)

struct XcdBarrier {
    unsigned* bar; unsigned x;
    volatile LAS unsigned* st;
};

__device__ __forceinline__ XcdBarrier xcd_barrier_post(unsigned* bar, volatile LAS unsigned* st) {
    XcdBarrier b; b.bar = bar; b.x = xb_xcc_id(); b.st = st;
    if (threadIdx.x == 0) (void)xb_add(&bar[XB_XCNT(b.x)], 1u);
    return b;
}
__device__ __forceinline__ void xcd_barrier_complete(unsigned* bar, unsigned x, unsigned& nloc, unsigned& nx) {
    const unsigned G = gridDim.x * gridDim.y * gridDim.z;
    unsigned sum, cnt, mine, sp = 0u;
    for (;;) {
        sum = 0u; cnt = 0u; mine = 0u;
#pragma unroll
        for (unsigned j = 0; j < 16; ++j) { const unsigned c = xb_ld(&bar[XB_XCNT(j)]); sum += c; cnt += (c > 0u) ? 1u : 0u; mine = (j == x) ? c : mine; }
        if (sum == G) break;
        __builtin_amdgcn_s_sleep(1);
        if ((++sp & 255u) == 0u) { if (xb_ld(&bar[XB_TMO])) break; if (sp > XB_SPIN_CAP) { atomicAdd(&bar[XB_TMO], 1u); break; } }
    }
    nloc = mine > 0u ? mine : 1u; nx = cnt > 0u ? cnt : 1u;
}

__device__ __forceinline__ void xcd_barrier(const XcdBarrier& b) {
    asm volatile("s_waitcnt vmcnt(0)" ::: "memory");
    __syncthreads();
    if (threadIdx.x == 0) {
        unsigned* bar = b.bar;
        __builtin_amdgcn_s_waitcnt(0);
        unsigned nloc = b.st[0], nx = b.st[1];
        if (nloc == 0u) { xcd_barrier_complete(bar, b.x, nloc, nx); b.st[0] = nloc; b.st[1] = nx; }
        const unsigned old = xb_add(&bar[XB_XSUB(b.x)], 1u);
        const unsigned gen = old / nloc;
        if (old + 1u == (gen + 1u) * nloc) {
            __builtin_amdgcn_fence(__ATOMIC_RELEASE, "agent");
            asm volatile("s_waitcnt vmcnt(0)" ::: "memory");
            const unsigned og = xb_add(&bar[XB_TOP], 1u);
            const unsigned tg = og / nx;
            if (og + 1u == (tg + 1u) * nx) xb_add(&bar[XB_TOPGEN], 1u);
            else XB_SPIN(xb_ld(&bar[XB_TOPGEN]) == tg, bar);
            __builtin_amdgcn_fence(__ATOMIC_ACQUIRE, "agent");
            xb_add(&bar[XB_XGEN(b.x)], 1u);
            asm volatile("s_waitcnt vmcnt(0)" ::: "memory");
        } else {
            XB_SPIN(xb_ld(&bar[XB_XGEN(b.x)]) == gen, bar);
            __builtin_amdgcn_fence(__ATOMIC_ACQUIRE, "agent");
            asm volatile("s_waitcnt vmcnt(0)" ::: "memory");
        }
    }
    __syncthreads();
}

#ifndef PROBE_REP
#define PROBE_REP 0
#endif
#ifndef EN_CH
#define EN_CH 31
#endif
#ifndef EN_PREP
#define EN_PREP 1
#endif
#ifndef EN_GIN
#define EN_GIN 1
#endif
#ifndef EN_GLAA
#define EN_GLAA 1
#endif
#ifndef EN_SCAN
#define EN_SCAN 1
#endif
#ifndef EN_GLAC
#define EN_GLAC 1
#endif
#ifndef EN_ATTN
#define EN_ATTN 1
#endif
#ifndef EN_CHAIN
#define EN_CHAIN 1
#endif
constexpr int PH_PER_LAYER = 10, N_PHASES = 1 + 2 * PH_PER_LAYER;
constexpr int MISC_OFF = LDS_BYTES - 64;
#define REPS(k) (((PROBE_REP >> (k)) & 1) ? 2 : 1)
__global__ void __launch_bounds__(NTHREADS, 2) fwd_kernel(Args a) {
    extern __shared__ __attribute__((aligned(16))) unsigned char lds_raw[];
    LAS unsigned char* lds = (LAS unsigned char*)lds_raw;
    const int tid = otid(), lane = tid & 63, wave = __builtin_amdgcn_readfirstlane(tid >> 6);
    const int gw = blockIdx.x * 8 + wave, ngw = gridDim.x * 8, gtid = blockIdx.x * NTHREADS + tid, ngt = gridDim.x * NTHREADS;
    LAS float* scr = (LAS float*)(lds + wave * 16384);
    const int lo = kph_lo(), hi = kph_hi();
    volatile LAS unsigned* MISC = (volatile LAS unsigned*)(lds + MISC_OFF);
    if (tid < 16) MISC[tid] = 0u;
    __syncthreads();
    XcdBarrier bar; bar.bar = (unsigned*)kws(); bar.x = 0; bar.st = nullptr;
    if (hi - lo > 1) bar = xcd_barrier_post((unsigned*)kws(), MISC);
#define IN_PH(k) (lo <= (k) && (k) < hi)
#define SEAM(k) do { if (IN_PH(k) && IN_PH((k) + 1)) { if ((k) == 0) { __threadfence(); cg::this_grid().sync(); } else { xcd_barrier(bar); if ((PROBE_REP >> 11) & 1) xcd_barrier(bar); } } } while (0)
    if (EN_PREP && IN_PH(0)) for (int rep = 0; rep < REPS(10); ++rep) { prep_small(a, gw, ngw, scr, lane); prep_win(a, 0, gw, ngw, scr, lane); prep_rows(a, gw, ngw, lane); prep_shift(gw, lane); prep_misc(a, gtid, ngt); __syncthreads(); }
    SEAM(0);
    for (int L = 0; L < 2; ++L) {
        const int pb = 1 + L * PH_PER_LAYER;
        unsigned char* ws = kws();
        bf16_t* XB = (bf16_t*)(ws + WS_XB); float* SQ1 = (float*)(ws + WS_SQ1); float* SQ2 = (float*)(ws + WS_SQ2);
        bf16_t* S0 = (bf16_t*)(ws + WS_OV); bf16_t* S1 = (bf16_t*)(ws + WS_OV + SLOT); bf16_t* S2 = (bf16_t*)(ws + WS_OV + 2 * SLOT); bf16_t* S3 = (bf16_t*)(ws + WS_OV + 3 * SLOT); bf16_t* S4 = (bf16_t*)(ws + WS_OV + 4 * SLOT);
        const bf16_t* WIN = (const bf16_t*)(ws + WS_WIN);
        EpiIn ein; ein.L = L; ein.ws = ws; ein.out = kout(); ein.qg = kin(I_QG) + L * 64; ein.kg = kin(I_KG) + L * 64;
        if (EN_GIN && IN_PH(pb + 0)) for (int rep = 0; rep < REPS(0); ++rep) { ein.tile0 = 0; run_gemm_g(lds, XB, WIN, ein); }
        SEAM(pb + 0);
        if (EN_GLAA && IN_PH(pb + 1)) for (int rep = 0; rep < REPS(1); ++rep) gla_a_phase(a, L, lds, 0, NPC * 4, 0);
        SEAM(pb + 1);
        if (EN_SCAN && IN_PH(pb + 2)) for (int rep = 0; rep < REPS(2); ++rep) {
            gla_a_phase(a, L, lds, NPC * 4, NCH * 4, 0); gla_c_phase(a, L, lds, rep + 1 < REPS(2), NPC * 4, NCH * 4, 32);
            attn_phase(a, L, lds, rep + 1 < REPS(2), NPC * 8, NCH * 8, 64);
            gla_scan_phase(a, L, rep + 1 < REPS(2)); }
        SEAM(pb + 2);
        if (EN_GLAC && IN_PH(pb + 3)) for (int rep = 0; rep < REPS(3); ++rep) gla_c_phase(a, L, lds, rep + 1 < REPS(3), 0, NPC * 4, 0);
        SEAM(pb + 3);
        if (EN_GIN && IN_PH(pb + 4)) for (int rep = 0; rep < REPS(4); ++rep) { ein.tile0 = 13; run_gemm(lds, XB, WIN + (size_t)13 * 256 * 1024, MP, 16 * 256, 1024, ein); }
        SEAM(pb + 4);
        if (EN_ATTN && IN_PH(pb + 5)) for (int rep = 0; rep < REPS(5); ++rep) attn_phase(a, L, lds, rep + 1 < REPS(5), 0, NPC * 8, 0);
        SEAM(pb + 5);
        if (EN_GIN && IN_PH(pb + 6)) for (int rep = 0; rep < REPS(6); ++rep) { ein.tile0 = 29; run_gemm_m(lds, XB, WIN + (size_t)29 * 256 * 1024, ein); }
        if (!(IN_PH(pb + 6) && IN_PH(pb + 7))) SEAM(pb + 6);
        if (EN_CHAIN && IN_PH(pb + 7)) for (int rep = 0; rep < REPS(7); ++rep) { const int dry = rep + 1 < REPS(7);
            if (EN_CH & 1) { bf16_t* AXA = (bf16_t*)(ws + WS_AX + 4 * MiB); EpiYA ea{S1, dry, AXA}; run_gemm(lds, S0, wsm(a, L, 0), MP, 1024, 1024, ea); mini_gemm<1024>(lds, S0 + (size_t)MP * 1024, wsm(a, L, 0), ea); }
            if (EN_CH & 2) { bf16_t* AXA = (bf16_t*)(ws + WS_AX + 4 * MiB); bf16_t* AXB = (bf16_t*)(ws + WS_AX + 5 * MiB); EpiYB eb{S1, S2, dry, AXA, AXB}; run_gemm(lds, S4, wsm(a, L, 1), MP, 1024, 1024, eb); mini_gemm<1024>(lds, S4 + (size_t)MP * 1024, wsm(a, L, 1), eb); }
        }
        SEAM(pb + 7);
        if (EN_CHAIN && IN_PH(pb + 8)) {
            if (L == 0) { prep_win(a, 1, gw, ngw, scr, lane); __syncthreads(); }
            for (int rep = 0; rep < REPS(8); ++rep) {
            EpiOut eo; eo.xp = L == 0 ? kin(I_XP) : kout(); eo.xs = L == 0 ? kin(I_XS) : kout() + (size_t)MP * 1024; eo.out = kout(); eo.xb = S3; eo.sq = SQ1; eo.dry = rep + 1 < REPS(8);
            if (EN_CH & 4) { run_gemm(lds, S2, wsm(a, L, 2), MP, 1024, 1024, eo); mini_gemm<1024>(lds, (const bf16_t*)(ws + WS_AX + 5 * MiB), wsm(a, L, 2), eo); } }
        }
        SEAM(pb + 8);
        if (EN_CHAIN && IN_PH(pb + 9)) for (int rep = 0; rep < REPS(9); ++rep) { const int dry = rep + 1 < REPS(9);
            if (EN_CH & 8) { EpiP ep{(float*)S0, dry}; run_gemm(lds, (const bf16_t*)(ws + WS_PB) + (size_t)L * MT * 256, wsm(a, L, 4), MP, 1024, 256, ep); mini_gemm<256>(lds, (const bf16_t*)(ws + WS_PB) + ((size_t)L * MT + MP) * 256, wsm(a, L, 4), ep); }
            EpiGate eg; eg.sq1 = SQ1; eg.PT = (const float*)S0; eg.out = kout(); eg.xb = XB; eg.sq2 = SQ2; eg.dry = dry;
            if (EN_CH & 16) { run_gemm(lds, S3, wsm(a, L, 3), MP, 1024, 1024, eg); mini_gemm<1024>(lds, S3 + (size_t)MP * 1024, wsm(a, L, 3), eg); }
        }
        SEAM(pb + 9);
    }
}

#ifndef MK_ONE_LAUNCH
#define MK_ONE_LAUNCH 1
#endif
extern "C" void kernel_launch(void* const* d_in, const int* in_sizes, int n_in, void* d_out, int out_size, void* d_ws, size_t ws_size, hipStream_t stream) {
    static int grid = 0;
    if (grid == 0) {
        if (n_in != 21 || ws_size < WS_END) { fprintf(stderr, "kernel_launch: unexpected n_in %d or ws_size %zu (< %zu)\n", n_in, ws_size, (size_t)WS_END); grid = -1; return; }
        int dev = 0, cus = 0, per_cu = 0;
        (void)hipGetDevice(&dev); (void)hipDeviceGetAttribute(&cus, hipDeviceAttributeMultiprocessorCount, dev);
        (void)hipFuncSetAttribute((const void*)fwd_kernel, hipFuncAttributeMaxDynamicSharedMemorySize, LDS_BYTES);
        (void)hipOccupancyMaxActiveBlocksPerMultiprocessor(&per_cu, (const void*)fwd_kernel, NTHREADS, LDS_BYTES);
        (void)hipGetLastError();
        if (per_cu < 1) { fprintf(stderr, "kernel_launch: occupancy query says %d blocks/CU\n", per_cu); per_cu = 1; }
        grid = cus;
    }
    if (grid < 0) return;
    Args a{};
    for (int i = 0; i < 21; ++i) a.in[i] = (const float*)d_in[i];
    a.out = (float*)d_out; a.ws = (unsigned char*)d_ws;
#if MK_ONE_LAUNCH
    (void)hipMemsetAsync(d_ws, 0, 16384, stream);
    a.ph_lo = 0; a.ph_hi = N_PHASES;
    void* args[] = {&a};
    hipError_t e = hipLaunchCooperativeKernel((const void*)fwd_kernel, dim3(grid), dim3(NTHREADS), args, LDS_BYTES, stream);
    if (e != hipSuccess) fprintf(stderr, "cooperative launch failed: %s (grid %d)\n", hipGetErrorString(e), grid);
#else
    for (int p = 0; p < N_PHASES; ++p) { a.ph_lo = p; a.ph_hi = p + 1; hipLaunchKernelGGL(fwd_kernel, dim3(grid), dim3(NTHREADS), LDS_BYTES, stream, a); }
#endif
}
```

```cpp
#include <hip/hip_runtime.h>
#include <hip/hip_cooperative_groups.h>
#include <cstdio>
#include <cstdint>
namespace cg = cooperative_groups;
namespace pg8 {
#define PG8_LAS __attribute__((address_space(3)))
typedef unsigned short bf16_t;
typedef short bf16x8 __attribute__((ext_vector_type(8)));
typedef float f32x4 __attribute__((ext_vector_type(4)));
typedef unsigned u32x4 __attribute__((ext_vector_type(4)));
constexpr int BM = 256, BK = 64, HALF = 128, HTB = HALF * BK * 2  , STAGE_BYTES = 8 * HTB, NXCD = 8, WGM = 8;

__host__ __device__ __forceinline__ int lds_byte(int r, int c) { const int st = (r >> 4) * 2 + (c >> 5), rr = r & 15, cc = c & 31, ob = rr * 64 + cc * 2; return st * 1024 + (ob ^ (((ob >> 9) & 1) << 5)); }
__host__ __device__ __forceinline__ void stage_rc(int b, int& R, int& C) { const int st = b / 1024, sb = b % 1024, swz = sb ^ (((sb >> 9) & 1) << 5); R = (st >> 1) * 16 + swz / 64; C = (st & 1) * 32 + (swz % 64) / 2; }
__host__ __device__ __forceinline__ int perm32(int rho) { const int n = rho >> 4, i = rho & 15; return 8 * (i >> 2) + 4 * n + (i & 3); }

struct Unit { int pm, pn; };
struct Gemm { const bf16_t* A; const bf16_t* Bt; int M, N, K; };

struct StaticOrder {
    int nM, nN, nwg, G, c;
    __host__ __device__ void init(int M, int N, int G_, int c_) { nM = M / BM; nN = N / BM; nwg = nM * nN; G = G_; c = c_; }
    __host__ __device__ bool next(int i, Unit& u) const {
        const long L = (long)i * G + c; if (L >= nwg) return false;
        int wgid = (int)L; { const int q = nwg / NXCD, r = nwg % NXCD, xcd = wgid % NXCD, off = wgid / NXCD; wgid = (xcd < r ? xcd * (q + 1) : r * (q + 1) + (xcd - r) * q) + off; }
        const int nig = WGM * nN, gid = wgid / nig, fm = gid * WGM, gsz = (nM - fm) < WGM ? (nM - fm) : WGM;
        u.pm = fm + ((wgid % nig) % gsz); u.pn = (wgid % nig) / gsz; return true;
    }
    __device__ __forceinline__ void a_ready(const Unit&) const {}
    __device__ __forceinline__ void done(const Unit&) const {}
};
__device__ __forceinline__ unsigned cvt_pk_bf16(float lo, float hi) { unsigned r; asm volatile("v_cvt_pk_bf16_f32 %0, %1, %2" : "=v"(r) : "v"(lo), "v"(hi)); return r; }
template <class Epi, class Sched, bool ALIGN_EPI = false, bool SP2 = false>
__device__ __forceinline__ void gemm_phase(PG8_LAS unsigned char* lds, const Gemm g, const Sched& S, const Epi& E) {
    int tid_ = threadIdx.x; asm volatile("" : "+v"(tid_));
    const int tid = tid_, wid = __builtin_amdgcn_readfirstlane(tid >> 6), lane = tid & 63, wr = wid >> 2, wc = wid & 3, fr = lane & 15, fq = lane >> 4;
    const int K = g.K, nt = K / BK;
    unsigned voffA[2], voffB[2];
#pragma unroll
    for (int i = 0; i < 2; ++i) { int R, C; stage_rc(tid * 16 + i * 8192, R, C); const int Rb = Epi::PERM ? ((R & ~31) + perm32(R & 31)) : R;
        voffA[i] = (unsigned)(R * K + C) * 2u; voffB[i] = (unsigned)(Rb * K + C) * 2u; }
    const size_t kstep = (size_t)(BK * 2);
    const size_t hstep = (size_t)HALF * K * 2;
    const size_t tstep = 2 * hstep;
    const unsigned ldsw = (unsigned)wid * 1024u;
    const int aoff = lds_byte(wr * 64 + fr, fq * 8), boff = lds_byte(wc * 32 + fr, fq * 8);
#define PG8_SA(b, h) (((b) * 2 + (h)) * HTB)
#define PG8_SB(b, h) ((4 + (b) * 2 + (h)) * HTB)
#define PG8_STAGE(bufoff, gbase, voff) do { _Pragma("unroll") for (int _i = 0; _i < 2; ++_i) \
        __builtin_amdgcn_global_load_lds((const unsigned*)((const char*)(gbase) + (voff)[_i]), (PG8_LAS unsigned*)(lds + (bufoff) + ldsw + _i * 8192), 16, 0, 0); } while (0)
#define PG8_LDA(dst, b, h) do { _Pragma("unroll") for (int m = 0; m < 4; ++m) _Pragma("unroll") for (int k = 0; k < 2; ++k) dst[m][k] = *(const PG8_LAS bf16x8*)(lds + PG8_SA(b, h) + aoff + m * 2048 + k * 1024); } while (0)
#define PG8_LDB(dst, b, h) do { _Pragma("unroll") for (int n = 0; n < 2; ++n) _Pragma("unroll") for (int k = 0; k < 2; ++k) dst[n][k] = *(const PG8_LAS bf16x8*)(lds + PG8_SB(b, h) + boff + n * 2048 + k * 1024); } while (0)
#define PG8_MMA(ai, bj, At, Bt) do { __builtin_amdgcn_s_setprio(1); _Pragma("unroll") for (int m = 0; m < 4; ++m) _Pragma("unroll") for (int n = 0; n < 2; ++n) _Pragma("unroll") for (int k = 0; k < 2; ++k) \
        acc[ai][bj][m][n] = __builtin_amdgcn_mfma_f32_16x16x32_bf16(Bt[n][k], At[m][k], acc[ai][bj][m][n], 0, 0, 0); __builtin_amdgcn_s_setprio(0); } while (0)
#define PG8_WAIT_V(n) asm volatile("s_waitcnt vmcnt(" #n ")" ::: "memory")
#define PG8_WAIT_L(n) asm volatile("s_waitcnt lgkmcnt(" #n ")" ::: "memory")
#define PG8_BAR __builtin_amdgcn_s_barrier()
#define PG8_SCHED __builtin_amdgcn_sched_barrier(0)
    Unit cur, nxt; int ui = 0;
    if (!S.next(0, cur)) return;
    f32x4 acc[2][2][4][2];
#pragma unroll
    for (int a = 0; a < 2; ++a)
#pragma unroll
        for (int b = 0; b < 2; ++b)
#pragma unroll
            for (int m = 0; m < 4; ++m)
#pragma unroll
                for (int n = 0; n < 2; ++n) acc[a][b][m][n] = (f32x4){0.f, 0.f, 0.f, 0.f};
    bf16x8 At[4][2], B0[2][2], B1[2][2];
    const char* cA = (const char*)g.A + (size_t)cur.pm * tstep; const char* cB = (const char*)g.Bt + (size_t)cur.pn * tstep;
    S.a_ready(cur);
    if constexpr (SP2) {
        PG8_STAGE(PG8_SB(0, 0), cB, voffB); PG8_STAGE(PG8_SB(0, 1), cB + hstep, voffB); PG8_STAGE(PG8_SA(0, 0), cA, voffA); PG8_STAGE(PG8_SA(0, 1), cA + hstep, voffA);
        if (wr == 1) PG8_BAR;
        PG8_WAIT_V(2); PG8_BAR;
        PG8_STAGE(PG8_SB(1, 0), cB + kstep, voffB); PG8_STAGE(PG8_SA(1, 0), cA + kstep, voffA); PG8_STAGE(PG8_SB(1, 1), cB + hstep + kstep, voffB);
        PG8_WAIT_V(6); PG8_BAR;
    } else {
        PG8_STAGE(PG8_SB(0, 0), cB, voffB); PG8_STAGE(PG8_SA(0, 0), cA, voffA); PG8_STAGE(PG8_SB(0, 1), cB + hstep, voffB); PG8_STAGE(PG8_SA(0, 1), cA + hstep, voffA);
        if (wr == 1) PG8_BAR;
        PG8_WAIT_V(4); PG8_BAR;
        PG8_STAGE(PG8_SB(1, 0), cB + kstep, voffB); PG8_STAGE(PG8_SA(1, 0), cA + kstep, voffA); PG8_STAGE(PG8_SB(1, 1), cB + hstep + kstep, voffB);
        PG8_WAIT_V(6); PG8_BAR;
    }
    for (;;) {
        const bool has_next = S.next(ui + 1, nxt);
        const char* nA = has_next ? (const char*)g.A + (size_t)nxt.pm * tstep : cA; const char* nB = has_next ? (const char*)g.Bt + (size_t)nxt.pn * tstep : cB;
        for (int t = 0; t < nt; t += 2) {
            const bool last = (t == nt - 2);
            const char* a1 = cA + (size_t)(t + 1) * kstep;
            const char* a2 = last ? nA : cA + (size_t)(t + 2) * kstep; const char* b2 = last ? nB : cB + (size_t)(t + 2) * kstep;
            const char* a3 = a2 + kstep; const char* b3 = b2 + kstep;
            if (last && has_next) S.a_ready(nxt);
            if constexpr (SP2) {
            PG8_LDB(B0, 0, 0); PG8_LDB(B1, 0, 1); PG8_SCHED; PG8_LDA(At, 0, 0); PG8_STAGE(PG8_SA(1, 1), a1 + hstep, voffA);
            PG8_WAIT_V(8); PG8_WAIT_L(0); PG8_BAR; PG8_MMA(0, 0, At, B0); PG8_MMA(0, 1, At, B1); PG8_BAR; PG8_SCHED;
            PG8_LDA(At, 0, 1); PG8_STAGE(PG8_SB(0, 0), b2, voffB); PG8_STAGE(PG8_SB(0, 1), b2 + hstep, voffB); PG8_STAGE(PG8_SA(0, 0), a2, voffA);
            PG8_WAIT_V(8); PG8_WAIT_L(0); PG8_BAR; PG8_MMA(1, 0, At, B0); PG8_MMA(1, 1, At, B1); PG8_BAR; PG8_SCHED;
            PG8_LDB(B0, 1, 0); PG8_LDB(B1, 1, 1); PG8_SCHED; PG8_LDA(At, 1, 0); PG8_STAGE(PG8_SA(0, 1), a2 + hstep, voffA);
            PG8_WAIT_V(8); PG8_WAIT_L(0); PG8_BAR; PG8_MMA(0, 0, At, B0); PG8_MMA(0, 1, At, B1); PG8_BAR; PG8_SCHED;
            PG8_LDA(At, 1, 1); PG8_STAGE(PG8_SB(1, 0), b3, voffB); PG8_STAGE(PG8_SB(1, 1), b3 + hstep, voffB); PG8_STAGE(PG8_SA(1, 0), a3, voffA);
            PG8_WAIT_V(8); PG8_WAIT_L(0); PG8_BAR; PG8_MMA(1, 0, At, B0); PG8_MMA(1, 1, At, B1); PG8_BAR; PG8_SCHED;
            } else {
            PG8_LDB(B0, 0, 0); PG8_SCHED; PG8_LDA(At, 0, 0); PG8_STAGE(PG8_SA(1, 1), a1 + hstep, voffA);
            PG8_WAIT_L(8); PG8_BAR; PG8_WAIT_L(0); PG8_MMA(0, 0, At, B0); PG8_BAR; PG8_SCHED;
            PG8_LDB(B1, 0, 1); PG8_STAGE(PG8_SB(0, 0), b2, voffB);
            PG8_BAR; PG8_WAIT_L(0); PG8_MMA(0, 1, At, B1); PG8_BAR;
            PG8_LDA(At, 0, 1); PG8_STAGE(PG8_SA(0, 0), a2, voffA);
            PG8_BAR; PG8_WAIT_L(0); PG8_MMA(1, 0, At, B0); PG8_BAR; PG8_SCHED;
            PG8_STAGE(PG8_SB(0, 1), b2 + hstep, voffB);
            PG8_WAIT_V(6); PG8_BAR; PG8_MMA(1, 1, At, B1); PG8_BAR;
            PG8_LDB(B0, 1, 0); PG8_SCHED; PG8_LDA(At, 1, 0); PG8_STAGE(PG8_SA(0, 1), a2 + hstep, voffA);
            PG8_WAIT_L(8); PG8_BAR; PG8_WAIT_L(0); PG8_MMA(0, 0, At, B0); PG8_BAR; PG8_SCHED;
            PG8_LDB(B1, 1, 1); PG8_STAGE(PG8_SB(1, 0), b3, voffB);
            PG8_BAR; PG8_WAIT_L(0); PG8_MMA(0, 1, At, B1); PG8_BAR;
            PG8_LDA(At, 1, 1); PG8_STAGE(PG8_SA(1, 0), a3, voffA);
            PG8_BAR; PG8_WAIT_L(0); PG8_MMA(1, 0, At, B0); PG8_BAR; PG8_SCHED;
            PG8_STAGE(PG8_SB(1, 1), b3 + hstep, voffB);
            PG8_WAIT_V(6); PG8_BAR; PG8_MMA(1, 1, At, B1); PG8_BAR;
            }
        }
        if constexpr (ALIGN_EPI) { if (wr == 0) PG8_BAR; }
        if constexpr (!Epi::AFTER_DRAIN) { E(acc, cur, wr, wc, fr, fq); S.done(cur); }
        if (!has_next) break;
#pragma unroll
        for (int a = 0; a < 2; ++a)
#pragma unroll
            for (int b = 0; b < 2; ++b)
#pragma unroll
                for (int m = 0; m < 4; ++m)
#pragma unroll
                    for (int n = 0; n < 2; ++n) acc[a][b][m][n] = (f32x4){0.f, 0.f, 0.f, 0.f};
        cur = nxt; cA = nA; cB = nB; ++ui;
        if constexpr (ALIGN_EPI) { if (wr == 1) PG8_BAR; }
    }
    PG8_WAIT_V(0);
    if constexpr (!ALIGN_EPI) { if (wr == 0) PG8_BAR; }
    PG8_BAR;
    if constexpr (Epi::AFTER_DRAIN) { E.fused(acc, cur, wr, wc, fr, fq, lds, wid, lane); S.done(cur); }
#undef PG8_SA
#undef PG8_SB
#undef PG8_STAGE
#undef PG8_LDA
#undef PG8_LDB
#undef PG8_MMA
#undef PG8_WAIT_V
#undef PG8_WAIT_L
#undef PG8_BAR
#undef PG8_SCHED
}
}

#define DI __device__ __forceinline__
#define LAS __attribute__((address_space(3)))
typedef unsigned short bf16_t;
typedef short bf16x8 __attribute__((ext_vector_type(8)));
typedef short s16x4 __attribute__((ext_vector_type(4)));
typedef float f32x4 __attribute__((ext_vector_type(4)));
typedef unsigned u32x4 __attribute__((ext_vector_type(4)));
typedef unsigned u32x2 __attribute__((ext_vector_type(2)));

constexpr int DM = 1024, MP = 16384, MS = 512, MT = MP + MS;
constexpr int NPC = 256, NCH = 264;
constexpr float EPS = 1e-6f, LOG2E = 1.4426950408889634f;
constexpr int NWIN_T = 37;
constexpr int NTHREADS = 512;
constexpr int LDS_BYTES = 147456;

constexpr size_t MiB = 1u << 20;
constexpr size_t SLOT = 33 * MiB;
constexpr size_t WS_MSH = 65536;
constexpr size_t WS_SQ1 = 1 * MiB, WS_SQ2 = 5 * MiB / 2, WS_RA = 4 * MiB, WS_DC = 6 * MiB, WS_WSM = 7 * MiB, WSM_LAYER = 17 * MiB / 2;
constexpr size_t WS_WIN = 24 * MiB, WS_PB = 43 * MiB, WS_XB = 60 * MiB, WS_OV = 93 * MiB, WS_AX = WS_OV + 5 * SLOT, WS_END = WS_AX + 6 * MiB;
constexpr size_t O_Y = 0, O_SP = 17301504, O_KP = 18350080, O_VP = 22544384, O_SS = 26738688, O_KS = 28835840, O_VS = 37224448;


typedef const __attribute__((address_space(4))) unsigned char* kargp_t;
DI kargp_t kbase() { kargp_t k = (kargp_t)__builtin_amdgcn_kernarg_segment_ptr(); asm volatile("" : "+s"(k)); return k; }
DI const float* kin(int i) { return *(const float* const __attribute__((address_space(4)))*)(kbase() + 8 * i); }
DI float* kout() { return *(float* const __attribute__((address_space(4)))*)(kbase() + 168); }
DI unsigned char* kws() { return *(unsigned char* const __attribute__((address_space(4)))*)(kbase() + 176); }
DI int kph_lo() { return *(const __attribute__((address_space(4))) int*)(kbase() + 184); }
DI int kph_hi() { return *(const __attribute__((address_space(4))) int*)(kbase() + 188); }
DI int otid() { int t = threadIdx.x; asm volatile("" : "+v"(t)); return t; }
DI float bflo(unsigned w) { return __uint_as_float(w << 16); }
DI float bfhi(unsigned w) { return __uint_as_float(w & 0xffff0000u); }
DI float bf2f(bf16_t b) { return __uint_as_float(((unsigned)b) << 16); }
typedef float f32x2_t __attribute__((ext_vector_type(2))); typedef __bf16 bf16x2_t __attribute__((ext_vector_type(2)));
DI unsigned pk2(float lo, float hi) { f32x2_t v = {lo, hi}; bf16x2_t r = __builtin_convertvector(v, bf16x2_t); return __builtin_bit_cast(unsigned, r); }
DI float sigm(float x) { return __builtin_amdgcn_rcpf(1.f + __expf(-x)); }
DI float silu(float x) { return x * sigm(x); }
DI float row_rstd(const float* sq, int row) {
    const f32x4* p = (const f32x4*)(sq + (size_t)row * 16); const f32x4 a = p[0], b = p[1], c = p[2], d = p[3];
    const float s = (((a.x + a.y) + (a.z + a.w)) + ((b.x + b.y) + (b.z + b.w))) + (((c.x + c.y) + (c.z + c.w)) + ((d.x + d.y) + (d.z + d.w)));
    return rsqrtf(s * (1.f / 1024.f) + EPS);
}
DI u32x4 pack8(const float* v) { u32x4 w; w.x = pk2(v[0], v[1]); w.y = pk2(v[2], v[3]); w.z = pk2(v[4], v[5]); w.w = pk2(v[6], v[7]); return w; }
DI void unpack8(u32x4 w, float* v) { v[0] = bflo(w.x); v[1] = bfhi(w.x); v[2] = bflo(w.y); v[3] = bfhi(w.y); v[4] = bflo(w.z); v[5] = bfhi(w.z); v[6] = bflo(w.w); v[7] = bfhi(w.w); }

enum { T_QA = 0, T_KA, T_VA, T_GA, T_RA, T_QB, T_KB, T_VB, T_GB, T_MGA, T_MGB };
struct EpiIn {
    static constexpr bool PERM = false, AFTER_DRAIN = false;
    int tile0, L; unsigned char* ws; float* out; const float *qg, *kg;
    template <int TYPE> DI void run(const pg8::f32x4 (&acc)[2][2][4][2], int pm, int tcol, int wr, int wc, int fr, int fq) const {
        constexpr size_t doff = TYPE == T_QA ? WS_OV + 2 * SLOT : TYPE == T_KA ? WS_OV + 2 * SLOT + (size_t)MT * 1024 : TYPE == T_VA ? WS_OV + SLOT : TYPE == T_GA ? WS_OV : TYPE == T_QB ? WS_OV + SLOT : TYPE == T_KB ? WS_OV + 2 * SLOT
                              : TYPE == T_VB ? WS_OV + 3 * SLOT : TYPE == T_GB ? WS_OV + 4 * SLOT : TYPE == T_MGA ? WS_OV + SLOT : WS_OV + 2 * SLOT;
        constexpr bool ANX = TYPE == T_QB || TYPE == T_KB || TYPE == T_VB || TYPE == T_GB || TYPE == T_MGA || TYPE == T_MGB;
        constexpr size_t aoff = WS_AX + (TYPE == T_QB ? 0 : TYPE == T_KB ? 1 : TYPE == T_VB ? 2 : TYPE == T_GB ? 3 : TYPE == T_MGA ? 4 : 5) * MiB;
        const bool srow = ANX && pm >= MP / 256;
        bf16_t* dst = (bf16_t*)(ws + (srow ? aoff : doff)); const int rsub = srow ? MP : 0; const float* sq = (const float*)(ws + WS_SQ2); float* RA = (float*)(ws + WS_RA);
        float* okp = out + (TYPE == T_KB ? O_KP : O_VP) + (size_t)L * 4 * 512 * 1024; float* oks = out + (TYPE == T_KB ? O_KS : O_VS) + (size_t)L * 8 * 512 * 1024;
        const int ld = (TYPE == T_QA || TYPE == T_KA) ? 512 : 1024;
        float gq[2][8];
        if (TYPE == T_QB || TYPE == T_KB) {
            const float* g = TYPE == T_QB ? qg : kg;
#pragma unroll
            for (int bj = 0; bj < 2; ++bj)
#pragma unroll
                for (int k = 0; k < 8; ++k) gq[bj][k] = g[32 * bj + 8 * fq + k] * (TYPE == T_QB ? 0.125f * LOG2E : 1.f);
        }
#pragma unroll
        for (int ai = 0; ai < 2; ++ai)
#pragma unroll
            for (int m = 0; m < 4; ++m) {
                const int row = pm * 256 + ai * 128 + wr * 64 + m * 16 + fr;
                const float rs = row_rstd(sq, row);
                float v[2][8];
#pragma unroll
                for (int bj = 0; bj < 2; ++bj)
#pragma unroll
                    for (int n = 0; n < 2; ++n)
#pragma unroll
                        for (int e = 0; e < 4; ++e) v[bj][4 * n + e] = acc[ai][bj][m][n][e] * rs;
                if (TYPE == T_RA) {
                    if (wc == 0 && fq < 2) { float* p = RA + (size_t)row * 16 + 8 * fq; *(f32x4*)p = (f32x4){v[0][0], v[0][1], v[0][2], v[0][3]}; *(f32x4*)(p + 4) = (f32x4){v[0][4], v[0][5], v[0][6], v[0][7]}; }
                    continue;
                }
                if (TYPE == T_QB || TYPE == T_KB) {
                    float ss = 0.f;
#pragma unroll
                    for (int bj = 0; bj < 2; ++bj)
#pragma unroll
                        for (int k = 0; k < 8; ++k) ss += v[bj][k] * v[bj][k];
                    ss += __shfl_xor(ss, 16); ss += __shfl_xor(ss, 32);
                    const float r = rsqrtf(ss * (1.f / 64.f) + EPS);
#pragma unroll
                    for (int bj = 0; bj < 2; ++bj)
#pragma unroll
                        for (int k = 0; k < 8; ++k) v[bj][k] *= r * gq[bj][k];
                }
                float* bo = nullptr;
                if (TYPE == T_KB || TYPE == T_VB) {
                    if (row < MP) { const int t = row & 4095; if (t >= 3584) bo = okp + ((size_t)(row >> 12) * 512 + (t - 3584)) * 1024; }
                    else { const int rr = row - MP; bo = oks + ((size_t)(rr >> 6) * 512 + 448 + (rr & 63)) * 1024; }
                }
#pragma unroll
                for (int bj = 0; bj < 2; ++bj) {
                    const int col = tcol * 256 + 64 * wc + 32 * bj + 8 * fq;
                    if (TYPE == T_QA) {
#pragma unroll
                        for (int k = 0; k < 8; ++k) v[bj][k] *= 0.08838834764831845f;
                    }
                    if (TYPE == T_GA || TYPE == T_GB) {
#pragma unroll
                        for (int k = 0; k < 8; ++k) v[bj][k] = silu(v[bj][k]);
                    }
                    if (TYPE == T_MGA || TYPE == T_MGB) {
#pragma unroll
                        for (int k = 0; k < 8; ++k) v[bj][k] = sigm(v[bj][k]);
                    }
                    if ((TYPE == T_KB || TYPE == T_VB) && bo) { *(f32x4*)(bo + col) = (f32x4){v[bj][0], v[bj][1], v[bj][2], v[bj][3]}; *(f32x4*)(bo + col + 4) = (f32x4){v[bj][4], v[bj][5], v[bj][6], v[bj][7]}; }
                    if (TYPE == T_VA) {
                        bf16_t* p = dst + ((size_t)((row >> 6) * 4 + tcol) * 256 + 64 * wc + 32 * bj + 8 * fq) * 64 + (row & 63);
#pragma unroll
                        for (int k = 0; k < 8; k += 2) { const unsigned w = pk2(v[bj][k], v[bj][k + 1]); p[k * 64] = (bf16_t)w; p[(k + 1) * 64] = (bf16_t)(w >> 16); }
                    } else if (TYPE == T_VB) {
                        bf16_t* p = dst + ((size_t)(((row - rsub) >> 6) * 16 + tcol * 4 + wc) * 64 + 32 * bj + 8 * fq) * 64 + (row & 63);
#pragma unroll
                        for (int k = 0; k < 8; k += 2) { const unsigned w = pk2(v[bj][k], v[bj][k + 1]); p[k * 64] = (bf16_t)w; p[(k + 1) * 64] = (bf16_t)(w >> 16); }
                    } else
                    *(u32x4*)(dst + (size_t)(row - rsub) * ld + col) = pack8(v[bj]);
                }
                asm volatile("" ::: "memory");
            }
    }
    DI void operator()(const pg8::f32x4 (&acc)[2][2][4][2], const pg8::Unit& u, int wr, int wc, int fr, int fq) const {
        asm volatile("" : "+v"(fr), "+v"(fq));
        const int gt = tile0 + u.pn;
        if (gt < 2) run<T_QA>(acc, u.pm, gt, wr, wc, fr, fq);
        else if (gt < 4) run<T_KA>(acc, u.pm, gt - 2, wr, wc, fr, fq);
        else if (gt < 8) run<T_VA>(acc, u.pm, gt - 4, wr, wc, fr, fq);
        else if (gt < 12) run<T_GA>(acc, u.pm, gt - 8, wr, wc, fr, fq);
        else if (gt == 12) run<T_RA>(acc, u.pm, 0, wr, wc, fr, fq);
        else if (gt < 17) run<T_QB>(acc, u.pm, gt - 13, wr, wc, fr, fq);
        else if (gt < 21) run<T_KB>(acc, u.pm, gt - 17, wr, wc, fr, fq);
        else if (gt < 25) run<T_VB>(acc, u.pm, gt - 21, wr, wc, fr, fq);
        else if (gt < 29) run<T_GB>(acc, u.pm, gt - 25, wr, wc, fr, fq);
        else if (gt < 33) run<T_MGA>(acc, u.pm, gt - 29, wr, wc, fr, fq);
        else run<T_MGB>(acc, u.pm, gt - 33, wr, wc, fr, fq);
    }
};
#define EPI_ROWS_BEGIN _Pragma("unroll") for (int ai = 0; ai < 2; ++ai) _Pragma("unroll") for (int m = 0; m < 4; ++m) { asm volatile("" ::: "memory"); const int row = u.pm * 256 + ai * 128 + wr * 64 + m * 16 + fr;
#define EPI_COLS_BEGIN _Pragma("unroll") for (int bj = 0; bj < 2; ++bj) { const int col = u.pn * 256 + 64 * wc + 32 * bj + 8 * fq; float v[8]; \
    _Pragma("unroll") for (int n = 0; n < 2; ++n) _Pragma("unroll") for (int e = 0; e < 4; ++e) v[4 * n + e] = acc[ai][bj][m][n][e];
struct EpiYA {
    static constexpr bool PERM = false, AFTER_DRAIN = false; bf16_t* G; int dry; bf16_t* Gs;
    DI void operator()(const pg8::f32x4 (&acc)[2][2][4][2], const pg8::Unit& u, int wr, int wc, int fr, int fq) const {
        asm volatile("" : "+v"(fr), "+v"(fq));
        EPI_ROWS_BEGIN EPI_COLS_BEGIN
            bf16_t* p = G + (size_t)row * 1024 + col; float g[8]; unpack8(*(const u32x4*)p, g);
#pragma unroll
            for (int k = 0; k < 8; ++k) v[k] *= g[k];
            if (!dry) *(u32x4*)p = pack8(v);
        } }
    }
    DI void mini(int row, int col, f32x4 s) const {
        bf16_t* p = Gs + (size_t)(row - MP) * 1024 + col; const u32x2 g = *(const u32x2*)p;
        u32x2 w; w.x = pk2(s.x * bflo(g.x), s.y * bfhi(g.x)); w.y = pk2(s.z * bflo(g.y), s.w * bfhi(g.y)); if (!dry) *(u32x2*)p = w;
    }
};
struct EpiYB {
    static constexpr bool PERM = false, AFTER_DRAIN = false; const bf16_t* YA; bf16_t* G; int dry; const bf16_t* YAs; bf16_t* Gs;
    DI void operator()(const pg8::f32x4 (&acc)[2][2][4][2], const pg8::Unit& u, int wr, int wc, int fr, int fq) const {
        asm volatile("" : "+v"(fr), "+v"(fq));
        EPI_ROWS_BEGIN EPI_COLS_BEGIN
            bf16_t* p = G + (size_t)row * 1024 + col; float g[8], ya[8]; unpack8(*(const u32x4*)p, g); unpack8(*(const u32x4*)(YA + (size_t)row * 1024 + col), ya);
#pragma unroll
            for (int k = 0; k < 8; ++k) v[k] = ya[k] + v[k] * g[k];
            if (!dry) *(u32x4*)p = pack8(v);
        } }
    }
    DI void mini(int row, int col, f32x4 s) const {
        bf16_t* p = Gs + (size_t)(row - MP) * 1024 + col; const u32x2 g = *(const u32x2*)p, y = *(const u32x2*)(YAs + (size_t)(row - MP) * 1024 + col);
        u32x2 w; w.x = pk2(bflo(y.x) + s.x * bflo(g.x), bfhi(y.x) + s.y * bfhi(g.x)); w.y = pk2(bflo(y.y) + s.z * bflo(g.y), bfhi(y.y) + s.w * bfhi(g.y)); if (!dry) *(u32x2*)p = w;
    }
};
struct EpiOut {
    static constexpr bool PERM = false, AFTER_DRAIN = false; const float* xp; const float* xs; float* out; bf16_t* xb; float* sq; int dry;
    DI void operator()(const pg8::f32x4 (&acc)[2][2][4][2], const pg8::Unit& u, int wr, int wc, int fr, int fq) const {
        asm volatile("" : "+v"(fr), "+v"(fq));
        EPI_ROWS_BEGIN
            const float* base = row < MP ? xp + (size_t)row * 1024 : xs + (size_t)(row - MP) * 1024; float ss = 0.f;
            EPI_COLS_BEGIN
                const f32x4 b0 = *(const f32x4*)(base + col), b1 = *(const f32x4*)(base + col + 4);
                v[0] += b0.x; v[1] += b0.y; v[2] += b0.z; v[3] += b0.w; v[4] += b1.x; v[5] += b1.y; v[6] += b1.z; v[7] += b1.w;
#pragma unroll
                for (int k = 0; k < 8; ++k) ss += v[k] * v[k];
                if (!dry) { float* o = out + (size_t)row * 1024 + col; *(f32x4*)o = (f32x4){v[0], v[1], v[2], v[3]}; *(f32x4*)(o + 4) = (f32x4){v[4], v[5], v[6], v[7]};
                *(u32x4*)(xb + (size_t)row * 1024 + col) = pack8(v); }
            }
            ss += __shfl_xor(ss, 16); ss += __shfl_xor(ss, 32);
            if (fq == 0 && !dry) sq[(size_t)row * 16 + 4 * u.pn + wc] = ss;
        }
    }
    DI void mini(int row, int col, f32x4 s) const {
        const float* base = row < MP ? xp + (size_t)row * 1024 : xs + (size_t)(row - MP) * 1024; const f32x4 b0 = *(const f32x4*)(base + col);
        const f32x4 x = s + b0; float ss = (x.x * x.x + x.y * x.y) + (x.z * x.z + x.w * x.w);
        ss += __shfl_xor(ss, 1); ss += __shfl_xor(ss, 2); ss += __shfl_xor(ss, 4); ss += __shfl_xor(ss, 8);
        if (!dry) { *(f32x4*)(out + (size_t)row * 1024 + col) = x; u32x2 w; w.x = pk2(x.x, x.y); w.y = pk2(x.z, x.w); *(u32x2*)(xb + (size_t)row * 1024 + col) = w;
            if ((col & 63) == 0) sq[(size_t)row * 16 + (col >> 6)] = ss; }
    }
};
struct EpiP {
    static constexpr bool PERM = false, AFTER_DRAIN = false; float* PT; int dry;
    DI void operator()(const pg8::f32x4 (&acc)[2][2][4][2], const pg8::Unit& u, int wr, int wc, int fr, int fq) const {
        asm volatile("" : "+v"(fr), "+v"(fq));
        EPI_ROWS_BEGIN EPI_COLS_BEGIN
            if (!dry) { float* o = PT + (size_t)row * 1024 + col; *(f32x4*)o = (f32x4){v[0], v[1], v[2], v[3]}; *(f32x4*)(o + 4) = (f32x4){v[4], v[5], v[6], v[7]}; }
        } }
    }
    DI void mini(int row, int col, f32x4 s) const { if (!dry) *(f32x4*)(PT + (size_t)row * 1024 + col) = s; }
};
struct EpiGate {
    static constexpr bool PERM = false, AFTER_DRAIN = false; const float* sq1; const float* PT; float* out; bf16_t* xb; float* sq2; int dry;
    DI void operator()(const pg8::f32x4 (&acc)[2][2][4][2], const pg8::Unit& u, int wr, int wc, int fr, int fq) const {
        asm volatile("" : "+v"(fr), "+v"(fq));
        EPI_ROWS_BEGIN
            const float rs = row_rstd(sq1, row); float ss = 0.f;
            EPI_COLS_BEGIN
                float* o = out + (size_t)row * 1024 + col; const float* pt = PT + (size_t)row * 1024 + col;
                const f32x4 b0 = *(const f32x4*)o, b1 = *(const f32x4*)(o + 4), p0 = *(const f32x4*)pt, p1 = *(const f32x4*)(pt + 4);
                const float xb_[8] = {b0.x, b0.y, b0.z, b0.w, b1.x, b1.y, b1.z, b1.w}, pp[8] = {p0.x, p0.y, p0.z, p0.w, p1.x, p1.y, p1.z, p1.w};
#pragma unroll
                for (int k = 0; k < 8; ++k) { v[k] = xb_[k] + sigm(v[k] * rs) * pp[k]; ss += v[k] * v[k]; }
                if (!dry) { *(f32x4*)o = (f32x4){v[0], v[1], v[2], v[3]}; *(f32x4*)(o + 4) = (f32x4){v[4], v[5], v[6], v[7]};
                *(u32x4*)(xb + (size_t)row * 1024 + col) = pack8(v); }
            }
            ss += __shfl_xor(ss, 16); ss += __shfl_xor(ss, 32);
            if (fq == 0 && !dry) sq2[(size_t)row * 16 + 4 * u.pn + wc] = ss;
        }
    }
    DI void mini(int row, int col, f32x4 s) const {
        const float rs = row_rstd(sq1, row); float* o = out + (size_t)row * 1024 + col; const f32x4 b0 = *(const f32x4*)o, p0 = *(const f32x4*)(PT + (size_t)row * 1024 + col);
        f32x4 x; x.x = b0.x + sigm(s.x * rs) * p0.x; x.y = b0.y + sigm(s.y * rs) * p0.y; x.z = b0.z + sigm(s.z * rs) * p0.z; x.w = b0.w + sigm(s.w * rs) * p0.w;
        float ss = (x.x * x.x + x.y * x.y) + (x.z * x.z + x.w * x.w);
        ss += __shfl_xor(ss, 1); ss += __shfl_xor(ss, 2); ss += __shfl_xor(ss, 4); ss += __shfl_xor(ss, 8);
        if (!dry) { *(f32x4*)o = x; u32x2 w; w.x = pk2(x.x, x.y); w.y = pk2(x.z, x.w); *(u32x2*)(xb + (size_t)row * 1024 + col) = w;
            if ((col & 63) == 0) sq2[(size_t)row * 16 + (col >> 6)] = ss; }
    }
};

struct OrderG {
    pg8::StaticOrder S; int G, c;
    DI void init(int G_, int c_) { S.init(MP, 13 * 256, G_, c_); G = G_; c = c_; }
    DI bool next(int i, pg8::Unit& u) const { if (S.next(i, u)) return true; const long s = (long)i * G + c - 64 * 13; if (s >= 2 * NWIN_T) return false; u.pm = 64 + (int)(s / NWIN_T); u.pn = (int)(s % NWIN_T); return true; }
    DI void a_ready(const pg8::Unit&) const {}
    DI void done(const pg8::Unit&) const {}
};
struct OrderM {
    pg8::StaticOrder S;
    DI void init(int G_, int c_) { S.init(MP, 1024, G_, c_); }
    DI bool next(int i, pg8::Unit& u) const { pg8::Unit v; if (!S.next(i >> 1, v)) return false; u.pm = v.pm; u.pn = 4 * (i & 1) + v.pn; return true; }
    DI void a_ready(const pg8::Unit&) const {}
    DI void done(const pg8::Unit&) const {}
};
template <class Epi> DI void run_gemm_m(LAS unsigned char* lds, const bf16_t* A, const bf16_t* Bt, const Epi& E) {
    int K = 1024; asm volatile("" : "+s"(K));
    pg8::Gemm g{A, Bt, MP, 8 * 256, K}; OrderM S; S.init((int)gridDim.x, (int)blockIdx.x);
    pg8::gemm_phase<Epi, OrderM, true, true>(lds, g, S, E);
}
template <class Epi> DI void run_gemm_g(LAS unsigned char* lds, const bf16_t* A, const bf16_t* Bt, const Epi& E) {
    int K = 1024; asm volatile("" : "+s"(K));
    pg8::Gemm g{A, Bt, MT, NWIN_T * 256, K}; OrderG S; S.init((int)gridDim.x, (int)blockIdx.x);
    pg8::gemm_phase<Epi, OrderG, true, true>(lds, g, S, E);
}
template <class Epi> DI void run_gemm(LAS unsigned char* lds, const bf16_t* A, const bf16_t* Bt, int M, int N, int K, const Epi& E) {
    asm volatile("" : "+s"(K), "+s"(N));
    pg8::Gemm g{A, Bt, M, N, K}; pg8::StaticOrder S; S.init(M, N, (int)gridDim.x, (int)blockIdx.x);
    pg8::gemm_phase<Epi, pg8::StaticOrder, true, true>(lds, g, S, E);
}

template <int K, class Epi> DI void mini_gemm(LAS unsigned char* lds, const bf16_t* A, const bf16_t* Wt, const Epi& E) {
    const int tid = otid(), lane = tid & 63, wave = __builtin_amdgcn_readfirstlane(tid >> 6), r = lane & 15, q = lane >> 4;
    constexpr int KW = K / 8;
    for (int mt = blockIdx.x; mt < 256; mt += gridDim.x) {
        const int row0 = 32 * (mt >> 4), cb = mt & 15, tile = cb >> 2, wcp = cb & 3, k0 = wave * KW;
        f32x4 acc[4][2];
#pragma unroll
        for (int ct = 0; ct < 4; ++ct) { acc[ct][0] = (f32x4){0.f, 0.f, 0.f, 0.f}; acc[ct][1] = (f32x4){0.f, 0.f, 0.f, 0.f}; }
#pragma unroll
        for (int ks = 0; ks < KW / 32; ++ks) {
            bf16x8 af[2], wf[4];
#pragma unroll
            for (int rt = 0; rt < 2; ++rt) af[rt] = *(const bf16x8*)(A + (size_t)(row0 + 16 * rt + r) * K + k0 + 32 * ks + 8 * q);
#pragma unroll
            for (int ct = 0; ct < 4; ++ct) { const int x = 16 * ct + r, p = 128 * (x >> 5) + 32 * wcp + 16 * ((x >> 2) & 1) + 4 * ((x >> 3) & 3) + (x & 3);
                wf[ct] = *(const bf16x8*)(Wt + (size_t)(tile * 256 + p) * K + k0 + 32 * ks + 8 * q); }
#pragma unroll
            for (int ct = 0; ct < 4; ++ct)
#pragma unroll
                for (int rt = 0; rt < 2; ++rt) acc[ct][rt] = __builtin_amdgcn_mfma_f32_16x16x32_bf16(wf[ct], af[rt], acc[ct][rt], 0, 0, 0);
        }
        LAS float* part = (LAS float*)lds + wave * (32 * 68);
#pragma unroll
        for (int ct = 0; ct < 4; ++ct)
#pragma unroll
            for (int rt = 0; rt < 2; ++rt) *(LAS f32x4*)(part + (16 * rt + r) * 68 + 16 * ct + 4 * q) = acc[ct][rt];
        __syncthreads();
        { const int row = tid >> 4, c4 = (tid & 15) * 4; f32x4 s = (f32x4){0.f, 0.f, 0.f, 0.f};
#pragma unroll
          for (int w = 0; w < 8; ++w) s += *(const LAS f32x4*)((const LAS float*)lds + w * (32 * 68) + row * 68 + c4);
          E.mini(MP + row0 + row, 64 * cb + c4, s); }
        __syncthreads();
    }
}

struct Args { const float* in[21]; float* out; unsigned char* ws; int ph_lo, ph_hi; };
static_assert(sizeof(Args) == 192, "Args layout (kin/kout/kws offsets)");
enum { I_XP = 0, I_XS, I_STATE, I_CK, I_CV, I_PP, I_PS, I_NORMG, I_WIN, I_WGU, I_BG, I_GLAG, I_QG, I_KG, I_RELB, I_WA, I_WB, I_WO, I_PLEG, I_WPG, I_WPLE };

DI void transpose_item(const float* W, int ldw, int srccol0, int nvalid, const float* gain, bf16_t* WT, int K, int rowbase, int k0, LAS float* scr, int lane) {
#pragma unroll 16
    for (int i = 0; i < 32; ++i) { const int kk = 2 * i + (lane >> 5), c = lane & 31;
        float w = 0.f; if (c < nvalid) w = W[(size_t)(k0 + kk) * ldw + srccol0 + c]; if (gain) w *= gain[k0 + kk];
        scr[kk * 33 + c] = w; }
    asm volatile("s_waitcnt lgkmcnt(0)" ::: "memory");
    const int c8 = lane & 7;
#pragma unroll
    for (int j = 0; j < 4; ++j) { const int n = (lane >> 3) + 8 * j; const LAS float* s = scr + (8 * c8) * 33 + n;
        u32x4 o; o.x = pk2(s[0 * 33], s[1 * 33]); o.y = pk2(s[2 * 33], s[3 * 33]); o.z = pk2(s[4 * 33], s[5 * 33]); o.w = pk2(s[6 * 33], s[7 * 33]);
        const int prow = 16 * ((n >> 2) & 1) + 4 * (n >> 3) + (n & 3);
        *(u32x4*)(WT + (size_t)(rowbase + prow) * K + k0 + 8 * c8) = o; }
    asm volatile("s_waitcnt lgkmcnt(0)" ::: "memory");
}
DI int win_src(int t, int& nvalid) {
    nvalid = 256;
    if (t < 2) return t * 256; if (t < 4) return 512 + (t - 2) * 256; if (t < 8) return 1024 + (t - 4) * 256; if (t < 12) return 2064 + (t - 8) * 256;
    if (t == 12) { nvalid = 16; return 2048; }
    if (t < 17) return 3088 + (t - 13) * 256; if (t < 21) return 4112 + (t - 17) * 256; if (t < 25) return 5136 + (t - 21) * 256; if (t < 29) return 6160 + (t - 25) * 256;
    if (t < 33) return 7184 + (t - 29) * 256; return 8208 + (t - 33) * 256;
}
DI void transpose_generic(const float* W, int ldw, int K, int ntile, bool is_win, const float* gain, bf16_t* WT, int item, LAS float* scr, int lane) {
    const int nkb = K / 64; const int kb = item % nkb, nb = (item / nkb) & 7, t = item / (nkb * 8);
    int nvalid = 256, src = t * 256; if (is_win) src = win_src(t, nvalid);
    int nv = nvalid - 32 * nb; nv = nv < 0 ? 0 : (nv > 32 ? 32 : nv);
    transpose_item(W, ldw, src + 32 * nb, nv, gain, WT, K, t * 256 + 128 * (nb & 1) + 32 * (nb >> 1), kb * 64, scr, lane);
}
constexpr int WIN_ITEMS = NWIN_T * 8 * 16, SQ_ITEMS = 4 * 8 * 16, PLE_ITEMS = 4 * 8 * 4;
constexpr int N_IN = 9232;
DI void prep_win(const Args& a, int L, int gw, int ngw, LAS float* scr, int lane) {
    bf16_t* WT = (bf16_t*)(kws() + WS_WIN);
    for (int it = gw; it < WIN_ITEMS; it += ngw) transpose_generic(kin(I_WIN) + (size_t)L * 1024 * N_IN, N_IN, 1024, NWIN_T, true, kin(I_NORMG) + L * 1024, WT, it, scr, lane);
}
DI bf16_t* wsm(const Args& a, int L, int which) { return (bf16_t*)(kws() + WS_WSM + (size_t)L * WSM_LAYER + (size_t)which * 2 * MiB); }
DI void prep_small(const Args& a, int gw, int ngw, LAS float* scr, int lane) {
    constexpr int PER_L = 4 * SQ_ITEMS + PLE_ITEMS;
    for (int it = gw; it < 2 * PER_L; it += ngw) {
        const int L = it / PER_L; int r = it % PER_L;
        if (r < SQ_ITEMS) { transpose_generic(kin(I_WA) + (size_t)L * 1048576, 1024, 1024, 4, false, nullptr, wsm(a, L, 0), r, scr, lane); continue; } r -= SQ_ITEMS;
        if (r < SQ_ITEMS) { transpose_generic(kin(I_WB) + (size_t)L * 1048576, 1024, 1024, 4, false, nullptr, wsm(a, L, 1), r, scr, lane); continue; } r -= SQ_ITEMS;
        if (r < SQ_ITEMS) { transpose_generic(kin(I_WO) + (size_t)L * 1048576, 1024, 1024, 4, false, nullptr, wsm(a, L, 2), r, scr, lane); continue; } r -= SQ_ITEMS;
        if (r < SQ_ITEMS) { transpose_generic(kin(I_WPG) + (size_t)L * 1048576, 1024, 1024, 4, false, kin(I_PLEG) + L * 1024, wsm(a, L, 3), r, scr, lane); continue; } r -= SQ_ITEMS;
        transpose_generic(kin(I_WPLE) + (size_t)L * 262144, 1024, 256, 4, false, nullptr, wsm(a, L, 4), r, scr, lane);
    }
}
DI float wave_sum(float v) {
#pragma unroll
    for (int o = 1; o < 64; o <<= 1) v += __shfl_xor(v, o);
    return v;
}
DI void prep_shift(int gw, int lane) {
    if (gw < 32) { const int L = gw >> 4, h = gw & 15;
        float mq = fabsf(kin(I_QG)[L * 64 + lane]), mk = fabsf(kin(I_KG)[L * 64 + lane]), mb = 0.f;
        for (int i = lane; i < 257; i += 64) mb = fmaxf(mb, fabsf(kin(I_RELB)[((size_t)L * 16 + h) * 257 + i]));
#pragma unroll
        for (int o = 1; o < 64; o <<= 1) { mq = fmaxf(mq, __shfl_xor(mq, o)); mk = fmaxf(mk, __shfl_xor(mk, o)); mb = fmaxf(mb, __shfl_xor(mb, o)); }
        if (lane == 0) ((float*)(kws() + WS_MSH))[gw] = (8.f * mq * mk + mb) * LOG2E; }
}
DI void prep_rows(const Args& a, int gw, int ngw, int lane) {
    bf16_t* XB = (bf16_t*)(kws() + WS_XB); float* SQ2 = (float*)(kws() + WS_SQ2);
    const float* xp = kin(I_XP); const float* xs = kin(I_XS);
    for (int row0 = gw; row0 < MT; row0 += 4 * ngw) {
        f32x4 v[4][4];
#pragma unroll
        for (int u = 0; u < 4; ++u) { const int row = row0 + u * ngw; if (row < MT) { const float* x = row < MP ? xp + (size_t)row * 1024 : xs + (size_t)(row - MP) * 1024;
#pragma unroll
            for (int j = 0; j < 4; ++j) v[u][j] = ((const f32x4*)x)[lane + 64 * j]; } }
#pragma unroll
        for (int u = 0; u < 4; ++u) { const int row = row0 + u * ngw; if (row < MT) { float s = 0.f;
#pragma unroll
            for (int j = 0; j < 4; ++j) s += (v[u][j].x * v[u][j].x + v[u][j].y * v[u][j].y) + (v[u][j].z * v[u][j].z + v[u][j].w * v[u][j].w);
            s = wave_sum(s);
            if (lane < 16) SQ2[(size_t)row * 16 + lane] = lane == 0 ? s : 0.f;
#pragma unroll
            for (int j = 0; j < 4; ++j) { u32x2 w; w.x = pk2(v[u][j].x, v[u][j].y); w.y = pk2(v[u][j].z, v[u][j].w); ((u32x2*)(XB + (size_t)row * 1024))[lane + 64 * j] = w; } } }
    }
}
DI void prep_misc(const Args& a, int gtid, int ngt) {
    bf16_t* PB = (bf16_t*)(kws() + WS_PB);
    const float* pp = kin(I_PP); const float* ps = kin(I_PS);
    for (int i0 = gtid; i0 < 2 * MT * 32; i0 += 4 * ngt) {
        f32x4 p0[4], p1[4];
#pragma unroll
        for (int k = 0; k < 4; ++k) { const int i = i0 + k * ngt; if (i < 2 * MT * 32) { const int c8 = i & 31, row = (i >> 5) % MT, L = (i >> 5) / MT;
            const float* src = row < MP ? pp + ((size_t)L * MP + row) * 256 + c8 * 8 : ps + ((size_t)L * MS + (row - MP)) * 256 + c8 * 8; p0[k] = *(const f32x4*)src; p1[k] = *(const f32x4*)(src + 4); } }
#pragma unroll
        for (int k = 0; k < 4; ++k) { const int i = i0 + k * ngt; if (i < 2 * MT * 32) { const int c8 = i & 31, row = (i >> 5) % MT, L = (i >> 5) / MT;
            u32x4 w; w.x = pk2(p0[k].x, p0[k].y); w.y = pk2(p0[k].z, p0[k].w); w.z = pk2(p1[k].x, p1[k].y); w.w = pk2(p1[k].z, p1[k].w);
            *(u32x4*)(PB + ((size_t)L * MT + row) * 256 + c8 * 8) = w; } }
    }
    constexpr int PER = 448 * 1024 / 4;
    const float* ck = kin(I_CK); const float* cv = kin(I_CV); float* out = kout();
    for (int i0 = gtid; i0 < 32 * PER; i0 += 8 * ngt) {
        f32x4 v[8];
#pragma unroll
        for (int k = 0; k < 8; ++k) { const int i = i0 + k * ngt; if (i < 32 * PER) { const int lb = i / PER, r = i % PER, kv = lb >> 4, l_b = lb & 15;
            v[k] = *((const f32x4*)((kv ? cv : ck) + (size_t)l_b * 512 * 1024 + 64 * 1024) + r); } }
#pragma unroll
        for (int k = 0; k < 8; ++k) { const int i = i0 + k * ngt; if (i < 32 * PER) { const int lb = i / PER, r = i % PER, kv = lb >> 4, l_b = lb & 15;
            *((f32x4*)(out + (kv ? O_VS : O_KS) + (size_t)l_b * 512 * 1024) + r) = v[k]; } }
    }
}

DI void gla_prep(const Args& a, int L, int c, int h, LAS float* totp, LAS float* ra_s, float (&b)[16], float& blast) {
    const int tid = otid(), d = tid & 127, jq = __builtin_amdgcn_readfirstlane(tid >> 7);
    if (tid < 256) *(LAS f32x4*)(ra_s + tid * 4) = *(const f32x4*)((const float*)(kws() + WS_RA) + (size_t)c * 64 * 16 + tid * 4);
    const float* wg = kin(I_WGU) + (size_t)L * 16 * 512 + h * 128 + d; float w[16];
#pragma unroll
    for (int r = 0; r < 16; ++r) w[r] = wg[r * 512];
    const float bg = kin(I_BG)[L * 512 + h * 128 + d];
    __syncthreads();
    float run = 0.f;
#pragma unroll
    for (int jj = 0; jj < 16; ++jj) {
        const LAS f32x4* rp = (const LAS f32x4*)(ra_s + (16 * jq + jj) * 16); const f32x4 r0 = rp[0], r1 = rp[1], r2 = rp[2], r3 = rp[3];
        float r = bg;
        r += r0.x * w[0]; r += r0.y * w[1]; r += r0.z * w[2]; r += r0.w * w[3]; r += r1.x * w[4]; r += r1.y * w[5]; r += r1.z * w[6]; r += r1.w * w[7];
        r += r2.x * w[8]; r += r2.y * w[9]; r += r2.z * w[10]; r += r2.w * w[11]; r += r3.x * w[12]; r += r3.y * w[13]; r += r3.z * w[14]; r += r3.w * w[15];
        const float lg = (fminf(r, 0.f) - __logf(1.f + __expf(-fabsf(r)))) * (1.f / 16.f);
        run += lg; b[jj] = run;
    }
    totp[jq * 128 + d] = run;
    __syncthreads();
    const float t0 = totp[d], t1 = totp[128 + d], t2 = totp[256 + d], t3 = totp[384 + d];
    const float off = jq == 0 ? 0.f : jq == 1 ? t0 : jq == 2 ? t0 + t1 : t0 + t1 + t2;
    blast = (t0 + t1) + (t2 + t3);
#pragma unroll
    for (int jj = 0; jj < 16; ++jj) b[jj] += off;
    if (jq == 0) totp[512 + d] = blast;
}
DI bf16x8 lds16(const LAS unsigned char* p) { return *(const LAS bf16x8*)p; }
DI s16x4 lds8(const LAS unsigned char* p) { return *(const LAS s16x4*)p; }
DI void vt_load(const bf16_t* VT, u32x4 (&vr)[4]) {
    const int tid = otid();
#pragma unroll
    for (int k = 0; k < 4; ++k) vr[k] = *(const u32x4*)(VT + (size_t)(tid + 512 * k) * 8);
}
DI void vt_store(const u32x4 (&vr)[4], LAS unsigned char* vt) {
    const int tid = otid();
#pragma unroll
    for (int k = 0; k < 4; ++k) { const int i = tid + 512 * k; *(LAS u32x4*)(vt + ((i >> 3) * 72 + (i & 7) * 8) * 2) = vr[k]; }
}
constexpr int GA_KT = 0, GA_VT = 18432, GA_TOT = 55296;
DI void gla_a_phase(const Args& a, int L, LAS unsigned char* lds, int item_lo, int item_hi, int first_wg) {
    const int tid = otid(), lane = tid & 63, wave = __builtin_amdgcn_readfirstlane(tid >> 6), r = lane & 15, q = lane >> 4;
    const bf16_t* KA = (const bf16_t*)(kws() + WS_OV + 2 * SLOT) + (size_t)MT * 512; const bf16_t* VA = (const bf16_t*)(kws() + WS_OV + 1 * SLOT);
    bf16_t* ST = (bf16_t*)(kws() + WS_OV + 3 * SLOT); float* DC = (float*)(kws() + WS_DC);
    LAS float* totp = (LAS float*)(lds + GA_TOT);
    int wg0_ = (int)blockIdx.x - first_wg; if (wg0_ < 0) wg0_ += (int)gridDim.x;
    for (int item = item_lo + wg0_; item < item_hi; item += gridDim.x) {
        const int c = item >> 2, h = item & 3;
        const int d = tid & 127, jq = tid >> 7;
        bf16_t kraw[16]; u32x4 vr[4];
#pragma unroll
        for (int jj = 0; jj < 16; ++jj) kraw[jj] = KA[((size_t)c * 64 + 16 * jq + jj) * 512 + h * 128 + d];
        vt_load(VA + (size_t)(c * 4 + h) * 16384, vr);
        float b[16], blast; gla_prep(a, L, c, h, totp, (LAS float*)(lds + GA_VT), b, blast);
        { float kd[16];
#pragma unroll
          for (int jj = 0; jj < 16; ++jj) kd[jj] = bf2f(kraw[jj]) * __expf(blast - b[jj]);
          LAS u32x4* o = (LAS u32x4*)(lds + GA_KT + (d * 72 + 16 * jq) * 2); o[0] = pack8(kd); o[1] = pack8(kd + 8); }
        if (jq == 0) DC[(size_t)item * 128 + d] = __expf(blast);
        vt_store(vr, lds + GA_VT);
        __syncthreads();
        f32x4 acc[8][2];
#pragma unroll
        for (int dt = 0; dt < 8; ++dt) { acc[dt][0] = (f32x4){0.f, 0.f, 0.f, 0.f}; acc[dt][1] = (f32x4){0.f, 0.f, 0.f, 0.f}; }
#pragma unroll
        for (int s = 0; s < 2; ++s) {
            bf16x8 bv[2];
#pragma unroll
            for (int vt = 0; vt < 2; ++vt) bv[vt] = lds16(lds + GA_VT + ((32 * wave + 16 * vt + r) * 72 + 32 * s + 8 * q) * 2);
#pragma unroll
            for (int dt = 0; dt < 8; ++dt) { const bf16x8 ak = lds16(lds + GA_KT + ((16 * dt + r) * 72 + 32 * s + 8 * q) * 2);
#pragma unroll
                for (int vt = 0; vt < 2; ++vt) acc[dt][vt] = __builtin_amdgcn_mfma_f32_16x16x32_bf16(ak, bv[vt], acc[dt][vt], 0, 0, 0); }
        }
        if (c < NPC) {
#pragma unroll
            for (int vt = 0; vt < 2; ++vt)
#pragma unroll
                for (int dt = 0; dt < 8; ++dt) { u32x2 w; w.x = pk2(acc[dt][vt][0], acc[dt][vt][1]); w.y = pk2(acc[dt][vt][2], acc[dt][vt][3]);
                    *(u32x2*)(ST + (size_t)item * 32768 + (32 * wave + 16 * vt + r) * 128 + 16 * dt + 4 * q) = w; }
        } else {
            const int bb = c - NPC; const size_t so = (((size_t)L * 8 + bb) * 4 + h) * 32768;
            const float* s0 = kin(I_STATE) + so; float* s1 = kout() + O_SS + so;
#pragma unroll
            for (int dt = 0; dt < 8; ++dt)
#pragma unroll
                for (int e = 0; e < 4; ++e) { const int dd = 16 * dt + 4 * q + e; const float dc = __expf(totp[512 + dd]);
#pragma unroll
                    for (int vt = 0; vt < 2; ++vt) { const int v = 32 * wave + 16 * vt + r; s1[dd * 256 + v] = dc * s0[dd * 256 + v] + acc[dt][vt][e]; } }
        }
        __syncthreads();
    }
}
DI void gla_scan_phase(const Args& a, int L, int dry) {
    bf16_t* ST = (bf16_t*)(kws() + WS_OV + 3 * SLOT); const float* DC = (const float*)(kws() + WS_DC);
    const int ngt = gridDim.x * NTHREADS;
    for (int gt = blockIdx.x * NTHREADS + otid(); gt < 16 * 8192; gt += ngt) {
        const int bh = gt >> 13, e4 = gt & 8191, bb = bh >> 2, h = bh & 3, d = (4 * e4) & 127, v = (4 * e4) >> 7;
        float run[4] = {0.f, 0.f, 0.f, 0.f};
        for (int n0 = 0; n0 < 64; n0 += 8) {
            u32x2 cur[8]; f32x4 dc[8];
#pragma unroll
            for (int k = 0; k < 8; ++k) { const size_t it = (size_t)(bb * 64 + n0 + k) * 4 + h; cur[k] = *(const u32x2*)(ST + it * 32768 + 4 * e4); dc[k] = *(const f32x4*)(DC + it * 128 + d); }
#pragma unroll
            for (int k = 0; k < 8; ++k) { const size_t it = (size_t)(bb * 64 + n0 + k) * 4 + h;
                u32x2 w; w.x = pk2(run[0], run[1]); w.y = pk2(run[2], run[3]); if (!dry || run[0] == 1.2345e30f) *(u32x2*)(ST + it * 32768 + 4 * e4) = w;
                run[0] = dc[k].x * run[0] + bflo(cur[k].x); run[1] = dc[k].y * run[1] + bfhi(cur[k].x); run[2] = dc[k].z * run[2] + bflo(cur[k].y); run[3] = dc[k].w * run[3] + bfhi(cur[k].y); }
        }
        float* o = kout() + O_SP + (((size_t)L * 4 + bb) * 4 + h) * 32768;
#pragma unroll
        for (int e = 0; e < 4; ++e) if (!dry || run[e] == 1.2345e30f) o[(d + e) * 256 + v] = run[e];
    }
}
constexpr int GC_QS = 0, GC_KS = 17408, GC_VT = 34816, GC_SS = 71680, GC_TOT = 141312, GC_RED = 143872;
DI void gla_c_phase(const Args& a, int L, LAS unsigned char* lds, int dry, int item_lo, int item_hi, int first_wg) {
    const int tid = otid(), lane = tid & 63, wave = __builtin_amdgcn_readfirstlane(tid >> 6), r = lane & 15, q = lane >> 4, it = wave & 3, vh = wave >> 2;
    const bf16_t* QA = (const bf16_t*)(kws() + WS_OV + 2 * SLOT); const bf16_t* KA = QA + (size_t)MT * 512; const bf16_t* VA = (const bf16_t*)(kws() + WS_OV + 1 * SLOT);
    bf16_t* SGA = (bf16_t*)(kws() + WS_OV); const bf16_t* ST = (const bf16_t*)(kws() + WS_OV + 3 * SLOT);
    LAS float* totp = (LAS float*)(lds + GC_TOT); LAS float* red = (LAS float*)(lds + GC_RED);
    const float* gg = kin(I_GLAG) + L * 256;
    int wg0_ = (int)blockIdx.x - first_wg; if (wg0_ < 0) wg0_ += (int)gridDim.x;
    for (int item = item_lo + wg0_; item < item_hi; item += gridDim.x) {
        const int c = item >> 2, h = item & 3;
        const int d = tid & 127, jq = tid >> 7;
        bf16_t qraw[16], kraw[16]; u32x4 vr[4], sr[8];
#pragma unroll
        for (int jj = 0; jj < 16; ++jj) { const size_t g = ((size_t)c * 64 + 16 * jq + jj) * 512 + h * 128 + d; qraw[jj] = QA[g]; kraw[jj] = KA[g]; }
        vt_load(VA + (size_t)(c * 4 + h) * 16384, vr);
        if (c < NPC) { const bf16_t* s = ST + (size_t)item * 32768;
#pragma unroll
            for (int k = 0; k < 8; ++k) sr[k] = *(const u32x4*)(s + (size_t)(tid + 512 * k) * 8); }
        float b[16], blast; gla_prep(a, L, c, h, totp, (LAS float*)(lds + GC_SS), b, blast);
#pragma unroll
        for (int jj = 0; jj < 16; ++jj) { const int j = 16 * jq + jj; const float eb = __expf(b[jj]);
            ((LAS bf16_t*)(lds + GC_QS))[j * 136 + d] = (bf16_t)pk2(bf2f(qraw[jj]) * eb, 0.f);
            ((LAS bf16_t*)(lds + GC_KS))[j * 136 + d] = (bf16_t)pk2(bf2f(kraw[jj]) * __builtin_amdgcn_rcpf(eb), 0.f); }
        vt_store(vr, lds + GC_VT);
        if (c < NPC) {
#pragma unroll
            for (int k = 0; k < 8; ++k) { const int i = tid + 512 * k, v = i >> 4, c8 = i & 15; *(LAS u32x4*)(lds + GC_SS + (v * 136 + c8 * 8) * 2) = sr[k]; }
        } else {
            const float* s0 = kin(I_STATE) + ((((size_t)L * 8 + (c - NPC)) * 4 + h) * 32768);
            for (int i = tid; i < 8192; i += NTHREADS) { const int dd = i & 127, v4 = i >> 7; const f32x4 s = *(const f32x4*)(s0 + dd * 256 + v4 * 4); LAS bf16_t* o = (LAS bf16_t*)(lds + GC_SS) + (v4 * 4) * 136 + dd;
                o[0] = (bf16_t)pk2(s.x, 0.f); o[136] = (bf16_t)pk2(s.y, 0.f); o[272] = (bf16_t)pk2(s.z, 0.f); o[408] = (bf16_t)pk2(s.w, 0.f); }
        }
        __syncthreads();
        bf16_t* orow = SGA + ((size_t)c * 64 + 16 * it + r) * 1024 + h * 256;
        u32x2 gate[8];
#pragma unroll
        for (int vt = 0; vt < 8; ++vt) gate[vt] = *(const u32x2*)(orow + 128 * vh + 16 * vt + 4 * q);
        bf16x8 bq[4];
#pragma unroll
        for (int ks = 0; ks < 4; ++ks) bq[ks] = lds16(lds + GC_QS + ((16 * it + r) * 136 + 32 * ks + 8 * q) * 2);
        f32x4 at[4];
#pragma unroll
        for (int jt = 0; jt < 4; ++jt) { at[jt] = (f32x4){0.f, 0.f, 0.f, 0.f};
            if (jt <= it) {
#pragma unroll
                for (int ks = 0; ks < 4; ++ks) at[jt] = __builtin_amdgcn_mfma_f32_16x16x32_bf16(lds16(lds + GC_KS + ((16 * jt + r) * 136 + 32 * ks + 8 * q) * 2), bq[ks], at[jt], 0, 0, 0);
                if (jt == it) {
#pragma unroll
                    for (int e = 0; e < 4; ++e) if (4 * q + e > r) at[jt][e] = 0.f;
                } } }
        bf16x8 bp[2];
#pragma unroll
        for (int s = 0; s < 2; ++s) { u32x4 w; w.x = pk2(at[2 * s][0], at[2 * s][1]); w.y = pk2(at[2 * s][2], at[2 * s][3]); w.z = pk2(at[2 * s + 1][0], at[2 * s + 1][1]); w.w = pk2(at[2 * s + 1][2], at[2 * s + 1][3]); bp[s] = __builtin_bit_cast(bf16x8, w); }
        f32x4 o[8];
#pragma unroll
        for (int vt = 0; vt < 8; ++vt) { o[vt] = (f32x4){0.f, 0.f, 0.f, 0.f}; const int v = 128 * vh + 16 * vt + r;
#pragma unroll
            for (int s = 0; s < 2; ++s) if (2 * s <= it) { const s16x4 lo = lds8(lds + GC_VT + (v * 72 + 32 * s + 4 * q) * 2), hi = lds8(lds + GC_VT + (v * 72 + 32 * s + 16 + 4 * q) * 2);
                const bf16x8 av = __builtin_shufflevector(lo, hi, 0, 1, 2, 3, 4, 5, 6, 7); o[vt] = __builtin_amdgcn_mfma_f32_16x16x32_bf16(av, bp[s], o[vt], 0, 0, 0); }
#pragma unroll
            for (int ks = 0; ks < 4; ++ks) o[vt] = __builtin_amdgcn_mfma_f32_16x16x32_bf16(lds16(lds + GC_SS + (v * 136 + 32 * ks + 8 * q) * 2), bq[ks], o[vt], 0, 0, 0); }
        float ss = 0.f;
#pragma unroll
        for (int vt = 0; vt < 8; ++vt) ss += (o[vt][0] * o[vt][0] + o[vt][1] * o[vt][1]) + (o[vt][2] * o[vt][2] + o[vt][3] * o[vt][3]);
        ss += __shfl_xor(ss, 16); ss += __shfl_xor(ss, 32);
        if (q == 0) red[vh * 64 + 16 * it + r] = ss;
        __syncthreads();
        const float rstd = rsqrtf((red[16 * it + r] + red[64 + 16 * it + r]) * (1.f / 256.f) + EPS);
#pragma unroll
        for (int vt = 0; vt < 8; ++vt) { const int v = 128 * vh + 16 * vt + 4 * q; const u32x2 g = gate[vt]; const f32x4 gn = *(const f32x4*)(gg + v);
            u32x2 w; w.x = pk2(o[vt][0] * rstd * gn.x * bflo(g.x), o[vt][1] * rstd * gn.y * bfhi(g.x)); w.y = pk2(o[vt][2] * rstd * gn.z * bflo(g.y), o[vt][3] * rstd * gn.w * bfhi(g.y));
            if (!dry || rstd == 1.2345e30f) *(u32x2*)(orow + v) = w; }
        __syncthreads();
    }
}

constexpr int AT_KS = 0, AT_VT = 36864, AT_BIAS = 73728, AT_BUF = 18432;
template <bool SAMPLE> DI void attn_load_k(int L, const bf16_t* KB, const float* ck, int bb, int n, int t, int hh, int sj, int sdq, u32x4& w0, u32x4& w1) {
    if (SAMPLE && t < 8) { const float* s = ck + (((size_t)L * 8 + bb) * 512 + t * 64 + sj) * 1024 + hh * 64 + 16 * sdq;
        const f32x4 f0 = *(const f32x4*)s, f1 = *(const f32x4*)(s + 4), f2 = *(const f32x4*)(s + 8), f3 = *(const f32x4*)(s + 12);
        w0.x = pk2(f0.x, f0.y); w0.y = pk2(f0.z, f0.w); w0.z = pk2(f1.x, f1.y); w0.w = pk2(f1.z, f1.w); w1.x = pk2(f2.x, f2.y); w1.y = pk2(f2.z, f2.w); w1.z = pk2(f3.x, f3.y); w1.w = pk2(f3.z, f3.w);
    } else { const size_t krow = SAMPLE ? (size_t)bb * 64 + sj : (size_t)bb * 4096 + (n - 8 + t) * 64 + sj; const bf16_t* s = KB + krow * 1024 + hh * 64 + 16 * sdq; w0 = *(const u32x4*)s; w1 = *(const u32x4*)(s + 8); }
}
template <bool SAMPLE> DI void attn_load_v(int L, const bf16_t* VBT, const float* cv, int bb, int n, int t, int hh, int tid, u32x4& w0, u32x4& w1) {
    if (SAMPLE && t < 8) { const int sj2 = tid & 63, dq2 = (tid >> 6) & 3; const float* s = cv + (((size_t)L * 8 + bb) * 512 + t * 64 + sj2) * 1024 + hh * 64 + 16 * dq2;
        const f32x4 f0 = *(const f32x4*)s, f1 = *(const f32x4*)(s + 4), f2 = *(const f32x4*)(s + 8), f3 = *(const f32x4*)(s + 12);
        w0.x = pk2(f0.x, f0.y); w0.y = pk2(f0.z, f0.w); w0.z = pk2(f1.x, f1.y); w0.w = pk2(f1.z, f1.w); w1.x = pk2(f2.x, f2.y); w1.y = pk2(f2.z, f2.w); w1.z = pk2(f3.x, f3.y); w1.w = pk2(f3.z, f3.w);
    } else { const int cc = SAMPLE ? bb : bb * 64 + (n - 8 + t); const bf16_t* s = VBT + ((size_t)cc * 16 + hh) * 4096 + (size_t)(tid & 255) * 8; w0 = *(const u32x4*)s; w1 = *(const u32x4*)(s + 2048); }
}
template <bool SAMPLE> DI void attn_item(const Args& a, int L, LAS unsigned char* lds, int dry, int item, bool stage_bias) {
    const int tid = otid(), lane = tid & 63, wave = __builtin_amdgcn_readfirstlane(tid >> 6), r = lane & 15, q = lane >> 4, g = wave >> 2, it = wave & 3;
    const bf16_t* QB = (const bf16_t*)(kws() + (SAMPLE ? WS_AX : WS_OV + 1 * SLOT)); const bf16_t* KB = (const bf16_t*)(kws() + (SAMPLE ? WS_AX + 1 * MiB : WS_OV + 2 * SLOT));
    const bf16_t* VB = (const bf16_t*)(kws() + (SAMPLE ? WS_AX + 2 * MiB : WS_OV + 3 * SLOT)); const bf16_t* GBs = (const bf16_t*)(kws() + (SAMPLE ? WS_AX + 3 * MiB : WS_OV + 4 * SLOT));
    bf16_t* SGB = (bf16_t*)(kws() + WS_OV + 4 * SLOT);
    const float* ck = kin(I_CK); const float* cv = kin(I_CV);
    LAS float* bias_s = (LAS float*)(lds + AT_BIAS);
    const int sg = tid >> 8, sj = (tid >> 2) & 63, sdq = tid & 3;
    const int c = item >> 3, hp = item & 7, h = 2 * hp + g;
    const int bb = SAMPLE ? c - NPC : c >> 6, n = SAMPLE ? 8 : c & 63, t0 = n >= 8 ? 0 : 8 - n;
    if (stage_bias) { const float* msh = (const float*)(kws() + WS_MSH) + L * 16 + 2 * hp;
    for (int i = tid; i < 2 * 257; i += NTHREADS) { const int g2 = i / 257, idx = i % 257; bias_s[g2 * 260 + idx] = kin(I_RELB)[((size_t)L * 16 + 2 * hp + g2) * 257 + idx] * LOG2E - msh[g2]; } }
    const size_t qrow = (size_t)c * 64 + 16 * it + r, qrl = SAMPLE ? qrow - MP : qrow;
    bf16x8 qf[2];
#pragma unroll
    for (int ks = 0; ks < 2; ++ks) qf[ks] = *(const bf16x8*)(QB + qrl * 1024 + h * 64 + 32 * ks + 8 * q);
    const int qi = 16 * it + r;
    bf16_t* orow = SGB + qrow * 1024 + h * 64;
    float l_run = 0.f;
    f32x4 o[4];
#pragma unroll
    for (int dt = 0; dt < 4; ++dt) o[dt] = (f32x4){0.f, 0.f, 0.f, 0.f};
    u32x4 k0, k1, v0, v1;
#define ATT_LOADT(T_) do { attn_load_k<SAMPLE>(L, KB, ck, bb, n, (T_), 2 * hp + sg, sj, sdq, k0, k1); attn_load_v<SAMPLE>(L, VB, cv, bb, n, (T_), 2 * hp + sg, tid, v0, v1); } while (0)
#define ATT_WRITE(T_, BUF_) do { const int bo_ = (BUF_) * AT_BUF; \
        LAS u32x4* ok = (LAS u32x4*)(lds + AT_KS + bo_ + ((sg * 64 + sj) * 72 + 16 * sdq) * 2); ok[0] = k0; ok[1] = k1; \
        if (SAMPLE && (T_) < 8) { const int sj2 = tid & 63, dq2 = (tid >> 6) & 3; LAS bf16_t* ov = (LAS bf16_t*)(lds + AT_VT + bo_) + (sg * 64 + 16 * dq2) * 72 + sj2; \
            ov[0] = (bf16_t)v0.x; ov[72] = (bf16_t)(v0.x >> 16); ov[144] = (bf16_t)v0.y; ov[216] = (bf16_t)(v0.y >> 16); ov[288] = (bf16_t)v0.z; ov[360] = (bf16_t)(v0.z >> 16); ov[432] = (bf16_t)v0.w; ov[504] = (bf16_t)(v0.w >> 16); \
            ov[576] = (bf16_t)v1.x; ov[648] = (bf16_t)(v1.x >> 16); ov[720] = (bf16_t)v1.y; ov[792] = (bf16_t)(v1.y >> 16); ov[864] = (bf16_t)v1.z; ov[936] = (bf16_t)(v1.z >> 16); ov[1008] = (bf16_t)v1.w; ov[1080] = (bf16_t)(v1.w >> 16); \
        } else { const int p0 = tid & 255, p1 = p0 + 256; \
            *(LAS u32x4*)(lds + AT_VT + bo_ + ((sg * 64 + (p0 >> 3)) * 72 + (p0 & 7) * 8) * 2) = v0; *(LAS u32x4*)(lds + AT_VT + bo_ + ((sg * 64 + (p1 >> 3)) * 72 + (p1 & 7) * 8) * 2) = v1; } } while (0)
    ATT_LOADT(t0);
    ATT_WRITE(t0, 0);
    if (t0 + 1 < 9) ATT_LOADT(t0 + 1);
    __syncthreads();
#pragma unroll 1
    for (int t = t0; t < 9; ++t) {
        const int cb = (t - t0) & 1;
        if (t + 1 < 9) { ATT_WRITE(t + 1, cb ^ 1); if (t + 2 < 9) ATT_LOADT(t + 2); }
        const LAS unsigned char* kb_ = lds + AT_KS + cb * AT_BUF; const LAS unsigned char* vb_ = lds + AT_VT + cb * AT_BUF;
        f32x4 sc[4];
#pragma unroll
        for (int jt = 0; jt < 4; ++jt) { f32x4 acc = (f32x4){0.f, 0.f, 0.f, 0.f};
#pragma unroll
            for (int ks = 0; ks < 2; ++ks) acc = __builtin_amdgcn_mfma_f32_16x16x32_bf16(lds16(kb_ + ((g * 64 + 16 * jt + r) * 72 + 32 * ks + 8 * q) * 2), qf[ks], acc, 0, 0, 0);
            sc[jt] = acc; }
        if (t >= 6) {
#pragma unroll
            for (int jt = 0; jt < 4; ++jt)
#pragma unroll
                for (int e = 0; e < 4; ++e) { int rel = 512 + qi - (64 * t + 16 * jt + 4 * q + e); rel = rel > 128 ? 128 : rel; rel = rel < -128 ? -128 : rel; sc[jt][e] += bias_s[g * 260 + rel + 128]; }
        } else { const float bfar = bias_s[g * 260 + 256];
#pragma unroll
            for (int jt = 0; jt < 4; ++jt) sc[jt] = sc[jt] + bfar;
        }
        float ps = 0.f;
#pragma unroll
        for (int jt = 0; jt < 4; ++jt)
#pragma unroll
            for (int e = 0; e < 4; ++e) { const float p = __builtin_amdgcn_exp2f(sc[jt][e]); sc[jt][e] = p; ps += p; }
        l_run += ps;
#pragma unroll
        for (int s = 0; s < 2; ++s) {
            u32x4 w; w.x = pk2(sc[2 * s][0], sc[2 * s][1]); w.y = pk2(sc[2 * s][2], sc[2 * s][3]); w.z = pk2(sc[2 * s + 1][0], sc[2 * s + 1][1]); w.w = pk2(sc[2 * s + 1][2], sc[2 * s + 1][3]);
            const bf16x8 bp = __builtin_bit_cast(bf16x8, w);
#pragma unroll
            for (int dt = 0; dt < 4; ++dt) { const LAS unsigned char* vp = vb_ + ((g * 64 + 16 * dt + r) * 72 + 32 * s + 4 * q) * 2;
                const s16x4 lo = lds8(vp), hi = lds8(vp + 32); const bf16x8 av = __builtin_shufflevector(lo, hi, 0, 1, 2, 3, 4, 5, 6, 7);
                o[dt] = __builtin_amdgcn_mfma_f32_16x16x32_bf16(av, bp, o[dt], 0, 0, 0); }
        }
        __syncthreads();
    }
#undef ATT_LOADT
#undef ATT_WRITE
    l_run += __shfl_xor(l_run, 16); l_run += __shfl_xor(l_run, 32);
    const float inv = __builtin_amdgcn_rcpf(l_run);
#pragma unroll
    for (int dt = 0; dt < 4; ++dt) { const int dd = 16 * dt + 4 * q; const u32x2 gv = *(const u32x2*)(GBs + qrl * 1024 + h * 64 + dd);
        u32x2 w; w.x = pk2(o[dt][0] * inv * bflo(gv.x), o[dt][1] * inv * bfhi(gv.x)); w.y = pk2(o[dt][2] * inv * bflo(gv.y), o[dt][3] * inv * bfhi(gv.y));
        if (!dry || inv == 1.2345e30f) *(u32x2*)(orow + dd) = w; }
}
DI void attn_phase(const Args& a, int L, LAS unsigned char* lds, int dry, int item_lo, int item_hi, int first_wg) {
    int wg0_ = (int)blockIdx.x - first_wg; if (wg0_ < 0) wg0_ += (int)gridDim.x;
    int prev_hp = -1;
    for (int item = item_lo + wg0_; item < item_hi; item += gridDim.x) { const bool sb = (item & 7) != prev_hp; prev_hp = item & 7;
        if ((item >> 3) >= NPC) attn_item<true>(a, L, lds, dry, item, sb); else attn_item<false>(a, L, lds, dry, item, sb); }
}

#define XB_TMO      128
#define XB_XCNT(j)  (256  + 64 * (j))
#define XB_XSUB(j)  (1280 + 64 * (j))
#define XB_XGEN(j)  (2304 + 64 * (j))
#define XB_TOP      3328
#define XB_TOPGEN   3392
#define XCD_BAR_WORDS 3456
#define XB_SPIN_CAP (1u << 18)

__device__ __forceinline__ unsigned xb_ld(unsigned* p)              { return __hip_atomic_load(p, __ATOMIC_RELAXED, __HIP_MEMORY_SCOPE_AGENT); }
__device__ __forceinline__ unsigned xb_add(unsigned* p, unsigned v) { return __hip_atomic_fetch_add(p, v, __ATOMIC_RELAXED, __HIP_MEMORY_SCOPE_AGENT); }
__device__ __forceinline__ unsigned xb_xcc_id() { return (unsigned)__builtin_amdgcn_s_getreg((3 << 11) | 20) & 0xFu; }
#define XB_SPIN(cond, bar) do { unsigned _sp = 0; while (cond) { __builtin_amdgcn_s_sleep(1); \
    if ((++_sp & 255u) == 0u) { if (xb_ld(&(bar)[XB_TMO])) break; if (_sp > XB_SPIN_CAP) { atomicAdd(&(bar)[XB_TMO], 1u); break; } } } } while (0)

struct XcdBarrier {
    unsigned* bar; unsigned x;
    volatile LAS unsigned* st;
};

__device__ __forceinline__ XcdBarrier xcd_barrier_post(unsigned* bar, volatile LAS unsigned* st) {
    XcdBarrier b; b.bar = bar; b.x = xb_xcc_id(); b.st = st;
    if (threadIdx.x == 0) (void)xb_add(&bar[XB_XCNT(b.x)], 1u);
    return b;
}
__device__ __forceinline__ void xcd_barrier_complete(unsigned* bar, unsigned x, unsigned& nloc, unsigned& nx) {
    const unsigned G = gridDim.x * gridDim.y * gridDim.z;
    unsigned sum, cnt, mine, sp = 0u;
    for (;;) {
        sum = 0u; cnt = 0u; mine = 0u;
#pragma unroll
        for (unsigned j = 0; j < 16; ++j) { const unsigned c = xb_ld(&bar[XB_XCNT(j)]); sum += c; cnt += (c > 0u) ? 1u : 0u; mine = (j == x) ? c : mine; }
        if (sum == G) break;
        __builtin_amdgcn_s_sleep(1);
        if ((++sp & 255u) == 0u) { if (xb_ld(&bar[XB_TMO])) break; if (sp > XB_SPIN_CAP) { atomicAdd(&bar[XB_TMO], 1u); break; } }
    }
    nloc = mine > 0u ? mine : 1u; nx = cnt > 0u ? cnt : 1u;
}

__device__ __forceinline__ void xcd_barrier(const XcdBarrier& b) {
    asm volatile("s_waitcnt vmcnt(0)" ::: "memory");
    __syncthreads();
    if (threadIdx.x == 0) {
        unsigned* bar = b.bar;
        __builtin_amdgcn_s_waitcnt(0);
        unsigned nloc = b.st[0], nx = b.st[1];
        if (nloc == 0u) { xcd_barrier_complete(bar, b.x, nloc, nx); b.st[0] = nloc; b.st[1] = nx; }
        const unsigned old = xb_add(&bar[XB_XSUB(b.x)], 1u);
        const unsigned gen = old / nloc;
        if (old + 1u == (gen + 1u) * nloc) {
            __builtin_amdgcn_fence(__ATOMIC_RELEASE, "agent");
            asm volatile("s_waitcnt vmcnt(0)" ::: "memory");
            const unsigned og = xb_add(&bar[XB_TOP], 1u);
            const unsigned tg = og / nx;
            if (og + 1u == (tg + 1u) * nx) xb_add(&bar[XB_TOPGEN], 1u);
            else XB_SPIN(xb_ld(&bar[XB_TOPGEN]) == tg, bar);
            __builtin_amdgcn_fence(__ATOMIC_ACQUIRE, "agent");
            xb_add(&bar[XB_XGEN(b.x)], 1u);
            asm volatile("s_waitcnt vmcnt(0)" ::: "memory");
        } else {
            XB_SPIN(xb_ld(&bar[XB_XGEN(b.x)]) == gen, bar);
            __builtin_amdgcn_fence(__ATOMIC_ACQUIRE, "agent");
            asm volatile("s_waitcnt vmcnt(0)" ::: "memory");
        }
    }
    __syncthreads();
}

#ifndef PROBE_REP
#define PROBE_REP 0
#endif
#ifndef EN_CH
#define EN_CH 31
#endif
#ifndef EN_PREP
#define EN_PREP 1
#endif
#ifndef EN_GIN
#define EN_GIN 1
#endif
#ifndef EN_GLAA
#define EN_GLAA 1
#endif
#ifndef EN_SCAN
#define EN_SCAN 1
#endif
#ifndef EN_GLAC
#define EN_GLAC 1
#endif
#ifndef EN_ATTN
#define EN_ATTN 1
#endif
#ifndef EN_CHAIN
#define EN_CHAIN 1
#endif
constexpr int PH_PER_LAYER = 10, N_PHASES = 1 + 2 * PH_PER_LAYER;
constexpr int MISC_OFF = LDS_BYTES - 64;
#define REPS(k) (((PROBE_REP >> (k)) & 1) ? 2 : 1)
__global__ void __launch_bounds__(NTHREADS, 2) fwd_kernel(Args a) {
    extern __shared__ __attribute__((aligned(16))) unsigned char lds_raw[];
    LAS unsigned char* lds = (LAS unsigned char*)lds_raw;
    const int tid = otid(), lane = tid & 63, wave = __builtin_amdgcn_readfirstlane(tid >> 6);
    const int gw = blockIdx.x * 8 + wave, ngw = gridDim.x * 8, gtid = blockIdx.x * NTHREADS + tid, ngt = gridDim.x * NTHREADS;
    LAS float* scr = (LAS float*)(lds + wave * 16384);
    const int lo = kph_lo(), hi = kph_hi();
    volatile LAS unsigned* MISC = (volatile LAS unsigned*)(lds + MISC_OFF);
    if (tid < 16) MISC[tid] = 0u;
    __syncthreads();
    XcdBarrier bar; bar.bar = (unsigned*)kws(); bar.x = 0; bar.st = nullptr;
    if (hi - lo > 1) bar = xcd_barrier_post((unsigned*)kws(), MISC);
#define IN_PH(k) (lo <= (k) && (k) < hi)
#define SEAM(k) do { if (IN_PH(k) && IN_PH((k) + 1)) { xcd_barrier(bar); if ((PROBE_REP >> 11) & 1) xcd_barrier(bar); } } while (0)
    if (lo < 0) { __threadfence(); cg::this_grid().sync(); }
    if (EN_PREP && IN_PH(0)) for (int rep = 0; rep < REPS(10); ++rep) { prep_small(a, gw, ngw, scr, lane); prep_win(a, 0, gw, ngw, scr, lane); prep_rows(a, gw, ngw, lane); prep_shift(gw, lane); prep_misc(a, gtid, ngt); __syncthreads(); }
    SEAM(0);
    for (int L = 0; L < 2; ++L) {
        const int pb = 1 + L * PH_PER_LAYER;
        unsigned char* ws = kws();
        bf16_t* XB = (bf16_t*)(ws + WS_XB); float* SQ1 = (float*)(ws + WS_SQ1); float* SQ2 = (float*)(ws + WS_SQ2);
        bf16_t* S0 = (bf16_t*)(ws + WS_OV); bf16_t* S1 = (bf16_t*)(ws + WS_OV + SLOT); bf16_t* S2 = (bf16_t*)(ws + WS_OV + 2 * SLOT); bf16_t* S3 = (bf16_t*)(ws + WS_OV + 3 * SLOT); bf16_t* S4 = (bf16_t*)(ws + WS_OV + 4 * SLOT);
        const bf16_t* WIN = (const bf16_t*)(ws + WS_WIN);
        EpiIn ein; ein.L = L; ein.ws = ws; ein.out = kout(); ein.qg = kin(I_QG) + L * 64; ein.kg = kin(I_KG) + L * 64;
        if (EN_GIN && IN_PH(pb + 0)) for (int rep = 0; rep < REPS(0); ++rep) { ein.tile0 = 0; run_gemm_g(lds, XB, WIN, ein); }
        SEAM(pb + 0);
        if (EN_GLAA && IN_PH(pb + 1)) for (int rep = 0; rep < REPS(1); ++rep) gla_a_phase(a, L, lds, 0, NPC * 4, 0);
        SEAM(pb + 1);
        if (EN_SCAN && IN_PH(pb + 2)) for (int rep = 0; rep < REPS(2); ++rep) {
            gla_a_phase(a, L, lds, NPC * 4, NCH * 4, 0); gla_c_phase(a, L, lds, rep + 1 < REPS(2), NPC * 4, NCH * 4, 32);
            attn_phase(a, L, lds, rep + 1 < REPS(2), NPC * 8, NCH * 8, 64);
            gla_scan_phase(a, L, rep + 1 < REPS(2)); }
        SEAM(pb + 2);
        if (EN_GLAC && IN_PH(pb + 3)) for (int rep = 0; rep < REPS(3); ++rep) gla_c_phase(a, L, lds, rep + 1 < REPS(3), 0, NPC * 4, 0);
        SEAM(pb + 3);
        if (EN_GIN && IN_PH(pb + 4)) for (int rep = 0; rep < REPS(4); ++rep) { ein.tile0 = 13; run_gemm(lds, XB, WIN + (size_t)13 * 256 * 1024, MP, 16 * 256, 1024, ein); }
        SEAM(pb + 4);
        if (EN_ATTN && IN_PH(pb + 5)) for (int rep = 0; rep < REPS(5); ++rep) attn_phase(a, L, lds, rep + 1 < REPS(5), 0, NPC * 8, 0);
        SEAM(pb + 5);
        if (EN_GIN && IN_PH(pb + 6)) for (int rep = 0; rep < REPS(6); ++rep) { ein.tile0 = 29; run_gemm_m(lds, XB, WIN + (size_t)29 * 256 * 1024, ein); }
        if (!(IN_PH(pb + 6) && IN_PH(pb + 7))) SEAM(pb + 6);
        if (EN_CHAIN && IN_PH(pb + 7)) for (int rep = 0; rep < REPS(7); ++rep) { const int dry = rep + 1 < REPS(7);
            if (EN_CH & 1) { bf16_t* AXA = (bf16_t*)(ws + WS_AX + 4 * MiB); EpiYA ea{S1, dry, AXA}; run_gemm(lds, S0, wsm(a, L, 0), MP, 1024, 1024, ea); mini_gemm<1024>(lds, S0 + (size_t)MP * 1024, wsm(a, L, 0), ea); }
            if (EN_CH & 2) { bf16_t* AXA = (bf16_t*)(ws + WS_AX + 4 * MiB); bf16_t* AXB = (bf16_t*)(ws + WS_AX + 5 * MiB); EpiYB eb{S1, S2, dry, AXA, AXB}; run_gemm(lds, S4, wsm(a, L, 1), MP, 1024, 1024, eb); mini_gemm<1024>(lds, S4 + (size_t)MP * 1024, wsm(a, L, 1), eb); }
        }
        SEAM(pb + 7);
        if (EN_CHAIN && IN_PH(pb + 8)) {
            if (L == 0) { prep_win(a, 1, gw, ngw, scr, lane); __syncthreads(); }
            for (int rep = 0; rep < REPS(8); ++rep) {
            EpiOut eo; eo.xp = L == 0 ? kin(I_XP) : kout(); eo.xs = L == 0 ? kin(I_XS) : kout() + (size_t)MP * 1024; eo.out = kout(); eo.xb = S3; eo.sq = SQ1; eo.dry = rep + 1 < REPS(8);
            if (EN_CH & 4) { run_gemm(lds, S2, wsm(a, L, 2), MP, 1024, 1024, eo); mini_gemm<1024>(lds, (const bf16_t*)(ws + WS_AX + 5 * MiB), wsm(a, L, 2), eo); } }
        }
        SEAM(pb + 8);
        if (EN_CHAIN && IN_PH(pb + 9)) for (int rep = 0; rep < REPS(9); ++rep) { const int dry = rep + 1 < REPS(9);
            if (EN_CH & 8) { EpiP ep{(float*)S0, dry}; run_gemm(lds, (const bf16_t*)(ws + WS_PB) + (size_t)L * MT * 256, wsm(a, L, 4), MP, 1024, 256, ep); mini_gemm<256>(lds, (const bf16_t*)(ws + WS_PB) + ((size_t)L * MT + MP) * 256, wsm(a, L, 4), ep); }
            EpiGate eg; eg.sq1 = SQ1; eg.PT = (const float*)S0; eg.out = kout(); eg.xb = XB; eg.sq2 = SQ2; eg.dry = dry;
            if (EN_CH & 16) { run_gemm(lds, S3, wsm(a, L, 3), MP, 1024, 1024, eg); mini_gemm<1024>(lds, S3 + (size_t)MP * 1024, wsm(a, L, 3), eg); }
        }
        SEAM(pb + 9);
    }
}

#ifndef MK_ONE_LAUNCH
#define MK_ONE_LAUNCH 1
#endif
extern "C" void kernel_launch(void* const* d_in, const int* in_sizes, int n_in, void* d_out, int out_size, void* d_ws, size_t ws_size, hipStream_t stream) {
    static int grid = 0;
    if (grid == 0) {
        if (n_in != 21 || ws_size < WS_END) { fprintf(stderr, "kernel_launch: unexpected n_in %d or ws_size %zu (< %zu)\n", n_in, ws_size, (size_t)WS_END); grid = -1; return; }
        int dev = 0, cus = 0, per_cu = 0;
        (void)hipGetDevice(&dev); (void)hipDeviceGetAttribute(&cus, hipDeviceAttributeMultiprocessorCount, dev);
        (void)hipFuncSetAttribute((const void*)fwd_kernel, hipFuncAttributeMaxDynamicSharedMemorySize, LDS_BYTES);
        (void)hipOccupancyMaxActiveBlocksPerMultiprocessor(&per_cu, (const void*)fwd_kernel, NTHREADS, LDS_BYTES);
        (void)hipGetLastError();
        if (per_cu < 1) { fprintf(stderr, "kernel_launch: occupancy query says %d blocks/CU\n", per_cu); per_cu = 1; }
        grid = cus;
    }
    if (grid < 0) return;
    Args a{};
    for (int i = 0; i < 21; ++i) a.in[i] = (const float*)d_in[i];
    a.out = (float*)d_out; a.ws = (unsigned char*)d_ws;
#if MK_ONE_LAUNCH
    (void)hipMemsetAsync(d_ws, 0, 16384, stream);
    a.ph_lo = 0; a.ph_hi = N_PHASES;
    void* args[] = {&a};
    hipError_t e = hipLaunchCooperativeKernel((const void*)fwd_kernel, dim3(grid), dim3(NTHREADS), args, LDS_BYTES, stream);
    if (e != hipSuccess) fprintf(stderr, "cooperative launch failed: %s (grid %d)\n", hipGetErrorString(e), grid);
#else
    for (int p = 0; p < N_PHASES; ++p) { a.ph_lo = p; a.ph_hi = p + 1; hipLaunchKernelGGL(fwd_kernel, dim3(grid), dim3(NTHREADS), LDS_BYTES, stream, a); }
#endif
}
```

```cpp
#include <hip/hip_runtime.h>
#include <hip/hip_cooperative_groups.h>
#include <cstdio>
#include <cstdint>
namespace cg = cooperative_groups;
namespace pg8 {
#define PG8_LAS __attribute__((address_space(3)))
typedef unsigned short bf16_t;
typedef short bf16x8 __attribute__((ext_vector_type(8)));
typedef float f32x4 __attribute__((ext_vector_type(4)));
typedef unsigned u32x4 __attribute__((ext_vector_type(4)));
constexpr int BM = 256, BK = 64, HALF = 128, HTB = HALF * BK * 2  , STAGE_BYTES = 8 * HTB, NXCD = 8, WGM = 8;

__host__ __device__ __forceinline__ int lds_byte(int r, int c) { const int st = (r >> 4) * 2 + (c >> 5), rr = r & 15, cc = c & 31, ob = rr * 64 + cc * 2; return st * 1024 + (ob ^ (((ob >> 9) & 1) << 5)); }
__host__ __device__ __forceinline__ void stage_rc(int b, int& R, int& C) { const int st = b / 1024, sb = b % 1024, swz = sb ^ (((sb >> 9) & 1) << 5); R = (st >> 1) * 16 + swz / 64; C = (st & 1) * 32 + (swz % 64) / 2; }
__host__ __device__ __forceinline__ int perm32(int rho) { const int n = rho >> 4, i = rho & 15; return 8 * (i >> 2) + 4 * n + (i & 3); }

struct Unit { int pm, pn; };
struct Gemm { const bf16_t* A; const bf16_t* Bt; int M, N, K; };

struct StaticOrder {
    int nM, nN, nwg, G, c;
    __host__ __device__ void init(int M, int N, int G_, int c_) { nM = M / BM; nN = N / BM; nwg = nM * nN; G = G_; c = c_; }
    __host__ __device__ bool next(int i, Unit& u) const {
        const long L = (long)i * G + c; if (L >= nwg) return false;
        int wgid = (int)L; { const int q = nwg / NXCD, r = nwg % NXCD, xcd = wgid % NXCD, off = wgid / NXCD; wgid = (xcd < r ? xcd * (q + 1) : r * (q + 1) + (xcd - r) * q) + off; }
        const int nig = WGM * nN, gid = wgid / nig, fm = gid * WGM, gsz = (nM - fm) < WGM ? (nM - fm) : WGM;
        u.pm = fm + ((wgid % nig) % gsz); u.pn = (wgid % nig) / gsz; return true;
    }
    __device__ __forceinline__ void a_ready(const Unit&) const {}
    __device__ __forceinline__ void done(const Unit&) const {}
};
__device__ __forceinline__ unsigned cvt_pk_bf16(float lo, float hi) { unsigned r; asm volatile("v_cvt_pk_bf16_f32 %0, %1, %2" : "=v"(r) : "v"(lo), "v"(hi)); return r; }
template <class Epi, class Sched, bool ALIGN_EPI = false, bool SP2 = false>
__device__ __forceinline__ void gemm_phase(PG8_LAS unsigned char* lds, const Gemm g, const Sched& S, const Epi& E) {
    int tid_ = threadIdx.x; asm volatile("" : "+v"(tid_));
    const int tid = tid_, wid = __builtin_amdgcn_readfirstlane(tid >> 6), lane = tid & 63, wr = wid >> 2, wc = wid & 3, fr = lane & 15, fq = lane >> 4;
    const int K = g.K, nt = K / BK;
    unsigned voffA[2], voffB[2];
#pragma unroll
    for (int i = 0; i < 2; ++i) { int R, C; stage_rc(tid * 16 + i * 8192, R, C); const int Rb = Epi::PERM ? ((R & ~31) + perm32(R & 31)) : R;
        voffA[i] = (unsigned)(R * K + C) * 2u; voffB[i] = (unsigned)(Rb * K + C) * 2u; }
    const size_t kstep = (size_t)(BK * 2);
    const size_t hstep = (size_t)HALF * K * 2;
    const size_t tstep = 2 * hstep;
    const unsigned ldsw = (unsigned)wid * 1024u;
    const int aoff = lds_byte(wr * 64 + fr, fq * 8), boff = lds_byte(wc * 32 + fr, fq * 8);
#define PG8_SA(b, h) (((b) * 2 + (h)) * HTB)
#define PG8_SB(b, h) ((4 + (b) * 2 + (h)) * HTB)
#define PG8_STAGE(bufoff, gbase, voff) do { _Pragma("unroll") for (int _i = 0; _i < 2; ++_i) \
        __builtin_amdgcn_global_load_lds((const unsigned*)((const char*)(gbase) + (voff)[_i]), (PG8_LAS unsigned*)(lds + (bufoff) + ldsw + _i * 8192), 16, 0, 0); } while (0)
#define PG8_LDA(dst, b, h) do { _Pragma("unroll") for (int m = 0; m < 4; ++m) _Pragma("unroll") for (int k = 0; k < 2; ++k) dst[m][k] = *(const PG8_LAS bf16x8*)(lds + PG8_SA(b, h) + aoff + m * 2048 + k * 1024); } while (0)
#define PG8_LDB(dst, b, h) do { _Pragma("unroll") for (int n = 0; n < 2; ++n) _Pragma("unroll") for (int k = 0; k < 2; ++k) dst[n][k] = *(const PG8_LAS bf16x8*)(lds + PG8_SB(b, h) + boff + n * 2048 + k * 1024); } while (0)
#define PG8_MMA(ai, bj, At, Bt) do { __builtin_amdgcn_s_setprio(1); _Pragma("unroll") for (int m = 0; m < 4; ++m) _Pragma("unroll") for (int n = 0; n < 2; ++n) _Pragma("unroll") for (int k = 0; k < 2; ++k) \
        acc[ai][bj][m][n] = __builtin_amdgcn_mfma_f32_16x16x32_bf16(Bt[n][k], At[m][k], acc[ai][bj][m][n], 0, 0, 0); __builtin_amdgcn_s_setprio(0); } while (0)
#define PG8_WAIT_V(n) asm volatile("s_waitcnt vmcnt(" #n ")" ::: "memory")
#define PG8_WAIT_L(n) asm volatile("s_waitcnt lgkmcnt(" #n ")" ::: "memory")
#define PG8_BAR __builtin_amdgcn_s_barrier()
#define PG8_SCHED __builtin_amdgcn_sched_barrier(0)
    Unit cur, nxt; int ui = 0;
    if (!S.next(0, cur)) return;
    f32x4 acc[2][2][4][2];
#pragma unroll
    for (int a = 0; a < 2; ++a)
#pragma unroll
        for (int b = 0; b < 2; ++b)
#pragma unroll
            for (int m = 0; m < 4; ++m)
#pragma unroll
                for (int n = 0; n < 2; ++n) acc[a][b][m][n] = (f32x4){0.f, 0.f, 0.f, 0.f};
    bf16x8 At[4][2], B0[2][2], B1[2][2];
    const char* cA = (const char*)g.A + (size_t)cur.pm * tstep; const char* cB = (const char*)g.Bt + (size_t)cur.pn * tstep;
    S.a_ready(cur);
    if constexpr (SP2) {
        PG8_STAGE(PG8_SB(0, 0), cB, voffB); PG8_STAGE(PG8_SB(0, 1), cB + hstep, voffB); PG8_STAGE(PG8_SA(0, 0), cA, voffA); PG8_STAGE(PG8_SA(0, 1), cA + hstep, voffA);
        if (wr == 1) PG8_BAR;
        PG8_WAIT_V(2); PG8_BAR;
        PG8_STAGE(PG8_SB(1, 0), cB + kstep, voffB); PG8_STAGE(PG8_SA(1, 0), cA + kstep, voffA); PG8_STAGE(PG8_SB(1, 1), cB + hstep + kstep, voffB);
        PG8_WAIT_V(6); PG8_BAR;
    } else {
        PG8_STAGE(PG8_SB(0, 0), cB, voffB); PG8_STAGE(PG8_SA(0, 0), cA, voffA); PG8_STAGE(PG8_SB(0, 1), cB + hstep, voffB); PG8_STAGE(PG8_SA(0, 1), cA + hstep, voffA);
        if (wr == 1) PG8_BAR;
        PG8_WAIT_V(4); PG8_BAR;
        PG8_STAGE(PG8_SB(1, 0), cB + kstep, voffB); PG8_STAGE(PG8_SA(1, 0), cA + kstep, voffA); PG8_STAGE(PG8_SB(1, 1), cB + hstep + kstep, voffB);
        PG8_WAIT_V(6); PG8_BAR;
    }
    for (;;) {
        const bool has_next = S.next(ui + 1, nxt);
        const char* nA = has_next ? (const char*)g.A + (size_t)nxt.pm * tstep : cA; const char* nB = has_next ? (const char*)g.Bt + (size_t)nxt.pn * tstep : cB;
        for (int t = 0; t < nt; t += 2) {
            const bool last = (t == nt - 2);
            const char* a1 = cA + (size_t)(t + 1) * kstep;
            const char* a2 = last ? nA : cA + (size_t)(t + 2) * kstep; const char* b2 = last ? nB : cB + (size_t)(t + 2) * kstep;
            const char* a3 = a2 + kstep; const char* b3 = b2 + kstep;
            if (last && has_next) S.a_ready(nxt);
            if constexpr (SP2) {
            PG8_LDB(B0, 0, 0); PG8_LDB(B1, 0, 1); PG8_SCHED; PG8_LDA(At, 0, 0); PG8_STAGE(PG8_SA(1, 1), a1 + hstep, voffA);
            PG8_WAIT_V(8); PG8_WAIT_L(0); PG8_BAR; PG8_MMA(0, 0, At, B0); PG8_MMA(0, 1, At, B1); PG8_BAR; PG8_SCHED;
            PG8_LDA(At, 0, 1); PG8_STAGE(PG8_SB(0, 0), b2, voffB); PG8_STAGE(PG8_SB(0, 1), b2 + hstep, voffB); PG8_STAGE(PG8_SA(0, 0), a2, voffA);
            PG8_WAIT_V(8); PG8_WAIT_L(0); PG8_BAR; PG8_MMA(1, 0, At, B0); PG8_MMA(1, 1, At, B1); PG8_BAR; PG8_SCHED;
            PG8_LDB(B0, 1, 0); PG8_LDB(B1, 1, 1); PG8_SCHED; PG8_LDA(At, 1, 0); PG8_STAGE(PG8_SA(0, 1), a2 + hstep, voffA);
            PG8_WAIT_V(8); PG8_WAIT_L(0); PG8_BAR; PG8_MMA(0, 0, At, B0); PG8_MMA(0, 1, At, B1); PG8_BAR; PG8_SCHED;
            PG8_LDA(At, 1, 1); PG8_STAGE(PG8_SB(1, 0), b3, voffB); PG8_STAGE(PG8_SB(1, 1), b3 + hstep, voffB); PG8_STAGE(PG8_SA(1, 0), a3, voffA);
            PG8_WAIT_V(8); PG8_WAIT_L(0); PG8_BAR; PG8_MMA(1, 0, At, B0); PG8_MMA(1, 1, At, B1); PG8_BAR; PG8_SCHED;
            } else {
            PG8_LDB(B0, 0, 0); PG8_SCHED; PG8_LDA(At, 0, 0); PG8_STAGE(PG8_SA(1, 1), a1 + hstep, voffA);
            PG8_WAIT_L(8); PG8_BAR; PG8_WAIT_L(0); PG8_MMA(0, 0, At, B0); PG8_BAR; PG8_SCHED;
            PG8_LDB(B1, 0, 1); PG8_STAGE(PG8_SB(0, 0), b2, voffB);
            PG8_BAR; PG8_WAIT_L(0); PG8_MMA(0, 1, At, B1); PG8_BAR;
            PG8_LDA(At, 0, 1); PG8_STAGE(PG8_SA(0, 0), a2, voffA);
            PG8_BAR; PG8_WAIT_L(0); PG8_MMA(1, 0, At, B0); PG8_BAR; PG8_SCHED;
            PG8_STAGE(PG8_SB(0, 1), b2 + hstep, voffB);
            PG8_WAIT_V(6); PG8_BAR; PG8_MMA(1, 1, At, B1); PG8_BAR;
            PG8_LDB(B0, 1, 0); PG8_SCHED; PG8_LDA(At, 1, 0); PG8_STAGE(PG8_SA(0, 1), a2 + hstep, voffA);
            PG8_WAIT_L(8); PG8_BAR; PG8_WAIT_L(0); PG8_MMA(0, 0, At, B0); PG8_BAR; PG8_SCHED;
            PG8_LDB(B1, 1, 1); PG8_STAGE(PG8_SB(1, 0), b3, voffB);
            PG8_BAR; PG8_WAIT_L(0); PG8_MMA(0, 1, At, B1); PG8_BAR;
            PG8_LDA(At, 1, 1); PG8_STAGE(PG8_SA(1, 0), a3, voffA);
            PG8_BAR; PG8_WAIT_L(0); PG8_MMA(1, 0, At, B0); PG8_BAR; PG8_SCHED;
            PG8_STAGE(PG8_SB(1, 1), b3 + hstep, voffB);
            PG8_WAIT_V(6); PG8_BAR; PG8_MMA(1, 1, At, B1); PG8_BAR;
            }
        }
        if constexpr (ALIGN_EPI) { if (wr == 0) PG8_BAR; }
        if constexpr (!Epi::AFTER_DRAIN) { E(acc, cur, wr, wc, fr, fq); S.done(cur); }
        if (!has_next) break;
#pragma unroll
        for (int a = 0; a < 2; ++a)
#pragma unroll
            for (int b = 0; b < 2; ++b)
#pragma unroll
                for (int m = 0; m < 4; ++m)
#pragma unroll
                    for (int n = 0; n < 2; ++n) acc[a][b][m][n] = (f32x4){0.f, 0.f, 0.f, 0.f};
        cur = nxt; cA = nA; cB = nB; ++ui;
        if constexpr (ALIGN_EPI) { if (wr == 1) PG8_BAR; }
    }
    PG8_WAIT_V(0);
    if constexpr (!ALIGN_EPI) { if (wr == 0) PG8_BAR; }
    PG8_BAR;
    if constexpr (Epi::AFTER_DRAIN) { E.fused(acc, cur, wr, wc, fr, fq, lds, wid, lane); S.done(cur); }
#undef PG8_SA
#undef PG8_SB
#undef PG8_STAGE
#undef PG8_LDA
#undef PG8_LDB
#undef PG8_MMA
#undef PG8_WAIT_V
#undef PG8_WAIT_L
#undef PG8_BAR
#undef PG8_SCHED
}
}

#define DI __device__ __forceinline__
#define LAS __attribute__((address_space(3)))
typedef unsigned short bf16_t;
typedef short bf16x8 __attribute__((ext_vector_type(8)));
typedef short s16x4 __attribute__((ext_vector_type(4)));
typedef float f32x4 __attribute__((ext_vector_type(4)));
typedef unsigned u32x4 __attribute__((ext_vector_type(4)));
typedef unsigned u32x2 __attribute__((ext_vector_type(2)));

constexpr int DM = 1024, MP = 16384, MS = 512, MT = MP + MS;
constexpr int NPC = 256, NCH = 264;
constexpr float EPS = 1e-6f, LOG2E = 1.4426950408889634f;
constexpr int NWIN_T = 37;
constexpr int NTHREADS = 512;
constexpr int LDS_BYTES = 147456;

constexpr size_t MiB = 1u << 20;
constexpr size_t SLOT = 33 * MiB;
constexpr size_t WS_MSH = 65536;
constexpr size_t WS_SQ1 = 1 * MiB, WS_SQ2 = 5 * MiB / 2, WS_RA = 4 * MiB, WS_DC = 6 * MiB, WS_WSM = 7 * MiB, WSM_LAYER = 17 * MiB / 2;
constexpr size_t WS_WIN = 24 * MiB, WS_PB = 43 * MiB, WS_XB = 60 * MiB, WS_OV = 93 * MiB, WS_AX = WS_OV + 5 * SLOT, WS_END = WS_AX + 6 * MiB;
constexpr size_t O_Y = 0, O_SP = 17301504, O_KP = 18350080, O_VP = 22544384, O_SS = 26738688, O_KS = 28835840, O_VS = 37224448;


typedef const __attribute__((address_space(4))) unsigned char* kargp_t;
DI kargp_t kbase() { kargp_t k = (kargp_t)__builtin_amdgcn_kernarg_segment_ptr(); asm volatile("" : "+s"(k)); return k; }
DI const float* kin(int i) { return *(const float* const __attribute__((address_space(4)))*)(kbase() + 8 * i); }
DI float* kout() { return *(float* const __attribute__((address_space(4)))*)(kbase() + 168); }
DI unsigned char* kws() { return *(unsigned char* const __attribute__((address_space(4)))*)(kbase() + 176); }
DI int kph_lo() { return *(const __attribute__((address_space(4))) int*)(kbase() + 184); }
DI int kph_hi() { return *(const __attribute__((address_space(4))) int*)(kbase() + 188); }
DI int otid() { int t = threadIdx.x; asm volatile("" : "+v"(t)); return t; }
DI float bflo(unsigned w) { return __uint_as_float(w << 16); }
DI float bfhi(unsigned w) { return __uint_as_float(w & 0xffff0000u); }
DI float bf2f(bf16_t b) { return __uint_as_float(((unsigned)b) << 16); }
typedef float f32x2_t __attribute__((ext_vector_type(2))); typedef __bf16 bf16x2_t __attribute__((ext_vector_type(2)));
DI unsigned pk2(float lo, float hi) { f32x2_t v = {lo, hi}; bf16x2_t r = __builtin_convertvector(v, bf16x2_t); return __builtin_bit_cast(unsigned, r); }
DI float sigm(float x) { return __builtin_amdgcn_rcpf(1.f + __expf(-x)); }
DI float silu(float x) { return x * sigm(x); }
DI float row_rstd(const float* sq, int row) {
    const f32x4* p = (const f32x4*)(sq + (size_t)row * 16); const f32x4 a = p[0], b = p[1], c = p[2], d = p[3];
    const float s = (((a.x + a.y) + (a.z + a.w)) + ((b.x + b.y) + (b.z + b.w))) + (((c.x + c.y) + (c.z + c.w)) + ((d.x + d.y) + (d.z + d.w)));
    return rsqrtf(s * (1.f / 1024.f) + EPS);
}
DI u32x4 pack8(const float* v) { u32x4 w; w.x = pk2(v[0], v[1]); w.y = pk2(v[2], v[3]); w.z = pk2(v[4], v[5]); w.w = pk2(v[6], v[7]); return w; }
DI void unpack8(u32x4 w, float* v) { v[0] = bflo(w.x); v[1] = bfhi(w.x); v[2] = bflo(w.y); v[3] = bfhi(w.y); v[4] = bflo(w.z); v[5] = bfhi(w.z); v[6] = bflo(w.w); v[7] = bfhi(w.w); }

enum { T_QA = 0, T_KA, T_VA, T_GA, T_RA, T_QB, T_KB, T_VB, T_GB, T_MGA, T_MGB };
struct EpiIn {
    static constexpr bool PERM = false, AFTER_DRAIN = false;
    int tile0, L; unsigned char* ws; float* out; const float *qg, *kg;
    template <int TYPE> DI void run(const pg8::f32x4 (&acc)[2][2][4][2], int pm, int tcol, int wr, int wc, int fr, int fq) const {
        constexpr size_t doff = TYPE == T_QA ? WS_OV + 2 * SLOT : TYPE == T_KA ? WS_OV + 2 * SLOT + (size_t)MT * 1024 : TYPE == T_VA ? WS_OV + SLOT : TYPE == T_GA ? WS_OV : TYPE == T_QB ? WS_OV + SLOT : TYPE == T_KB ? WS_OV + 2 * SLOT
                              : TYPE == T_VB ? WS_OV + 3 * SLOT : TYPE == T_GB ? WS_OV + 4 * SLOT : TYPE == T_MGA ? WS_OV + SLOT : WS_OV + 2 * SLOT;
        constexpr bool ANX = TYPE == T_QB || TYPE == T_KB || TYPE == T_VB || TYPE == T_GB || TYPE == T_MGA || TYPE == T_MGB;
        constexpr size_t aoff = WS_AX + (TYPE == T_QB ? 0 : TYPE == T_KB ? 1 : TYPE == T_VB ? 2 : TYPE == T_GB ? 3 : TYPE == T_MGA ? 4 : 5) * MiB;
        const bool srow = ANX && pm >= MP / 256;
        bf16_t* dst = (bf16_t*)(ws + (srow ? aoff : doff)); const int rsub = srow ? MP : 0; const float* sq = (const float*)(ws + WS_SQ2); float* RA = (float*)(ws + WS_RA);
        float* okp = out + (TYPE == T_KB ? O_KP : O_VP) + (size_t)L * 4 * 512 * 1024; float* oks = out + (TYPE == T_KB ? O_KS : O_VS) + (size_t)L * 8 * 512 * 1024;
        const int ld = (TYPE == T_QA || TYPE == T_KA) ? 512 : 1024;
        float gq[2][8];
        if (TYPE == T_QB || TYPE == T_KB) {
            const float* g = TYPE == T_QB ? qg : kg;
#pragma unroll
            for (int bj = 0; bj < 2; ++bj)
#pragma unroll
                for (int k = 0; k < 8; ++k) gq[bj][k] = g[32 * bj + 8 * fq + k] * (TYPE == T_QB ? 0.125f * LOG2E : 1.f);
        }
#pragma unroll
        for (int ai = 0; ai < 2; ++ai)
#pragma unroll
            for (int m = 0; m < 4; ++m) {
                const int row = pm * 256 + ai * 128 + wr * 64 + m * 16 + fr;
                const float rs = row_rstd(sq, row);
                float v[2][8];
#pragma unroll
                for (int bj = 0; bj < 2; ++bj)
#pragma unroll
                    for (int n = 0; n < 2; ++n)
#pragma unroll
                        for (int e = 0; e < 4; ++e) v[bj][4 * n + e] = acc[ai][bj][m][n][e] * rs;
                if (TYPE == T_RA) {
                    if (wc == 0 && fq < 2) { float* p = RA + (size_t)row * 16 + 8 * fq; *(f32x4*)p = (f32x4){v[0][0], v[0][1], v[0][2], v[0][3]}; *(f32x4*)(p + 4) = (f32x4){v[0][4], v[0][5], v[0][6], v[0][7]}; }
                    continue;
                }
                if (TYPE == T_QB || TYPE == T_KB) {
                    float ss = 0.f;
#pragma unroll
                    for (int bj = 0; bj < 2; ++bj)
#pragma unroll
                        for (int k = 0; k < 8; ++k) ss += v[bj][k] * v[bj][k];
                    ss += __shfl_xor(ss, 16); ss += __shfl_xor(ss, 32);
                    const float r = rsqrtf(ss * (1.f / 64.f) + EPS);
#pragma unroll
                    for (int bj = 0; bj < 2; ++bj)
#pragma unroll
                        for (int k = 0; k < 8; ++k) v[bj][k] *= r * gq[bj][k];
                }
                float* bo = nullptr;
                if (TYPE == T_KB || TYPE == T_VB) {
                    if (row < MP) { const int t = row & 4095; if (t >= 3584) bo = okp + ((size_t)(row >> 12) * 512 + (t - 3584)) * 1024; }
                    else { const int rr = row - MP; bo = oks + ((size_t)(rr >> 6) * 512 + 448 + (rr & 63)) * 1024; }
                }
#pragma unroll
                for (int bj = 0; bj < 2; ++bj) {
                    const int col = tcol * 256 + 64 * wc + 32 * bj + 8 * fq;
                    if (TYPE == T_QA) {
#pragma unroll
                        for (int k = 0; k < 8; ++k) v[bj][k] *= 0.08838834764831845f;
                    }
                    if (TYPE == T_GA || TYPE == T_GB) {
#pragma unroll
                        for (int k = 0; k < 8; ++k) v[bj][k] = silu(v[bj][k]);
                    }
                    if (TYPE == T_MGA || TYPE == T_MGB) {
#pragma unroll
                        for (int k = 0; k < 8; ++k) v[bj][k] = sigm(v[bj][k]);
                    }
                    if ((TYPE == T_KB || TYPE == T_VB) && bo) { *(f32x4*)(bo + col) = (f32x4){v[bj][0], v[bj][1], v[bj][2], v[bj][3]}; *(f32x4*)(bo + col + 4) = (f32x4){v[bj][4], v[bj][5], v[bj][6], v[bj][7]}; }
                    if (TYPE == T_VA) {
                        bf16_t* p = dst + ((size_t)((row >> 6) * 4 + tcol) * 256 + 64 * wc + 32 * bj + 8 * fq) * 64 + (row & 63);
#pragma unroll
                        for (int k = 0; k < 8; k += 2) { const unsigned w = pk2(v[bj][k], v[bj][k + 1]); p[k * 64] = (bf16_t)w; p[(k + 1) * 64] = (bf16_t)(w >> 16); }
                    } else if (TYPE == T_VB) {
                        bf16_t* p = dst + ((size_t)(((row - rsub) >> 6) * 16 + tcol * 4 + wc) * 64 + 32 * bj + 8 * fq) * 64 + (row & 63);
#pragma unroll
                        for (int k = 0; k < 8; k += 2) { const unsigned w = pk2(v[bj][k], v[bj][k + 1]); p[k * 64] = (bf16_t)w; p[(k + 1) * 64] = (bf16_t)(w >> 16); }
                    } else
                    *(u32x4*)(dst + (size_t)(row - rsub) * ld + col) = pack8(v[bj]);
                }
                asm volatile("" ::: "memory");
            }
    }
    DI void operator()(const pg8::f32x4 (&acc)[2][2][4][2], const pg8::Unit& u, int wr, int wc, int fr, int fq) const {
        asm volatile("" : "+v"(fr), "+v"(fq));
        const int gt = tile0 + u.pn;
        if (gt < 2) run<T_QA>(acc, u.pm, gt, wr, wc, fr, fq);
        else if (gt < 4) run<T_KA>(acc, u.pm, gt - 2, wr, wc, fr, fq);
        else if (gt < 8) run<T_VA>(acc, u.pm, gt - 4, wr, wc, fr, fq);
        else if (gt < 12) run<T_GA>(acc, u.pm, gt - 8, wr, wc, fr, fq);
        else if (gt == 12) run<T_RA>(acc, u.pm, 0, wr, wc, fr, fq);
        else if (gt < 17) run<T_QB>(acc, u.pm, gt - 13, wr, wc, fr, fq);
        else if (gt < 21) run<T_KB>(acc, u.pm, gt - 17, wr, wc, fr, fq);
        else if (gt < 25) run<T_VB>(acc, u.pm, gt - 21, wr, wc, fr, fq);
        else if (gt < 29) run<T_GB>(acc, u.pm, gt - 25, wr, wc, fr, fq);
        else if (gt < 33) run<T_MGA>(acc, u.pm, gt - 29, wr, wc, fr, fq);
        else run<T_MGB>(acc, u.pm, gt - 33, wr, wc, fr, fq);
    }
};
#define EPI_ROWS_BEGIN _Pragma("unroll") for (int ai = 0; ai < 2; ++ai) _Pragma("unroll") for (int m = 0; m < 4; ++m) { asm volatile("" ::: "memory"); const int row = u.pm * 256 + ai * 128 + wr * 64 + m * 16 + fr;
#define EPI_COLS_BEGIN _Pragma("unroll") for (int bj = 0; bj < 2; ++bj) { const int col = u.pn * 256 + 64 * wc + 32 * bj + 8 * fq; float v[8]; \
    _Pragma("unroll") for (int n = 0; n < 2; ++n) _Pragma("unroll") for (int e = 0; e < 4; ++e) v[4 * n + e] = acc[ai][bj][m][n][e];
struct EpiYA {
    static constexpr bool PERM = false, AFTER_DRAIN = false; bf16_t* G; int dry; bf16_t* Gs;
    DI void operator()(const pg8::f32x4 (&acc)[2][2][4][2], const pg8::Unit& u, int wr, int wc, int fr, int fq) const {
        asm volatile("" : "+v"(fr), "+v"(fq));
        EPI_ROWS_BEGIN EPI_COLS_BEGIN
            bf16_t* p = G + (size_t)row * 1024 + col; float g[8]; unpack8(*(const u32x4*)p, g);
#pragma unroll
            for (int k = 0; k < 8; ++k) v[k] *= g[k];
            if (!dry) *(u32x4*)p = pack8(v);
        } }
    }
    DI void mini(int row, int col, f32x4 s) const {
        bf16_t* p = Gs + (size_t)(row - MP) * 1024 + col; const u32x2 g = *(const u32x2*)p;
        u32x2 w; w.x = pk2(s.x * bflo(g.x), s.y * bfhi(g.x)); w.y = pk2(s.z * bflo(g.y), s.w * bfhi(g.y)); if (!dry) *(u32x2*)p = w;
    }
};
struct EpiYB {
    static constexpr bool PERM = false, AFTER_DRAIN = false; const bf16_t* YA; bf16_t* G; int dry; const bf16_t* YAs; bf16_t* Gs;
    DI void operator()(const pg8::f32x4 (&acc)[2][2][4][2], const pg8::Unit& u, int wr, int wc, int fr, int fq) const {
        asm volatile("" : "+v"(fr), "+v"(fq));
        EPI_ROWS_BEGIN EPI_COLS_BEGIN
            bf16_t* p = G + (size_t)row * 1024 + col; float g[8], ya[8]; unpack8(*(const u32x4*)p, g); unpack8(*(const u32x4*)(YA + (size_t)row * 1024 + col), ya);
#pragma unroll
            for (int k = 0; k < 8; ++k) v[k] = ya[k] + v[k] * g[k];
            if (!dry) *(u32x4*)p = pack8(v);
        } }
    }
    DI void mini(int row, int col, f32x4 s) const {
        bf16_t* p = Gs + (size_t)(row - MP) * 1024 + col; const u32x2 g = *(const u32x2*)p, y = *(const u32x2*)(YAs + (size_t)(row - MP) * 1024 + col);
        u32x2 w; w.x = pk2(bflo(y.x) + s.x * bflo(g.x), bfhi(y.x) + s.y * bfhi(g.x)); w.y = pk2(bflo(y.y) + s.z * bflo(g.y), bfhi(y.y) + s.w * bfhi(g.y)); if (!dry) *(u32x2*)p = w;
    }
};
struct EpiOut {
    static constexpr bool PERM = false, AFTER_DRAIN = false; const float* xp; const float* xs; float* out; bf16_t* xb; float* sq; int dry;
    DI void operator()(const pg8::f32x4 (&acc)[2][2][4][2], const pg8::Unit& u, int wr, int wc, int fr, int fq) const {
        asm volatile("" : "+v"(fr), "+v"(fq));
        EPI_ROWS_BEGIN
            const float* base = row < MP ? xp + (size_t)row * 1024 : xs + (size_t)(row - MP) * 1024; float ss = 0.f;
            EPI_COLS_BEGIN
                const f32x4 b0 = *(const f32x4*)(base + col), b1 = *(const f32x4*)(base + col + 4);
                v[0] += b0.x; v[1] += b0.y; v[2] += b0.z; v[3] += b0.w; v[4] += b1.x; v[5] += b1.y; v[6] += b1.z; v[7] += b1.w;
#pragma unroll
                for (int k = 0; k < 8; ++k) ss += v[k] * v[k];
                if (!dry) { float* o = out + (size_t)row * 1024 + col; *(f32x4*)o = (f32x4){v[0], v[1], v[2], v[3]}; *(f32x4*)(o + 4) = (f32x4){v[4], v[5], v[6], v[7]};
                *(u32x4*)(xb + (size_t)row * 1024 + col) = pack8(v); }
            }
            ss += __shfl_xor(ss, 16); ss += __shfl_xor(ss, 32);
            if (fq == 0 && !dry) sq[(size_t)row * 16 + 4 * u.pn + wc] = ss;
        }
    }
    DI void mini(int row, int col, f32x4 s) const {
        const float* base = row < MP ? xp + (size_t)row * 1024 : xs + (size_t)(row - MP) * 1024; const f32x4 b0 = *(const f32x4*)(base + col);
        const f32x4 x = s + b0; float ss = (x.x * x.x + x.y * x.y) + (x.z * x.z + x.w * x.w);
        ss += __shfl_xor(ss, 1); ss += __shfl_xor(ss, 2); ss += __shfl_xor(ss, 4); ss += __shfl_xor(ss, 8);
        if (!dry) { *(f32x4*)(out + (size_t)row * 1024 + col) = x; u32x2 w; w.x = pk2(x.x, x.y); w.y = pk2(x.z, x.w); *(u32x2*)(xb + (size_t)row * 1024 + col) = w;
            if ((col & 63) == 0) sq[(size_t)row * 16 + (col >> 6)] = ss; }
    }
};
struct EpiP {
    static constexpr bool PERM = false, AFTER_DRAIN = false; float* PT; int dry;
    DI void operator()(const pg8::f32x4 (&acc)[2][2][4][2], const pg8::Unit& u, int wr, int wc, int fr, int fq) const {
        asm volatile("" : "+v"(fr), "+v"(fq));
        EPI_ROWS_BEGIN EPI_COLS_BEGIN
            if (!dry) { float* o = PT + (size_t)row * 1024 + col; *(f32x4*)o = (f32x4){v[0], v[1], v[2], v[3]}; *(f32x4*)(o + 4) = (f32x4){v[4], v[5], v[6], v[7]}; }
        } }
    }
    DI void mini(int row, int col, f32x4 s) const { if (!dry) *(f32x4*)(PT + (size_t)row * 1024 + col) = s; }
};
struct EpiGate {
    static constexpr bool PERM = false, AFTER_DRAIN = false; const float* sq1; const float* PT; float* out; bf16_t* xb; float* sq2; int dry;
    DI void operator()(const pg8::f32x4 (&acc)[2][2][4][2], const pg8::Unit& u, int wr, int wc, int fr, int fq) const {
        asm volatile("" : "+v"(fr), "+v"(fq));
        EPI_ROWS_BEGIN
            const float rs = row_rstd(sq1, row); float ss = 0.f;
            EPI_COLS_BEGIN
                float* o = out + (size_t)row * 1024 + col; const float* pt = PT + (size_t)row * 1024 + col;
                const f32x4 b0 = *(const f32x4*)o, b1 = *(const f32x4*)(o + 4), p0 = *(const f32x4*)pt, p1 = *(const f32x4*)(pt + 4);
                const float xb_[8] = {b0.x, b0.y, b0.z, b0.w, b1.x, b1.y, b1.z, b1.w}, pp[8] = {p0.x, p0.y, p0.z, p0.w, p1.x, p1.y, p1.z, p1.w};
#pragma unroll
                for (int k = 0; k < 8; ++k) { v[k] = xb_[k] + sigm(v[k] * rs) * pp[k]; ss += v[k] * v[k]; }
                if (!dry) { *(f32x4*)o = (f32x4){v[0], v[1], v[2], v[3]}; *(f32x4*)(o + 4) = (f32x4){v[4], v[5], v[6], v[7]};
                *(u32x4*)(xb + (size_t)row * 1024 + col) = pack8(v); }
            }
            ss += __shfl_xor(ss, 16); ss += __shfl_xor(ss, 32);
            if (fq == 0 && !dry) sq2[(size_t)row * 16 + 4 * u.pn + wc] = ss;
        }
    }
    DI void mini(int row, int col, f32x4 s) const {
        const float rs = row_rstd(sq1, row); float* o = out + (size_t)row * 1024 + col; const f32x4 b0 = *(const f32x4*)o, p0 = *(const f32x4*)(PT + (size_t)row * 1024 + col);
        f32x4 x; x.x = b0.x + sigm(s.x * rs) * p0.x; x.y = b0.y + sigm(s.y * rs) * p0.y; x.z = b0.z + sigm(s.z * rs) * p0.z; x.w = b0.w + sigm(s.w * rs) * p0.w;
        float ss = (x.x * x.x + x.y * x.y) + (x.z * x.z + x.w * x.w);
        ss += __shfl_xor(ss, 1); ss += __shfl_xor(ss, 2); ss += __shfl_xor(ss, 4); ss += __shfl_xor(ss, 8);
        if (!dry) { *(f32x4*)o = x; u32x2 w; w.x = pk2(x.x, x.y); w.y = pk2(x.z, x.w); *(u32x2*)(xb + (size_t)row * 1024 + col) = w;
            if ((col & 63) == 0) sq2[(size_t)row * 16 + (col >> 6)] = ss; }
    }
};

struct OrderG {
    pg8::StaticOrder S; int G, c;
    DI void init(int G_, int c_) { S.init(MP, 13 * 256, G_, c_); G = G_; c = c_; }
    DI bool next(int i, pg8::Unit& u) const { if (S.next(i, u)) return true; const long s = (long)i * G + c - 64 * 13; if (s >= 2 * NWIN_T) return false; u.pm = 64 + (int)(s / NWIN_T); u.pn = (int)(s % NWIN_T); return true; }
    DI void a_ready(const pg8::Unit&) const {}
    DI void done(const pg8::Unit&) const {}
};
struct OrderM {
    pg8::StaticOrder S;
    DI void init(int G_, int c_) { S.init(MP, 1024, G_, c_); }
    DI bool next(int i, pg8::Unit& u) const { pg8::Unit v; if (!S.next(i >> 1, v)) return false; u.pm = v.pm; u.pn = 4 * (i & 1) + v.pn; return true; }
    DI void a_ready(const pg8::Unit&) const {}
    DI void done(const pg8::Unit&) const {}
};
template <class Epi> DI void run_gemm_m(LAS unsigned char* lds, const bf16_t* A, const bf16_t* Bt, const Epi& E) {
    int K = 1024; asm volatile("" : "+s"(K));
    pg8::Gemm g{A, Bt, MP, 8 * 256, K}; OrderM S; S.init((int)gridDim.x, (int)blockIdx.x);
    pg8::gemm_phase<Epi, OrderM, true, true>(lds, g, S, E);
}
template <class Epi> DI void run_gemm_g(LAS unsigned char* lds, const bf16_t* A, const bf16_t* Bt, const Epi& E) {
    int K = 1024; asm volatile("" : "+s"(K));
    pg8::Gemm g{A, Bt, MT, NWIN_T * 256, K}; OrderG S; S.init((int)gridDim.x, (int)blockIdx.x);
    pg8::gemm_phase<Epi, OrderG, true, true>(lds, g, S, E);
}
template <class Epi> DI void run_gemm(LAS unsigned char* lds, const bf16_t* A, const bf16_t* Bt, int M, int N, int K, const Epi& E) {
    asm volatile("" : "+s"(K), "+s"(N));
    pg8::Gemm g{A, Bt, M, N, K}; pg8::StaticOrder S; S.init(M, N, (int)gridDim.x, (int)blockIdx.x);
    pg8::gemm_phase<Epi, pg8::StaticOrder, true, true>(lds, g, S, E);
}

template <int K, class Epi> DI void mini_gemm(LAS unsigned char* lds, const bf16_t* A, const bf16_t* Wt, const Epi& E) {
    const int tid = otid(), lane = tid & 63, wave = __builtin_amdgcn_readfirstlane(tid >> 6), r = lane & 15, q = lane >> 4;
    constexpr int KW = K / 8;
    for (int mt = blockIdx.x; mt < 256; mt += gridDim.x) {
        const int row0 = 32 * (mt >> 4), cb = mt & 15, tile = cb >> 2, wcp = cb & 3, k0 = wave * KW;
        f32x4 acc[4][2];
#pragma unroll
        for (int ct = 0; ct < 4; ++ct) { acc[ct][0] = (f32x4){0.f, 0.f, 0.f, 0.f}; acc[ct][1] = (f32x4){0.f, 0.f, 0.f, 0.f}; }
#pragma unroll
        for (int ks = 0; ks < KW / 32; ++ks) {
            bf16x8 af[2], wf[4];
#pragma unroll
            for (int rt = 0; rt < 2; ++rt) af[rt] = *(const bf16x8*)(A + (size_t)(row0 + 16 * rt + r) * K + k0 + 32 * ks + 8 * q);
#pragma unroll
            for (int ct = 0; ct < 4; ++ct) { const int x = 16 * ct + r, p = 128 * (x >> 5) + 32 * wcp + 16 * ((x >> 2) & 1) + 4 * ((x >> 3) & 3) + (x & 3);
                wf[ct] = *(const bf16x8*)(Wt + (size_t)(tile * 256 + p) * K + k0 + 32 * ks + 8 * q); }
#pragma unroll
            for (int ct = 0; ct < 4; ++ct)
#pragma unroll
                for (int rt = 0; rt < 2; ++rt) acc[ct][rt] = __builtin_amdgcn_mfma_f32_16x16x32_bf16(wf[ct], af[rt], acc[ct][rt], 0, 0, 0);
        }
        LAS float* part = (LAS float*)lds + wave * (32 * 68);
#pragma unroll
        for (int ct = 0; ct < 4; ++ct)
#pragma unroll
            for (int rt = 0; rt < 2; ++rt) *(LAS f32x4*)(part + (16 * rt + r) * 68 + 16 * ct + 4 * q) = acc[ct][rt];
        __syncthreads();
        { const int row = tid >> 4, c4 = (tid & 15) * 4; f32x4 s = (f32x4){0.f, 0.f, 0.f, 0.f};
#pragma unroll
          for (int w = 0; w < 8; ++w) s += *(const LAS f32x4*)((const LAS float*)lds + w * (32 * 68) + row * 68 + c4);
          E.mini(MP + row0 + row, 64 * cb + c4, s); }
        __syncthreads();
    }
}

struct Args { const float* in[21]; float* out; unsigned char* ws; int ph_lo, ph_hi; };
static_assert(sizeof(Args) == 192, "Args layout (kin/kout/kws offsets)");
enum { I_XP = 0, I_XS, I_STATE, I_CK, I_CV, I_PP, I_PS, I_NORMG, I_WIN, I_WGU, I_BG, I_GLAG, I_QG, I_KG, I_RELB, I_WA, I_WB, I_WO, I_PLEG, I_WPG, I_WPLE };

DI void transpose_item(const float* W, int ldw, int srccol0, int nvalid, const float* gain, bf16_t* WT, int K, int rowbase, int k0, LAS float* scr, int lane) {
#pragma unroll 16
    for (int i = 0; i < 32; ++i) { const int kk = 2 * i + (lane >> 5), c = lane & 31;
        float w = 0.f; if (c < nvalid) w = W[(size_t)(k0 + kk) * ldw + srccol0 + c]; if (gain) w *= gain[k0 + kk];
        scr[kk * 33 + c] = w; }
    asm volatile("s_waitcnt lgkmcnt(0)" ::: "memory");
    const int c8 = lane & 7;
#pragma unroll
    for (int j = 0; j < 4; ++j) { const int n = (lane >> 3) + 8 * j; const LAS float* s = scr + (8 * c8) * 33 + n;
        u32x4 o; o.x = pk2(s[0 * 33], s[1 * 33]); o.y = pk2(s[2 * 33], s[3 * 33]); o.z = pk2(s[4 * 33], s[5 * 33]); o.w = pk2(s[6 * 33], s[7 * 33]);
        const int prow = 16 * ((n >> 2) & 1) + 4 * (n >> 3) + (n & 3);
        *(u32x4*)(WT + (size_t)(rowbase + prow) * K + k0 + 8 * c8) = o; }
    asm volatile("s_waitcnt lgkmcnt(0)" ::: "memory");
}
DI int win_src(int t, int& nvalid) {
    nvalid = 256;
    if (t < 2) return t * 256; if (t < 4) return 512 + (t - 2) * 256; if (t < 8) return 1024 + (t - 4) * 256; if (t < 12) return 2064 + (t - 8) * 256;
    if (t == 12) { nvalid = 16; return 2048; }
    if (t < 17) return 3088 + (t - 13) * 256; if (t < 21) return 4112 + (t - 17) * 256; if (t < 25) return 5136 + (t - 21) * 256; if (t < 29) return 6160 + (t - 25) * 256;
    if (t < 33) return 7184 + (t - 29) * 256; return 8208 + (t - 33) * 256;
}
DI void transpose_generic(const float* W, int ldw, int K, int ntile, bool is_win, const float* gain, bf16_t* WT, int item, LAS float* scr, int lane) {
    const int nkb = K / 64; const int kb = item % nkb, nb = (item / nkb) & 7, t = item / (nkb * 8);
    int nvalid = 256, src = t * 256; if (is_win) src = win_src(t, nvalid);
    int nv = nvalid - 32 * nb; nv = nv < 0 ? 0 : (nv > 32 ? 32 : nv);
    transpose_item(W, ldw, src + 32 * nb, nv, gain, WT, K, t * 256 + 128 * (nb & 1) + 32 * (nb >> 1), kb * 64, scr, lane);
}
constexpr int WIN_ITEMS = NWIN_T * 8 * 16, SQ_ITEMS = 4 * 8 * 16, PLE_ITEMS = 4 * 8 * 4;
constexpr int N_IN = 9232;
DI void prep_win(const Args& a, int L, int gw, int ngw, LAS float* scr, int lane) {
    bf16_t* WT = (bf16_t*)(kws() + WS_WIN);
    for (int it = gw; it < WIN_ITEMS; it += ngw) transpose_generic(kin(I_WIN) + (size_t)L * 1024 * N_IN, N_IN, 1024, NWIN_T, true, kin(I_NORMG) + L * 1024, WT, it, scr, lane);
}
DI bf16_t* wsm(const Args& a, int L, int which) { return (bf16_t*)(kws() + WS_WSM + (size_t)L * WSM_LAYER + (size_t)which * 2 * MiB); }
DI void prep_small(const Args& a, int gw, int ngw, LAS float* scr, int lane) {
    constexpr int PER_L = 4 * SQ_ITEMS + PLE_ITEMS;
    for (int it = gw; it < 2 * PER_L; it += ngw) {
        const int L = it / PER_L; int r = it % PER_L;
        if (r < SQ_ITEMS) { transpose_generic(kin(I_WA) + (size_t)L * 1048576, 1024, 1024, 4, false, nullptr, wsm(a, L, 0), r, scr, lane); continue; } r -= SQ_ITEMS;
        if (r < SQ_ITEMS) { transpose_generic(kin(I_WB) + (size_t)L * 1048576, 1024, 1024, 4, false, nullptr, wsm(a, L, 1), r, scr, lane); continue; } r -= SQ_ITEMS;
        if (r < SQ_ITEMS) { transpose_generic(kin(I_WO) + (size_t)L * 1048576, 1024, 1024, 4, false, nullptr, wsm(a, L, 2), r, scr, lane); continue; } r -= SQ_ITEMS;
        if (r < SQ_ITEMS) { transpose_generic(kin(I_WPG) + (size_t)L * 1048576, 1024, 1024, 4, false, kin(I_PLEG) + L * 1024, wsm(a, L, 3), r, scr, lane); continue; } r -= SQ_ITEMS;
        transpose_generic(kin(I_WPLE) + (size_t)L * 262144, 1024, 256, 4, false, nullptr, wsm(a, L, 4), r, scr, lane);
    }
}
DI float wave_sum(float v) {
#pragma unroll
    for (int o = 1; o < 64; o <<= 1) v += __shfl_xor(v, o);
    return v;
}
DI void prep_shift(int gw, int lane) {
    if (gw < 32) { const int L = gw >> 4, h = gw & 15;
        float mq = fabsf(kin(I_QG)[L * 64 + lane]), mk = fabsf(kin(I_KG)[L * 64 + lane]), mb = 0.f;
        for (int i = lane; i < 257; i += 64) mb = fmaxf(mb, fabsf(kin(I_RELB)[((size_t)L * 16 + h) * 257 + i]));
#pragma unroll
        for (int o = 1; o < 64; o <<= 1) { mq = fmaxf(mq, __shfl_xor(mq, o)); mk = fmaxf(mk, __shfl_xor(mk, o)); mb = fmaxf(mb, __shfl_xor(mb, o)); }
        if (lane == 0) ((float*)(kws() + WS_MSH))[gw] = (8.f * mq * mk + mb) * LOG2E; }
}
DI void prep_rows(const Args& a, int gw, int ngw, int lane) {
    bf16_t* XB = (bf16_t*)(kws() + WS_XB); float* SQ2 = (float*)(kws() + WS_SQ2);
    const float* xp = kin(I_XP); const float* xs = kin(I_XS);
    for (int row0 = gw; row0 < MT; row0 += 4 * ngw) {
        f32x4 v[4][4];
#pragma unroll
        for (int u = 0; u < 4; ++u) { const int row = row0 + u * ngw; if (row < MT) { const float* x = row < MP ? xp + (size_t)row * 1024 : xs + (size_t)(row - MP) * 1024;
#pragma unroll
            for (int j = 0; j < 4; ++j) v[u][j] = ((const f32x4*)x)[lane + 64 * j]; } }
#pragma unroll
        for (int u = 0; u < 4; ++u) { const int row = row0 + u * ngw; if (row < MT) { float s = 0.f;
#pragma unroll
            for (int j = 0; j < 4; ++j) s += (v[u][j].x * v[u][j].x + v[u][j].y * v[u][j].y) + (v[u][j].z * v[u][j].z + v[u][j].w * v[u][j].w);
            s = wave_sum(s);
            if (lane < 16) SQ2[(size_t)row * 16 + lane] = lane == 0 ? s : 0.f;
#pragma unroll
            for (int j = 0; j < 4; ++j) { u32x2 w; w.x = pk2(v[u][j].x, v[u][j].y); w.y = pk2(v[u][j].z, v[u][j].w); ((u32x2*)(XB + (size_t)row * 1024))[lane + 64 * j] = w; } } }
    }
}
DI void prep_misc(const Args& a, int gtid, int ngt) {
    bf16_t* PB = (bf16_t*)(kws() + WS_PB);
    const float* pp = kin(I_PP); const float* ps = kin(I_PS);
    for (int i0 = gtid; i0 < 2 * MT * 32; i0 += 4 * ngt) {
        f32x4 p0[4], p1[4];
#pragma unroll
        for (int k = 0; k < 4; ++k) { const int i = i0 + k * ngt; if (i < 2 * MT * 32) { const int c8 = i & 31, row = (i >> 5) % MT, L = (i >> 5) / MT;
            const float* src = row < MP ? pp + ((size_t)L * MP + row) * 256 + c8 * 8 : ps + ((size_t)L * MS + (row - MP)) * 256 + c8 * 8; p0[k] = *(const f32x4*)src; p1[k] = *(const f32x4*)(src + 4); } }
#pragma unroll
        for (int k = 0; k < 4; ++k) { const int i = i0 + k * ngt; if (i < 2 * MT * 32) { const int c8 = i & 31, row = (i >> 5) % MT, L = (i >> 5) / MT;
            u32x4 w; w.x = pk2(p0[k].x, p0[k].y); w.y = pk2(p0[k].z, p0[k].w); w.z = pk2(p1[k].x, p1[k].y); w.w = pk2(p1[k].z, p1[k].w);
            *(u32x4*)(PB + ((size_t)L * MT + row) * 256 + c8 * 8) = w; } }
    }
    constexpr int PER = 448 * 1024 / 4;
    const float* ck = kin(I_CK); const float* cv = kin(I_CV); float* out = kout();
    for (int i0 = gtid; i0 < 32 * PER; i0 += 8 * ngt) {
        f32x4 v[8];
#pragma unroll
        for (int k = 0; k < 8; ++k) { const int i = i0 + k * ngt; if (i < 32 * PER) { const int lb = i / PER, r = i % PER, kv = lb >> 4, l_b = lb & 15;
            v[k] = *((const f32x4*)((kv ? cv : ck) + (size_t)l_b * 512 * 1024 + 64 * 1024) + r); } }
#pragma unroll
        for (int k = 0; k < 8; ++k) { const int i = i0 + k * ngt; if (i < 32 * PER) { const int lb = i / PER, r = i % PER, kv = lb >> 4, l_b = lb & 15;
            *((f32x4*)(out + (kv ? O_VS : O_KS) + (size_t)l_b * 512 * 1024) + r) = v[k]; } }
    }
}

DI void gla_prep(const Args& a, int L, int c, int h, LAS float* totp, LAS float* ra_s, float (&b)[16], float& blast) {
    const int tid = otid(), d = tid & 127, jq = __builtin_amdgcn_readfirstlane(tid >> 7);
    if (tid < 256) *(LAS f32x4*)(ra_s + tid * 4) = *(const f32x4*)((const float*)(kws() + WS_RA) + (size_t)c * 64 * 16 + tid * 4);
    const float* wg = kin(I_WGU) + (size_t)L * 16 * 512 + h * 128 + d; float w[16];
#pragma unroll
    for (int r = 0; r < 16; ++r) w[r] = wg[r * 512];
    const float bg = kin(I_BG)[L * 512 + h * 128 + d];
    __syncthreads();
    float run = 0.f;
#pragma unroll
    for (int jj = 0; jj < 16; ++jj) {
        const LAS f32x4* rp = (const LAS f32x4*)(ra_s + (16 * jq + jj) * 16); const f32x4 r0 = rp[0], r1 = rp[1], r2 = rp[2], r3 = rp[3];
        float r = bg;
        r += r0.x * w[0]; r += r0.y * w[1]; r += r0.z * w[2]; r += r0.w * w[3]; r += r1.x * w[4]; r += r1.y * w[5]; r += r1.z * w[6]; r += r1.w * w[7];
        r += r2.x * w[8]; r += r2.y * w[9]; r += r2.z * w[10]; r += r2.w * w[11]; r += r3.x * w[12]; r += r3.y * w[13]; r += r3.z * w[14]; r += r3.w * w[15];
        const float lg = (fminf(r, 0.f) - __logf(1.f + __expf(-fabsf(r)))) * (1.f / 16.f);
        run += lg; b[jj] = run;
    }
    totp[jq * 128 + d] = run;
    __syncthreads();
    const float t0 = totp[d], t1 = totp[128 + d], t2 = totp[256 + d], t3 = totp[384 + d];
    const float off = jq == 0 ? 0.f : jq == 1 ? t0 : jq == 2 ? t0 + t1 : t0 + t1 + t2;
    blast = (t0 + t1) + (t2 + t3);
#pragma unroll
    for (int jj = 0; jj < 16; ++jj) b[jj] += off;
    if (jq == 0) totp[512 + d] = blast;
}
DI bf16x8 lds16(const LAS unsigned char* p) { return *(const LAS bf16x8*)p; }
DI s16x4 lds8(const LAS unsigned char* p) { return *(const LAS s16x4*)p; }
DI void vt_load(const bf16_t* VT, u32x4 (&vr)[4]) {
    const int tid = otid();
#pragma unroll
    for (int k = 0; k < 4; ++k) vr[k] = *(const u32x4*)(VT + (size_t)(tid + 512 * k) * 8);
}
DI void vt_store(const u32x4 (&vr)[4], LAS unsigned char* vt) {
    const int tid = otid();
#pragma unroll
    for (int k = 0; k < 4; ++k) { const int i = tid + 512 * k; *(LAS u32x4*)(vt + ((i >> 3) * 72 + (i & 7) * 8) * 2) = vr[k]; }
}
constexpr int GA_KT = 0, GA_VT = 18432, GA_TOT = 55296;
DI void gla_a_phase(const Args& a, int L, LAS unsigned char* lds, int item_lo, int item_hi, int first_wg) {
    const int tid = otid(), lane = tid & 63, wave = __builtin_amdgcn_readfirstlane(tid >> 6), r = lane & 15, q = lane >> 4;
    const bf16_t* KA = (const bf16_t*)(kws() + WS_OV + 2 * SLOT) + (size_t)MT * 512; const bf16_t* VA = (const bf16_t*)(kws() + WS_OV + 1 * SLOT);
    bf16_t* ST = (bf16_t*)(kws() + WS_OV + 3 * SLOT); float* DC = (float*)(kws() + WS_DC);
    LAS float* totp = (LAS float*)(lds + GA_TOT);
    int wg0_ = (int)blockIdx.x - first_wg; if (wg0_ < 0) wg0_ += (int)gridDim.x;
    for (int item = item_lo + wg0_; item < item_hi; item += gridDim.x) {
        const int c = item >> 2, h = item & 3;
        const int d = tid & 127, jq = tid >> 7;
        bf16_t kraw[16]; u32x4 vr[4];
#pragma unroll
        for (int jj = 0; jj < 16; ++jj) kraw[jj] = KA[((size_t)c * 64 + 16 * jq + jj) * 512 + h * 128 + d];
        vt_load(VA + (size_t)(c * 4 + h) * 16384, vr);
        float b[16], blast; gla_prep(a, L, c, h, totp, (LAS float*)(lds + GA_VT), b, blast);
        { float kd[16];
#pragma unroll
          for (int jj = 0; jj < 16; ++jj) kd[jj] = bf2f(kraw[jj]) * __expf(blast - b[jj]);
          LAS u32x4* o = (LAS u32x4*)(lds + GA_KT + (d * 72 + 16 * jq) * 2); o[0] = pack8(kd); o[1] = pack8(kd + 8); }
        if (jq == 0) DC[(size_t)item * 128 + d] = __expf(blast);
        vt_store(vr, lds + GA_VT);
        __syncthreads();
        f32x4 acc[8][2];
#pragma unroll
        for (int dt = 0; dt < 8; ++dt) { acc[dt][0] = (f32x4){0.f, 0.f, 0.f, 0.f}; acc[dt][1] = (f32x4){0.f, 0.f, 0.f, 0.f}; }
#pragma unroll
        for (int s = 0; s < 2; ++s) {
            bf16x8 bv[2];
#pragma unroll
            for (int vt = 0; vt < 2; ++vt) bv[vt] = lds16(lds + GA_VT + ((32 * wave + 16 * vt + r) * 72 + 32 * s + 8 * q) * 2);
#pragma unroll
            for (int dt = 0; dt < 8; ++dt) { const bf16x8 ak = lds16(lds + GA_KT + ((16 * dt + r) * 72 + 32 * s + 8 * q) * 2);
#pragma unroll
                for (int vt = 0; vt < 2; ++vt) acc[dt][vt] = __builtin_amdgcn_mfma_f32_16x16x32_bf16(ak, bv[vt], acc[dt][vt], 0, 0, 0); }
        }
        if (c < NPC) {
#pragma unroll
            for (int vt = 0; vt < 2; ++vt)
#pragma unroll
                for (int dt = 0; dt < 8; ++dt) { u32x2 w; w.x = pk2(acc[dt][vt][0], acc[dt][vt][1]); w.y = pk2(acc[dt][vt][2], acc[dt][vt][3]);
                    *(u32x2*)(ST + (size_t)item * 32768 + (32 * wave + 16 * vt + r) * 128 + 16 * dt + 4 * q) = w; }
        } else {
            const int bb = c - NPC; const size_t so = (((size_t)L * 8 + bb) * 4 + h) * 32768;
            const float* s0 = kin(I_STATE) + so; float* s1 = kout() + O_SS + so;
#pragma unroll
            for (int dt = 0; dt < 8; ++dt)
#pragma unroll
                for (int e = 0; e < 4; ++e) { const int dd = 16 * dt + 4 * q + e; const float dc = __expf(totp[512 + dd]);
#pragma unroll
                    for (int vt = 0; vt < 2; ++vt) { const int v = 32 * wave + 16 * vt + r; s1[dd * 256 + v] = dc * s0[dd * 256 + v] + acc[dt][vt][e]; } }
        }
        __syncthreads();
    }
}
DI void gla_scan_phase(const Args& a, int L, int dry) {
    bf16_t* ST = (bf16_t*)(kws() + WS_OV + 3 * SLOT); const float* DC = (const float*)(kws() + WS_DC);
    int wg = (int)blockIdx.x, nwg = (int)gridDim.x;
    if (nwg >= 256) { wg -= 128; nwg -= 128; if (wg < 0) return; }
    const int ngt = nwg * NTHREADS;
    for (int gt = wg * NTHREADS + otid(); gt < 16 * 8192; gt += ngt) {
        const int bh = gt >> 13, e4 = gt & 8191, bb = bh >> 2, h = bh & 3, d = (4 * e4) & 127, v = (4 * e4) >> 7;
        float run[4] = {0.f, 0.f, 0.f, 0.f};
        for (int n0 = 0; n0 < 64; n0 += 8) {
            u32x2 cur[8]; f32x4 dc[8];
#pragma unroll
            for (int k = 0; k < 8; ++k) { const size_t it = (size_t)(bb * 64 + n0 + k) * 4 + h; cur[k] = *(const u32x2*)(ST + it * 32768 + 4 * e4); dc[k] = *(const f32x4*)(DC + it * 128 + d); }
#pragma unroll
            for (int k = 0; k < 8; ++k) { const size_t it = (size_t)(bb * 64 + n0 + k) * 4 + h;
                u32x2 w; w.x = pk2(run[0], run[1]); w.y = pk2(run[2], run[3]); if (!dry || run[0] == 1.2345e30f) *(u32x2*)(ST + it * 32768 + 4 * e4) = w;
                run[0] = dc[k].x * run[0] + bflo(cur[k].x); run[1] = dc[k].y * run[1] + bfhi(cur[k].x); run[2] = dc[k].z * run[2] + bflo(cur[k].y); run[3] = dc[k].w * run[3] + bfhi(cur[k].y); }
        }
        float* o = kout() + O_SP + (((size_t)L * 4 + bb) * 4 + h) * 32768;
#pragma unroll
        for (int e = 0; e < 4; ++e) if (!dry || run[e] == 1.2345e30f) o[(d + e) * 256 + v] = run[e];
    }
}
constexpr int GC_QS = 0, GC_KS = 17408, GC_VT = 34816, GC_SS = 71680, GC_TOT = 141312, GC_RED = 143872;
DI void gla_c_phase(const Args& a, int L, LAS unsigned char* lds, int dry, int item_lo, int item_hi, int first_wg) {
    const int tid = otid(), lane = tid & 63, wave = __builtin_amdgcn_readfirstlane(tid >> 6), r = lane & 15, q = lane >> 4, it = wave & 3, vh = wave >> 2;
    const bf16_t* QA = (const bf16_t*)(kws() + WS_OV + 2 * SLOT); const bf16_t* KA = QA + (size_t)MT * 512; const bf16_t* VA = (const bf16_t*)(kws() + WS_OV + 1 * SLOT);
    bf16_t* SGA = (bf16_t*)(kws() + WS_OV); const bf16_t* ST = (const bf16_t*)(kws() + WS_OV + 3 * SLOT);
    LAS float* totp = (LAS float*)(lds + GC_TOT); LAS float* red = (LAS float*)(lds + GC_RED);
    const float* gg = kin(I_GLAG) + L * 256;
    int wg0_ = (int)blockIdx.x - first_wg; if (wg0_ < 0) wg0_ += (int)gridDim.x;
    for (int item = item_lo + wg0_; item < item_hi; item += gridDim.x) {
        const int c = item >> 2, h = item & 3;
        const int d = tid & 127, jq = tid >> 7;
        bf16_t qraw[16], kraw[16]; u32x4 vr[4], sr[8];
#pragma unroll
        for (int jj = 0; jj < 16; ++jj) { const size_t g = ((size_t)c * 64 + 16 * jq + jj) * 512 + h * 128 + d; qraw[jj] = QA[g]; kraw[jj] = KA[g]; }
        vt_load(VA + (size_t)(c * 4 + h) * 16384, vr);
        if (c < NPC) { const bf16_t* s = ST + (size_t)item * 32768;
#pragma unroll
            for (int k = 0; k < 8; ++k) sr[k] = *(const u32x4*)(s + (size_t)(tid + 512 * k) * 8); }
        float b[16], blast; gla_prep(a, L, c, h, totp, (LAS float*)(lds + GC_SS), b, blast);
#pragma unroll
        for (int jj = 0; jj < 16; ++jj) { const int j = 16 * jq + jj; const float eb = __expf(b[jj]);
            ((LAS bf16_t*)(lds + GC_QS))[j * 136 + d] = (bf16_t)pk2(bf2f(qraw[jj]) * eb, 0.f);
            ((LAS bf16_t*)(lds + GC_KS))[j * 136 + d] = (bf16_t)pk2(bf2f(kraw[jj]) * __builtin_amdgcn_rcpf(eb), 0.f); }
        vt_store(vr, lds + GC_VT);
        if (c < NPC) {
#pragma unroll
            for (int k = 0; k < 8; ++k) { const int i = tid + 512 * k, v = i >> 4, c8 = i & 15; *(LAS u32x4*)(lds + GC_SS + (v * 136 + c8 * 8) * 2) = sr[k]; }
        } else {
            const float* s0 = kin(I_STATE) + ((((size_t)L * 8 + (c - NPC)) * 4 + h) * 32768);
            for (int i = tid; i < 8192; i += NTHREADS) { const int dd = i & 127, v4 = i >> 7; const f32x4 s = *(const f32x4*)(s0 + dd * 256 + v4 * 4); LAS bf16_t* o = (LAS bf16_t*)(lds + GC_SS) + (v4 * 4) * 136 + dd;
                o[0] = (bf16_t)pk2(s.x, 0.f); o[136] = (bf16_t)pk2(s.y, 0.f); o[272] = (bf16_t)pk2(s.z, 0.f); o[408] = (bf16_t)pk2(s.w, 0.f); }
        }
        __syncthreads();
        bf16_t* orow = SGA + ((size_t)c * 64 + 16 * it + r) * 1024 + h * 256;
        u32x2 gate[8];
#pragma unroll
        for (int vt = 0; vt < 8; ++vt) gate[vt] = *(const u32x2*)(orow + 128 * vh + 16 * vt + 4 * q);
        bf16x8 bq[4];
#pragma unroll
        for (int ks = 0; ks < 4; ++ks) bq[ks] = lds16(lds + GC_QS + ((16 * it + r) * 136 + 32 * ks + 8 * q) * 2);
        f32x4 at[4];
#pragma unroll
        for (int jt = 0; jt < 4; ++jt) { at[jt] = (f32x4){0.f, 0.f, 0.f, 0.f};
            if (jt <= it) {
#pragma unroll
                for (int ks = 0; ks < 4; ++ks) at[jt] = __builtin_amdgcn_mfma_f32_16x16x32_bf16(lds16(lds + GC_KS + ((16 * jt + r) * 136 + 32 * ks + 8 * q) * 2), bq[ks], at[jt], 0, 0, 0);
                if (jt == it) {
#pragma unroll
                    for (int e = 0; e < 4; ++e) if (4 * q + e > r) at[jt][e] = 0.f;
                } } }
        bf16x8 bp[2];
#pragma unroll
        for (int s = 0; s < 2; ++s) { u32x4 w; w.x = pk2(at[2 * s][0], at[2 * s][1]); w.y = pk2(at[2 * s][2], at[2 * s][3]); w.z = pk2(at[2 * s + 1][0], at[2 * s + 1][1]); w.w = pk2(at[2 * s + 1][2], at[2 * s + 1][3]); bp[s] = __builtin_bit_cast(bf16x8, w); }
        f32x4 o[8];
#pragma unroll
        for (int vt = 0; vt < 8; ++vt) { o[vt] = (f32x4){0.f, 0.f, 0.f, 0.f}; const int v = 128 * vh + 16 * vt + r;
#pragma unroll
            for (int s = 0; s < 2; ++s) if (2 * s <= it) { const s16x4 lo = lds8(lds + GC_VT + (v * 72 + 32 * s + 4 * q) * 2), hi = lds8(lds + GC_VT + (v * 72 + 32 * s + 16 + 4 * q) * 2);
                const bf16x8 av = __builtin_shufflevector(lo, hi, 0, 1, 2, 3, 4, 5, 6, 7); o[vt] = __builtin_amdgcn_mfma_f32_16x16x32_bf16(av, bp[s], o[vt], 0, 0, 0); }
#pragma unroll
            for (int ks = 0; ks < 4; ++ks) o[vt] = __builtin_amdgcn_mfma_f32_16x16x32_bf16(lds16(lds + GC_SS + (v * 136 + 32 * ks + 8 * q) * 2), bq[ks], o[vt], 0, 0, 0); }
        float ss = 0.f;
#pragma unroll
        for (int vt = 0; vt < 8; ++vt) ss += (o[vt][0] * o[vt][0] + o[vt][1] * o[vt][1]) + (o[vt][2] * o[vt][2] + o[vt][3] * o[vt][3]);
        ss += __shfl_xor(ss, 16); ss += __shfl_xor(ss, 32);
        if (q == 0) red[vh * 64 + 16 * it + r] = ss;
        __syncthreads();
        const float rstd = rsqrtf((red[16 * it + r] + red[64 + 16 * it + r]) * (1.f / 256.f) + EPS);
#pragma unroll
        for (int vt = 0; vt < 8; ++vt) { const int v = 128 * vh + 16 * vt + 4 * q; const u32x2 g = gate[vt]; const f32x4 gn = *(const f32x4*)(gg + v);
            u32x2 w; w.x = pk2(o[vt][0] * rstd * gn.x * bflo(g.x), o[vt][1] * rstd * gn.y * bfhi(g.x)); w.y = pk2(o[vt][2] * rstd * gn.z * bflo(g.y), o[vt][3] * rstd * gn.w * bfhi(g.y));
            if (!dry || rstd == 1.2345e30f) *(u32x2*)(orow + v) = w; }
        __syncthreads();
    }
}

constexpr int AT_KS = 0, AT_VT = 36864, AT_BIAS = 73728, AT_BUF = 18432;
template <bool SAMPLE> DI void attn_load_k(int L, const bf16_t* KB, const float* ck, int bb, int n, int t, int hh, int sj, int sdq, u32x4& w0, u32x4& w1) {
    if (SAMPLE && t < 8) { const float* s = ck + (((size_t)L * 8 + bb) * 512 + t * 64 + sj) * 1024 + hh * 64 + 16 * sdq;
        const f32x4 f0 = *(const f32x4*)s, f1 = *(const f32x4*)(s + 4), f2 = *(const f32x4*)(s + 8), f3 = *(const f32x4*)(s + 12);
        w0.x = pk2(f0.x, f0.y); w0.y = pk2(f0.z, f0.w); w0.z = pk2(f1.x, f1.y); w0.w = pk2(f1.z, f1.w); w1.x = pk2(f2.x, f2.y); w1.y = pk2(f2.z, f2.w); w1.z = pk2(f3.x, f3.y); w1.w = pk2(f3.z, f3.w);
    } else { const size_t krow = SAMPLE ? (size_t)bb * 64 + sj : (size_t)bb * 4096 + (n - 8 + t) * 64 + sj; const bf16_t* s = KB + krow * 1024 + hh * 64 + 16 * sdq; w0 = *(const u32x4*)s; w1 = *(const u32x4*)(s + 8); }
}
template <bool SAMPLE> DI void attn_load_v(int L, const bf16_t* VBT, const float* cv, int bb, int n, int t, int hh, int tid, u32x4& w0, u32x4& w1) {
    if (SAMPLE && t < 8) { const int sj2 = tid & 63, dq2 = (tid >> 6) & 3; const float* s = cv + (((size_t)L * 8 + bb) * 512 + t * 64 + sj2) * 1024 + hh * 64 + 16 * dq2;
        const f32x4 f0 = *(const f32x4*)s, f1 = *(const f32x4*)(s + 4), f2 = *(const f32x4*)(s + 8), f3 = *(const f32x4*)(s + 12);
        w0.x = pk2(f0.x, f0.y); w0.y = pk2(f0.z, f0.w); w0.z = pk2(f1.x, f1.y); w0.w = pk2(f1.z, f1.w); w1.x = pk2(f2.x, f2.y); w1.y = pk2(f2.z, f2.w); w1.z = pk2(f3.x, f3.y); w1.w = pk2(f3.z, f3.w);
    } else { const int cc = SAMPLE ? bb : bb * 64 + (n - 8 + t); const bf16_t* s = VBT + ((size_t)cc * 16 + hh) * 4096 + (size_t)(tid & 255) * 8; w0 = *(const u32x4*)s; w1 = *(const u32x4*)(s + 2048); }
}
template <bool SAMPLE> DI void attn_item(const Args& a, int L, LAS unsigned char* lds, int dry, int item, bool stage_bias) {
    const int tid = otid(), lane = tid & 63, wave = __builtin_amdgcn_readfirstlane(tid >> 6), r = lane & 15, q = lane >> 4, g = wave >> 2, it = wave & 3;
    const bf16_t* QB = (const bf16_t*)(kws() + (SAMPLE ? WS_AX : WS_OV + 1 * SLOT)); const bf16_t* KB = (const bf16_t*)(kws() + (SAMPLE ? WS_AX + 1 * MiB : WS_OV + 2 * SLOT));
    const bf16_t* VB = (const bf16_t*)(kws() + (SAMPLE ? WS_AX + 2 * MiB : WS_OV + 3 * SLOT)); const bf16_t* GBs = (const bf16_t*)(kws() + (SAMPLE ? WS_AX + 3 * MiB : WS_OV + 4 * SLOT));
    bf16_t* SGB = (bf16_t*)(kws() + WS_OV + 4 * SLOT);
    const float* ck = kin(I_CK); const float* cv = kin(I_CV);
    LAS float* bias_s = (LAS float*)(lds + AT_BIAS);
    const int sg = tid >> 8, sj = (tid >> 2) & 63, sdq = tid & 3;
    const int c = item >> 3, hp = item & 7, h = 2 * hp + g;
    const int bb = SAMPLE ? c - NPC : c >> 6, n = SAMPLE ? 8 : c & 63, t0 = n >= 8 ? 0 : 8 - n;
    if (stage_bias) { const float* msh = (const float*)(kws() + WS_MSH) + L * 16 + 2 * hp;
    for (int i = tid; i < 2 * 257; i += NTHREADS) { const int g2 = i / 257, idx = i % 257; bias_s[g2 * 260 + idx] = kin(I_RELB)[((size_t)L * 16 + 2 * hp + g2) * 257 + idx] * LOG2E - msh[g2]; } }
    const size_t qrow = (size_t)c * 64 + 16 * it + r, qrl = SAMPLE ? qrow - MP : qrow;
    bf16x8 qf[2];
#pragma unroll
    for (int ks = 0; ks < 2; ++ks) qf[ks] = *(const bf16x8*)(QB + qrl * 1024 + h * 64 + 32 * ks + 8 * q);
    const int qi = 16 * it + r;
    bf16_t* orow = SGB + qrow * 1024 + h * 64;
    float l_run = 0.f;
    f32x4 o[4];
#pragma unroll
    for (int dt = 0; dt < 4; ++dt) o[dt] = (f32x4){0.f, 0.f, 0.f, 0.f};
    u32x4 k0, k1, v0, v1;
#define ATT_LOADT(T_) do { attn_load_k<SAMPLE>(L, KB, ck, bb, n, (T_), 2 * hp + sg, sj, sdq, k0, k1); attn_load_v<SAMPLE>(L, VB, cv, bb, n, (T_), 2 * hp + sg, tid, v0, v1); } while (0)
#define ATT_WRITE(T_, BUF_) do { const int bo_ = (BUF_) * AT_BUF; \
        LAS u32x4* ok = (LAS u32x4*)(lds + AT_KS + bo_ + ((sg * 64 + sj) * 72 + 16 * sdq) * 2); ok[0] = k0; ok[1] = k1; \
        if (SAMPLE && (T_) < 8) { const int sj2 = tid & 63, dq2 = (tid >> 6) & 3; LAS bf16_t* ov = (LAS bf16_t*)(lds + AT_VT + bo_) + (sg * 64 + 16 * dq2) * 72 + sj2; \
            ov[0] = (bf16_t)v0.x; ov[72] = (bf16_t)(v0.x >> 16); ov[144] = (bf16_t)v0.y; ov[216] = (bf16_t)(v0.y >> 16); ov[288] = (bf16_t)v0.z; ov[360] = (bf16_t)(v0.z >> 16); ov[432] = (bf16_t)v0.w; ov[504] = (bf16_t)(v0.w >> 16); \
            ov[576] = (bf16_t)v1.x; ov[648] = (bf16_t)(v1.x >> 16); ov[720] = (bf16_t)v1.y; ov[792] = (bf16_t)(v1.y >> 16); ov[864] = (bf16_t)v1.z; ov[936] = (bf16_t)(v1.z >> 16); ov[1008] = (bf16_t)v1.w; ov[1080] = (bf16_t)(v1.w >> 16); \
        } else { const int p0 = tid & 255, p1 = p0 + 256; \
            *(LAS u32x4*)(lds + AT_VT + bo_ + ((sg * 64 + (p0 >> 3)) * 72 + (p0 & 7) * 8) * 2) = v0; *(LAS u32x4*)(lds + AT_VT + bo_ + ((sg * 64 + (p1 >> 3)) * 72 + (p1 & 7) * 8) * 2) = v1; } } while (0)
    ATT_LOADT(t0);
    ATT_WRITE(t0, 0);
    if (t0 + 1 < 9) ATT_LOADT(t0 + 1);
    __syncthreads();
#pragma unroll 1
    for (int t = t0; t < 9; ++t) {
        const int cb = (t - t0) & 1;
        if (t + 1 < 9) { ATT_WRITE(t + 1, cb ^ 1); if (t + 2 < 9) ATT_LOADT(t + 2); }
        const LAS unsigned char* kb_ = lds + AT_KS + cb * AT_BUF; const LAS unsigned char* vb_ = lds + AT_VT + cb * AT_BUF;
        f32x4 sc[4];
#pragma unroll
        for (int jt = 0; jt < 4; ++jt) { f32x4 acc = (f32x4){0.f, 0.f, 0.f, 0.f};
#pragma unroll
            for (int ks = 0; ks < 2; ++ks) acc = __builtin_amdgcn_mfma_f32_16x16x32_bf16(lds16(kb_ + ((g * 64 + 16 * jt + r) * 72 + 32 * ks + 8 * q) * 2), qf[ks], acc, 0, 0, 0);
            sc[jt] = acc; }
        if (t >= 6) {
#pragma unroll
            for (int jt = 0; jt < 4; ++jt)
#pragma unroll
                for (int e = 0; e < 4; ++e) { int rel = 512 + qi - (64 * t + 16 * jt + 4 * q + e); rel = rel > 128 ? 128 : rel; rel = rel < -128 ? -128 : rel; sc[jt][e] += bias_s[g * 260 + rel + 128]; }
        } else { const float bfar = bias_s[g * 260 + 256];
#pragma unroll
            for (int jt = 0; jt < 4; ++jt) sc[jt] = sc[jt] + bfar;
        }
        float ps = 0.f;
#pragma unroll
        for (int jt = 0; jt < 4; ++jt)
#pragma unroll
            for (int e = 0; e < 4; ++e) { const float p = __builtin_amdgcn_exp2f(sc[jt][e]); sc[jt][e] = p; ps += p; }
        l_run += ps;
#pragma unroll
        for (int s = 0; s < 2; ++s) {
            u32x4 w; w.x = pk2(sc[2 * s][0], sc[2 * s][1]); w.y = pk2(sc[2 * s][2], sc[2 * s][3]); w.z = pk2(sc[2 * s + 1][0], sc[2 * s + 1][1]); w.w = pk2(sc[2 * s + 1][2], sc[2 * s + 1][3]);
            const bf16x8 bp = __builtin_bit_cast(bf16x8, w);
#pragma unroll
            for (int dt = 0; dt < 4; ++dt) { const LAS unsigned char* vp = vb_ + ((g * 64 + 16 * dt + r) * 72 + 32 * s + 4 * q) * 2;
                const s16x4 lo = lds8(vp), hi = lds8(vp + 32); const bf16x8 av = __builtin_shufflevector(lo, hi, 0, 1, 2, 3, 4, 5, 6, 7);
                o[dt] = __builtin_amdgcn_mfma_f32_16x16x32_bf16(av, bp, o[dt], 0, 0, 0); }
        }
        __syncthreads();
    }
#undef ATT_LOADT
#undef ATT_WRITE
    l_run += __shfl_xor(l_run, 16); l_run += __shfl_xor(l_run, 32);
    const float inv = __builtin_amdgcn_rcpf(l_run);
#pragma unroll
    for (int dt = 0; dt < 4; ++dt) { const int dd = 16 * dt + 4 * q; const u32x2 gv = *(const u32x2*)(GBs + qrl * 1024 + h * 64 + dd);
        u32x2 w; w.x = pk2(o[dt][0] * inv * bflo(gv.x), o[dt][1] * inv * bfhi(gv.x)); w.y = pk2(o[dt][2] * inv * bflo(gv.y), o[dt][3] * inv * bfhi(gv.y));
        if (!dry || inv == 1.2345e30f) *(u32x2*)(orow + dd) = w; }
}
DI void attn_phase(const Args& a, int L, LAS unsigned char* lds, int dry, int item_lo, int item_hi, int first_wg) {
    int wg0_ = (int)blockIdx.x - first_wg; if (wg0_ < 0) wg0_ += (int)gridDim.x;
    int prev_hp = -1;
    for (int item = item_lo + wg0_; item < item_hi; item += gridDim.x) { const bool sb = (item & 7) != prev_hp; prev_hp = item & 7;
        if ((item >> 3) >= NPC) attn_item<true>(a, L, lds, dry, item, sb); else attn_item<false>(a, L, lds, dry, item, sb); }
}

#define XB_TMO      128
#define XB_XCNT(j)  (256  + 64 * (j))
#define XB_XSUB(j)  (1280 + 64 * (j))
#define XB_XGEN(j)  (2304 + 64 * (j))
#define XB_TOP      3328
#define XB_TOPGEN   3392
#define XCD_BAR_WORDS 3456
#define XB_SPIN_CAP (1u << 18)

__device__ __forceinline__ unsigned xb_ld(unsigned* p)              { return __hip_atomic_load(p, __ATOMIC_RELAXED, __HIP_MEMORY_SCOPE_AGENT); }
__device__ __forceinline__ unsigned xb_add(unsigned* p, unsigned v) { return __hip_atomic_fetch_add(p, v, __ATOMIC_RELAXED, __HIP_MEMORY_SCOPE_AGENT); }
__device__ __forceinline__ unsigned xb_xcc_id() { return (unsigned)__builtin_amdgcn_s_getreg((3 << 11) | 20) & 0xFu; }
#define XB_SPIN(cond, bar) do { unsigned _sp = 0; while (cond) { __builtin_amdgcn_s_sleep(1); \
    if ((++_sp & 255u) == 0u) { if (xb_ld(&(bar)[XB_TMO])) break; if (_sp > XB_SPIN_CAP) { atomicAdd(&(bar)[XB_TMO], 1u); break; } } } } while (0)

struct XcdBarrier {
    unsigned* bar; unsigned x;
    volatile LAS unsigned* st;
};

__device__ __forceinline__ XcdBarrier xcd_barrier_post(unsigned* bar, volatile LAS unsigned* st) {
    XcdBarrier b; b.bar = bar; b.x = xb_xcc_id(); b.st = st;
    if (threadIdx.x == 0) (void)xb_add(&bar[XB_XCNT(b.x)], 1u);
    return b;
}
__device__ __forceinline__ void xcd_barrier_complete(unsigned* bar, unsigned x, unsigned& nloc, unsigned& nx) {
    const unsigned G = gridDim.x * gridDim.y * gridDim.z;
    unsigned sum, cnt, mine, sp = 0u;
    for (;;) {
        sum = 0u; cnt = 0u; mine = 0u;
#pragma unroll
        for (unsigned j = 0; j < 16; ++j) { const unsigned c = xb_ld(&bar[XB_XCNT(j)]); sum += c; cnt += (c > 0u) ? 1u : 0u; mine = (j == x) ? c : mine; }
        if (sum == G) break;
        __builtin_amdgcn_s_sleep(1);
        if ((++sp & 255u) == 0u) { if (xb_ld(&bar[XB_TMO])) break; if (sp > XB_SPIN_CAP) { atomicAdd(&bar[XB_TMO], 1u); break; } }
    }
    nloc = mine > 0u ? mine : 1u; nx = cnt > 0u ? cnt : 1u;
}

__device__ __forceinline__ void xcd_barrier(const XcdBarrier& b) {
    asm volatile("s_waitcnt vmcnt(0)" ::: "memory");
    __syncthreads();
    if (threadIdx.x == 0) {
        unsigned* bar = b.bar;
        __builtin_amdgcn_s_waitcnt(0);
        unsigned nloc = b.st[0], nx = b.st[1];
        if (nloc == 0u) { xcd_barrier_complete(bar, b.x, nloc, nx); b.st[0] = nloc; b.st[1] = nx; }
        const unsigned old = xb_add(&bar[XB_XSUB(b.x)], 1u);
        const unsigned gen = old / nloc;
        if (old + 1u == (gen + 1u) * nloc) {
            __builtin_amdgcn_fence(__ATOMIC_RELEASE, "agent");
            asm volatile("s_waitcnt vmcnt(0)" ::: "memory");
            const unsigned og = xb_add(&bar[XB_TOP], 1u);
            const unsigned tg = og / nx;
            if (og + 1u == (tg + 1u) * nx) xb_add(&bar[XB_TOPGEN], 1u);
            else XB_SPIN(xb_ld(&bar[XB_TOPGEN]) == tg, bar);
            __builtin_amdgcn_fence(__ATOMIC_ACQUIRE, "agent");
            xb_add(&bar[XB_XGEN(b.x)], 1u);
            asm volatile("s_waitcnt vmcnt(0)" ::: "memory");
        } else {
            XB_SPIN(xb_ld(&bar[XB_XGEN(b.x)]) == gen, bar);
            __builtin_amdgcn_fence(__ATOMIC_ACQUIRE, "agent");
            asm volatile("s_waitcnt vmcnt(0)" ::: "memory");
        }
    }
    __syncthreads();
}

#ifndef PROBE_REP
#define PROBE_REP 0
#endif
#ifndef EN_CH
#define EN_CH 31
#endif
#ifndef EN_PREP
#define EN_PREP 1
#endif
#ifndef EN_GIN
#define EN_GIN 1
#endif
#ifndef EN_GLAA
#define EN_GLAA 1
#endif
#ifndef EN_SCAN
#define EN_SCAN 1
#endif
#ifndef EN_GLAC
#define EN_GLAC 1
#endif
#ifndef EN_ATTN
#define EN_ATTN 1
#endif
#ifndef EN_CHAIN
#define EN_CHAIN 1
#endif
constexpr int PH_PER_LAYER = 10, N_PHASES = 1 + 2 * PH_PER_LAYER;
constexpr int MISC_OFF = LDS_BYTES - 64;
#define REPS(k) (((PROBE_REP >> (k)) & 1) ? 2 : 1)
__global__ void __launch_bounds__(NTHREADS, 2) fwd_kernel(Args a) {
    extern __shared__ __attribute__((aligned(16))) unsigned char lds_raw[];
    LAS unsigned char* lds = (LAS unsigned char*)lds_raw;
    const int tid = otid(), lane = tid & 63, wave = __builtin_amdgcn_readfirstlane(tid >> 6);
    const int gw = blockIdx.x * 8 + wave, ngw = gridDim.x * 8, gtid = blockIdx.x * NTHREADS + tid, ngt = gridDim.x * NTHREADS;
    LAS float* scr = (LAS float*)(lds + wave * 16384);
    const int lo = kph_lo(), hi = kph_hi();
    volatile LAS unsigned* MISC = (volatile LAS unsigned*)(lds + MISC_OFF);
    if (tid < 16) MISC[tid] = 0u;
    __syncthreads();
    XcdBarrier bar; bar.bar = (unsigned*)kws(); bar.x = 0; bar.st = nullptr;
    if (hi - lo > 1) bar = xcd_barrier_post((unsigned*)kws(), MISC);
#define IN_PH(k) (lo <= (k) && (k) < hi)
#define SEAM(k) do { if (IN_PH(k) && IN_PH((k) + 1)) { xcd_barrier(bar); if ((PROBE_REP >> 11) & 1) xcd_barrier(bar); } } while (0)
    if (lo < 0) { __threadfence(); cg::this_grid().sync(); }
    if (EN_PREP && IN_PH(0)) for (int rep = 0; rep < REPS(10); ++rep) { prep_small(a, gw, ngw, scr, lane); prep_win(a, 0, gw, ngw, scr, lane); prep_rows(a, gw, ngw, lane); prep_shift(gw, lane); prep_misc(a, gtid, ngt); __syncthreads(); }
    SEAM(0);
    for (int L = 0; L < 2; ++L) {
        const int pb = 1 + L * PH_PER_LAYER;
        unsigned char* ws = kws();
        bf16_t* XB = (bf16_t*)(ws + WS_XB); float* SQ1 = (float*)(ws + WS_SQ1); float* SQ2 = (float*)(ws + WS_SQ2);
        bf16_t* S0 = (bf16_t*)(ws + WS_OV); bf16_t* S1 = (bf16_t*)(ws + WS_OV + SLOT); bf16_t* S2 = (bf16_t*)(ws + WS_OV + 2 * SLOT); bf16_t* S3 = (bf16_t*)(ws + WS_OV + 3 * SLOT); bf16_t* S4 = (bf16_t*)(ws + WS_OV + 4 * SLOT);
        const bf16_t* WIN = (const bf16_t*)(ws + WS_WIN);
        EpiIn ein; ein.L = L; ein.ws = ws; ein.out = kout(); ein.qg = kin(I_QG) + L * 64; ein.kg = kin(I_KG) + L * 64;
        if (EN_GIN && IN_PH(pb + 0)) for (int rep = 0; rep < REPS(0); ++rep) { ein.tile0 = 0; run_gemm_g(lds, XB, WIN, ein); }
        SEAM(pb + 0);
        if (EN_GLAA && IN_PH(pb + 1)) for (int rep = 0; rep < REPS(1); ++rep) gla_a_phase(a, L, lds, 0, NPC * 4, 0);
        SEAM(pb + 1);
        if (EN_SCAN && IN_PH(pb + 2)) for (int rep = 0; rep < REPS(2); ++rep) {
            gla_a_phase(a, L, lds, NPC * 4, NCH * 4, 0); gla_c_phase(a, L, lds, rep + 1 < REPS(2), NPC * 4, NCH * 4, 32);
            attn_phase(a, L, lds, rep + 1 < REPS(2), NPC * 8, NCH * 8, 64);
            gla_scan_phase(a, L, rep + 1 < REPS(2)); }
        SEAM(pb + 2);
        if (EN_GLAC && IN_PH(pb + 3)) for (int rep = 0; rep < REPS(3); ++rep) gla_c_phase(a, L, lds, rep + 1 < REPS(3), 0, NPC * 4, 0);
        SEAM(pb + 3);
        if (EN_GIN && IN_PH(pb + 4)) for (int rep = 0; rep < REPS(4); ++rep) { ein.tile0 = 13; run_gemm(lds, XB, WIN + (size_t)13 * 256 * 1024, MP, 16 * 256, 1024, ein); }
        SEAM(pb + 4);
        if (EN_ATTN && IN_PH(pb + 5)) for (int rep = 0; rep < REPS(5); ++rep) attn_phase(a, L, lds, rep + 1 < REPS(5), 0, NPC * 8, 0);
        SEAM(pb + 5);
        if (EN_GIN && IN_PH(pb + 6)) for (int rep = 0; rep < REPS(6); ++rep) { ein.tile0 = 29; run_gemm_m(lds, XB, WIN + (size_t)29 * 256 * 1024, ein); }
        if (!(IN_PH(pb + 6) && IN_PH(pb + 7))) SEAM(pb + 6);
        if (EN_CHAIN && IN_PH(pb + 7)) for (int rep = 0; rep < REPS(7); ++rep) { const int dry = rep + 1 < REPS(7);
            if (EN_CH & 1) { bf16_t* AXA = (bf16_t*)(ws + WS_AX + 4 * MiB); EpiYA ea{S1, dry, AXA}; run_gemm(lds, S0, wsm(a, L, 0), MP, 1024, 1024, ea); mini_gemm<1024>(lds, S0 + (size_t)MP * 1024, wsm(a, L, 0), ea); }
            if (EN_CH & 2) { bf16_t* AXA = (bf16_t*)(ws + WS_AX + 4 * MiB); bf16_t* AXB = (bf16_t*)(ws + WS_AX + 5 * MiB); EpiYB eb{S1, S2, dry, AXA, AXB}; run_gemm(lds, S4, wsm(a, L, 1), MP, 1024, 1024, eb); mini_gemm<1024>(lds, S4 + (size_t)MP * 1024, wsm(a, L, 1), eb); }
        }
        SEAM(pb + 7);
        if (EN_CHAIN && IN_PH(pb + 8)) {
            if (L == 0) { prep_win(a, 1, gw, ngw, scr, lane); __syncthreads(); }
            for (int rep = 0; rep < REPS(8); ++rep) {
            EpiOut eo; eo.xp = L == 0 ? kin(I_XP) : kout(); eo.xs = L == 0 ? kin(I_XS) : kout() + (size_t)MP * 1024; eo.out = kout(); eo.xb = S3; eo.sq = SQ1; eo.dry = rep + 1 < REPS(8);
            if (EN_CH & 4) { run_gemm(lds, S2, wsm(a, L, 2), MP, 1024, 1024, eo); mini_gemm<1024>(lds, (const bf16_t*)(ws + WS_AX + 5 * MiB), wsm(a, L, 2), eo); } }
        }
        SEAM(pb + 8);
        if (EN_CHAIN && IN_PH(pb + 9)) for (int rep = 0; rep < REPS(9); ++rep) { const int dry = rep + 1 < REPS(9);
            if (EN_CH & 8) { EpiP ep{(float*)S0, dry}; run_gemm(lds, (const bf16_t*)(ws + WS_PB) + (size_t)L * MT * 256, wsm(a, L, 4), MP, 1024, 256, ep); mini_gemm<256>(lds, (const bf16_t*)(ws + WS_PB) + ((size_t)L * MT + MP) * 256, wsm(a, L, 4), ep); }
            EpiGate eg; eg.sq1 = SQ1; eg.PT = (const float*)S0; eg.out = kout(); eg.xb = XB; eg.sq2 = SQ2; eg.dry = dry;
            if (EN_CH & 16) { run_gemm(lds, S3, wsm(a, L, 3), MP, 1024, 1024, eg); mini_gemm<1024>(lds, S3 + (size_t)MP * 1024, wsm(a, L, 3), eg); }
        }
        SEAM(pb + 9);
    }
}

#ifndef MK_ONE_LAUNCH
#define MK_ONE_LAUNCH 1
#endif
extern "C" void kernel_launch(void* const* d_in, const int* in_sizes, int n_in, void* d_out, int out_size, void* d_ws, size_t ws_size, hipStream_t stream) {
    static int grid = 0;
    if (grid == 0) {
        if (n_in != 21 || ws_size < WS_END) { fprintf(stderr, "kernel_launch: unexpected n_in %d or ws_size %zu (< %zu)\n", n_in, ws_size, (size_t)WS_END); grid = -1; return; }
        int dev = 0, cus = 0, per_cu = 0;
        (void)hipGetDevice(&dev); (void)hipDeviceGetAttribute(&cus, hipDeviceAttributeMultiprocessorCount, dev);
        (void)hipFuncSetAttribute((const void*)fwd_kernel, hipFuncAttributeMaxDynamicSharedMemorySize, LDS_BYTES);
        (void)hipOccupancyMaxActiveBlocksPerMultiprocessor(&per_cu, (const void*)fwd_kernel, NTHREADS, LDS_BYTES);
        (void)hipGetLastError();
        if (per_cu < 1) { fprintf(stderr, "kernel_launch: occupancy query says %d blocks/CU\n", per_cu); per_cu = 1; }
        grid = cus;
    }
    if (grid < 0) return;
    Args a{};
    for (int i = 0; i < 21; ++i) a.in[i] = (const float*)d_in[i];
    a.out = (float*)d_out; a.ws = (unsigned char*)d_ws;
#if MK_ONE_LAUNCH
    (void)hipMemsetAsync(d_ws, 0, 16384, stream);
    a.ph_lo = 0; a.ph_hi = N_PHASES;
    void* args[] = {&a};
    hipError_t e = hipLaunchCooperativeKernel((const void*)fwd_kernel, dim3(grid), dim3(NTHREADS), args, LDS_BYTES, stream);
    if (e != hipSuccess) fprintf(stderr, "cooperative launch failed: %s (grid %d)\n", hipGetErrorString(e), grid);
#else
    for (int p = 0; p < N_PHASES; ++p) { a.ph_lo = p; a.ph_hi = p + 1; hipLaunchKernelGGL(fwd_kernel, dim3(grid), dim3(NTHREADS), LDS_BYTES, stream, a); }
#endif
}
```

```cpp
#include <hip/hip_runtime.h>
#include <hip/hip_cooperative_groups.h>
#include <cstdio>
#include <cstdint>
namespace cg = cooperative_groups;
namespace pg8 {
#define PG8_LAS __attribute__((address_space(3)))
typedef unsigned short bf16_t;
typedef short bf16x8 __attribute__((ext_vector_type(8)));
typedef float f32x4 __attribute__((ext_vector_type(4)));
typedef unsigned u32x4 __attribute__((ext_vector_type(4)));
constexpr int BM = 256, BK = 64, HALF = 128, HTB = HALF * BK * 2  , STAGE_BYTES = 8 * HTB, NXCD = 8, WGM = 8;

__host__ __device__ __forceinline__ int lds_byte(int r, int c) { const int st = (r >> 4) * 2 + (c >> 5), rr = r & 15, cc = c & 31, ob = rr * 64 + cc * 2; return st * 1024 + (ob ^ (((ob >> 9) & 1) << 5)); }
__host__ __device__ __forceinline__ void stage_rc(int b, int& R, int& C) { const int st = b / 1024, sb = b % 1024, swz = sb ^ (((sb >> 9) & 1) << 5); R = (st >> 1) * 16 + swz / 64; C = (st & 1) * 32 + (swz % 64) / 2; }
__host__ __device__ __forceinline__ int perm32(int rho) { const int n = rho >> 4, i = rho & 15; return 8 * (i >> 2) + 4 * n + (i & 3); }

struct Unit { int pm, pn; };
struct Gemm { const bf16_t* A; const bf16_t* Bt; int M, N, K; };

struct StaticOrder {
    int nM, nN, nwg, G, c;
    __host__ __device__ void init(int M, int N, int G_, int c_) { nM = M / BM; nN = N / BM; nwg = nM * nN; G = G_; c = c_; }
    __host__ __device__ bool next(int i, Unit& u) const {
        const long L = (long)i * G + c; if (L >= nwg) return false;
        int wgid = (int)L; { const int q = nwg / NXCD, r = nwg % NXCD, xcd = wgid % NXCD, off = wgid / NXCD; wgid = (xcd < r ? xcd * (q + 1) : r * (q + 1) + (xcd - r) * q) + off; }
        const int nig = WGM * nN, gid = wgid / nig, fm = gid * WGM, gsz = (nM - fm) < WGM ? (nM - fm) : WGM;
        u.pm = fm + ((wgid % nig) % gsz); u.pn = (wgid % nig) / gsz; return true;
    }
    __device__ __forceinline__ void a_ready(const Unit&) const {}
    __device__ __forceinline__ void done(const Unit&) const {}
};
__device__ __forceinline__ unsigned cvt_pk_bf16(float lo, float hi) { unsigned r; asm volatile("v_cvt_pk_bf16_f32 %0, %1, %2" : "=v"(r) : "v"(lo), "v"(hi)); return r; }
template <class Epi, class Sched, bool ALIGN_EPI = false, bool SP2 = false>
__device__ __forceinline__ void gemm_phase(PG8_LAS unsigned char* lds, const Gemm g, const Sched& S, const Epi& E) {
    int tid_ = threadIdx.x; asm volatile("" : "+v"(tid_));
    const int tid = tid_, wid = __builtin_amdgcn_readfirstlane(tid >> 6), lane = tid & 63, wr = wid >> 2, wc = wid & 3, fr = lane & 15, fq = lane >> 4;
    const int K = g.K, nt = K / BK;
    unsigned voffA[2], voffB[2];
#pragma unroll
    for (int i = 0; i < 2; ++i) { int R, C; stage_rc(tid * 16 + i * 8192, R, C); const int Rb = Epi::PERM ? ((R & ~31) + perm32(R & 31)) : R;
        voffA[i] = (unsigned)(R * K + C) * 2u; voffB[i] = (unsigned)(Rb * K + C) * 2u; }
    const size_t kstep = (size_t)(BK * 2);
    const size_t hstep = (size_t)HALF * K * 2;
    const size_t tstep = 2 * hstep;
    const unsigned ldsw = (unsigned)wid * 1024u;
    const int aoff = lds_byte(wr * 64 + fr, fq * 8), boff = lds_byte(wc * 32 + fr, fq * 8);
#define PG8_SA(b, h) (((b) * 2 + (h)) * HTB)
#define PG8_SB(b, h) ((4 + (b) * 2 + (h)) * HTB)
#define PG8_STAGE(bufoff, gbase, voff) do { _Pragma("unroll") for (int _i = 0; _i < 2; ++_i) \
        __builtin_amdgcn_global_load_lds((const unsigned*)((const char*)(gbase) + (voff)[_i]), (PG8_LAS unsigned*)(lds + (bufoff) + ldsw + _i * 8192), 16, 0, 0); } while (0)
#define PG8_LDA(dst, b, h) do { _Pragma("unroll") for (int m = 0; m < 4; ++m) _Pragma("unroll") for (int k = 0; k < 2; ++k) dst[m][k] = *(const PG8_LAS bf16x8*)(lds + PG8_SA(b, h) + aoff + m * 2048 + k * 1024); } while (0)
#define PG8_LDB(dst, b, h) do { _Pragma("unroll") for (int n = 0; n < 2; ++n) _Pragma("unroll") for (int k = 0; k < 2; ++k) dst[n][k] = *(const PG8_LAS bf16x8*)(lds + PG8_SB(b, h) + boff + n * 2048 + k * 1024); } while (0)
#define PG8_MMA(ai, bj, At, Bt) do { __builtin_amdgcn_s_setprio(1); _Pragma("unroll") for (int m = 0; m < 4; ++m) _Pragma("unroll") for (int n = 0; n < 2; ++n) _Pragma("unroll") for (int k = 0; k < 2; ++k) \
        acc[ai][bj][m][n] = __builtin_amdgcn_mfma_f32_16x16x32_bf16(Bt[n][k], At[m][k], acc[ai][bj][m][n], 0, 0, 0); __builtin_amdgcn_s_setprio(0); } while (0)
#define PG8_WAIT_V(n) asm volatile("s_waitcnt vmcnt(" #n ")" ::: "memory")
#define PG8_WAIT_L(n) asm volatile("s_waitcnt lgkmcnt(" #n ")" ::: "memory")
#define PG8_BAR __builtin_amdgcn_s_barrier()
#define PG8_SCHED __builtin_amdgcn_sched_barrier(0)
    Unit cur, nxt; int ui = 0;
    if (!S.next(0, cur)) return;
    f32x4 acc[2][2][4][2];
#pragma unroll
    for (int a = 0; a < 2; ++a)
#pragma unroll
        for (int b = 0; b < 2; ++b)
#pragma unroll
            for (int m = 0; m < 4; ++m)
#pragma unroll
                for (int n = 0; n < 2; ++n) acc[a][b][m][n] = (f32x4){0.f, 0.f, 0.f, 0.f};
    bf16x8 At[4][2], B0[2][2], B1[2][2];
    const char* cA = (const char*)g.A + (size_t)cur.pm * tstep; const char* cB = (const char*)g.Bt + (size_t)cur.pn * tstep;
    S.a_ready(cur);
    if constexpr (SP2) {
        PG8_STAGE(PG8_SB(0, 0), cB, voffB); PG8_STAGE(PG8_SB(0, 1), cB + hstep, voffB); PG8_STAGE(PG8_SA(0, 0), cA, voffA); PG8_STAGE(PG8_SA(0, 1), cA + hstep, voffA);
        if (wr == 1) PG8_BAR;
        PG8_WAIT_V(2); PG8_BAR;
        PG8_STAGE(PG8_SB(1, 0), cB + kstep, voffB); PG8_STAGE(PG8_SA(1, 0), cA + kstep, voffA); PG8_STAGE(PG8_SB(1, 1), cB + hstep + kstep, voffB);
        PG8_WAIT_V(6); PG8_BAR;
    } else {
        PG8_STAGE(PG8_SB(0, 0), cB, voffB); PG8_STAGE(PG8_SA(0, 0), cA, voffA); PG8_STAGE(PG8_SB(0, 1), cB + hstep, voffB); PG8_STAGE(PG8_SA(0, 1), cA + hstep, voffA);
        if (wr == 1) PG8_BAR;
        PG8_WAIT_V(4); PG8_BAR;
        PG8_STAGE(PG8_SB(1, 0), cB + kstep, voffB); PG8_STAGE(PG8_SA(1, 0), cA + kstep, voffA); PG8_STAGE(PG8_SB(1, 1), cB + hstep + kstep, voffB);
        PG8_WAIT_V(6); PG8_BAR;
    }
    for (;;) {
        const bool has_next = S.next(ui + 1, nxt);
        const char* nA = has_next ? (const char*)g.A + (size_t)nxt.pm * tstep : cA; const char* nB = has_next ? (const char*)g.Bt + (size_t)nxt.pn * tstep : cB;
        for (int t = 0; t < nt; t += 2) {
            const bool last = (t == nt - 2);
            const char* a1 = cA + (size_t)(t + 1) * kstep;
            const char* a2 = last ? nA : cA + (size_t)(t + 2) * kstep; const char* b2 = last ? nB : cB + (size_t)(t + 2) * kstep;
            const char* a3 = a2 + kstep; const char* b3 = b2 + kstep;
            if (last && has_next) S.a_ready(nxt);
            if constexpr (SP2) {
            PG8_LDB(B0, 0, 0); PG8_LDB(B1, 0, 1); PG8_SCHED; PG8_LDA(At, 0, 0); PG8_STAGE(PG8_SA(1, 1), a1 + hstep, voffA);
            PG8_WAIT_V(8); PG8_WAIT_L(0); PG8_BAR; PG8_MMA(0, 0, At, B0); PG8_MMA(0, 1, At, B1); PG8_BAR; PG8_SCHED;
            PG8_LDA(At, 0, 1); PG8_STAGE(PG8_SB(0, 0), b2, voffB); PG8_STAGE(PG8_SB(0, 1), b2 + hstep, voffB); PG8_STAGE(PG8_SA(0, 0), a2, voffA);
            PG8_WAIT_V(8); PG8_WAIT_L(0); PG8_BAR; PG8_MMA(1, 0, At, B0); PG8_MMA(1, 1, At, B1); PG8_BAR; PG8_SCHED;
            PG8_LDB(B0, 1, 0); PG8_LDB(B1, 1, 1); PG8_SCHED; PG8_LDA(At, 1, 0); PG8_STAGE(PG8_SA(0, 1), a2 + hstep, voffA);
            PG8_WAIT_V(8); PG8_WAIT_L(0); PG8_BAR; PG8_MMA(0, 0, At, B0); PG8_MMA(0, 1, At, B1); PG8_BAR; PG8_SCHED;
            PG8_LDA(At, 1, 1); PG8_STAGE(PG8_SB(1, 0), b3, voffB); PG8_STAGE(PG8_SB(1, 1), b3 + hstep, voffB); PG8_STAGE(PG8_SA(1, 0), a3, voffA);
            PG8_WAIT_V(8); PG8_WAIT_L(0); PG8_BAR; PG8_MMA(1, 0, At, B0); PG8_MMA(1, 1, At, B1); PG8_BAR; PG8_SCHED;
            } else {
            PG8_LDB(B0, 0, 0); PG8_SCHED; PG8_LDA(At, 0, 0); PG8_STAGE(PG8_SA(1, 1), a1 + hstep, voffA);
            PG8_WAIT_L(8); PG8_BAR; PG8_WAIT_L(0); PG8_MMA(0, 0, At, B0); PG8_BAR; PG8_SCHED;
            PG8_LDB(B1, 0, 1); PG8_STAGE(PG8_SB(0, 0), b2, voffB);
            PG8_BAR; PG8_WAIT_L(0); PG8_MMA(0, 1, At, B1); PG8_BAR;
            PG8_LDA(At, 0, 1); PG8_STAGE(PG8_SA(0, 0), a2, voffA);
            PG8_BAR; PG8_WAIT_L(0); PG8_MMA(1, 0, At, B0); PG8_BAR; PG8_SCHED;
            PG8_STAGE(PG8_SB(0, 1), b2 + hstep, voffB);
            PG8_WAIT_V(6); PG8_BAR; PG8_MMA(1, 1, At, B1); PG8_BAR;
            PG8_LDB(B0, 1, 0); PG8_SCHED; PG8_LDA(At, 1, 0); PG8_STAGE(PG8_SA(0, 1), a2 + hstep, voffA);
            PG8_WAIT_L(8); PG8_BAR; PG8_WAIT_L(0); PG8_MMA(0, 0, At, B0); PG8_BAR; PG8_SCHED;
            PG8_LDB(B1, 1, 1); PG8_STAGE(PG8_SB(1, 0), b3, voffB);
            PG8_BAR; PG8_WAIT_L(0); PG8_MMA(0, 1, At, B1); PG8_BAR;
            PG8_LDA(At, 1, 1); PG8_STAGE(PG8_SA(1, 0), a3, voffA);
            PG8_BAR; PG8_WAIT_L(0); PG8_MMA(1, 0, At, B0); PG8_BAR; PG8_SCHED;
            PG8_STAGE(PG8_SB(1, 1), b3 + hstep, voffB);
            PG8_WAIT_V(6); PG8_BAR; PG8_MMA(1, 1, At, B1); PG8_BAR;
            }
        }
        if constexpr (ALIGN_EPI) { if (wr == 0) PG8_BAR; }
        if constexpr (!Epi::AFTER_DRAIN) { E(acc, cur, wr, wc, fr, fq); S.done(cur); }
        if (!has_next) break;
#pragma unroll
        for (int a = 0; a < 2; ++a)
#pragma unroll
            for (int b = 0; b < 2; ++b)
#pragma unroll
                for (int m = 0; m < 4; ++m)
#pragma unroll
                    for (int n = 0; n < 2; ++n) acc[a][b][m][n] = (f32x4){0.f, 0.f, 0.f, 0.f};
        cur = nxt; cA = nA; cB = nB; ++ui;
        if constexpr (ALIGN_EPI) { if (wr == 1) PG8_BAR; }
    }
    PG8_WAIT_V(0);
    if constexpr (!ALIGN_EPI) { if (wr == 0) PG8_BAR; }
    PG8_BAR;
    if constexpr (Epi::AFTER_DRAIN) { E.fused(acc, cur, wr, wc, fr, fq, lds, wid, lane); S.done(cur); }
#undef PG8_SA
#undef PG8_SB
#undef PG8_STAGE
#undef PG8_LDA
#undef PG8_LDB
#undef PG8_MMA
#undef PG8_WAIT_V
#undef PG8_WAIT_L
#undef PG8_BAR
#undef PG8_SCHED
}
}

#define DI __device__ __forceinline__
#define LAS __attribute__((address_space(3)))
typedef unsigned short bf16_t;
typedef short bf16x8 __attribute__((ext_vector_type(8)));
typedef short s16x4 __attribute__((ext_vector_type(4)));
typedef float f32x4 __attribute__((ext_vector_type(4)));
typedef unsigned u32x4 __attribute__((ext_vector_type(4)));
typedef unsigned u32x2 __attribute__((ext_vector_type(2)));

constexpr int DM = 1024, MP = 16384, MS = 512, MT = MP + MS;
constexpr int NPC = 256, NCH = 264;
constexpr float EPS = 1e-6f, LOG2E = 1.4426950408889634f;
constexpr int NWIN_T = 37;
constexpr int NTHREADS = 512;
constexpr int LDS_BYTES = 147456;

constexpr size_t MiB = 1u << 20;
constexpr size_t SLOT = 33 * MiB;
constexpr size_t WS_MSH = 65536;
constexpr size_t WS_SQ1 = 1 * MiB, WS_SQ2 = 5 * MiB / 2, WS_RA = 4 * MiB, WS_DC = 6 * MiB, WS_WSM = 7 * MiB, WSM_LAYER = 17 * MiB / 2;
constexpr size_t WS_WIN = 24 * MiB, WS_PB = 43 * MiB, WS_XB = 60 * MiB, WS_OV = 93 * MiB, WS_AX = WS_OV + 5 * SLOT, WS_END = WS_AX + 6 * MiB;
constexpr size_t O_Y = 0, O_SP = 17301504, O_KP = 18350080, O_VP = 22544384, O_SS = 26738688, O_KS = 28835840, O_VS = 37224448;


typedef const __attribute__((address_space(4))) unsigned char* kargp_t;
DI kargp_t kbase() { kargp_t k = (kargp_t)__builtin_amdgcn_kernarg_segment_ptr(); asm volatile("" : "+s"(k)); return k; }
DI const float* kin(int i) { return *(const float* const __attribute__((address_space(4)))*)(kbase() + 8 * i); }
DI float* kout() { return *(float* const __attribute__((address_space(4)))*)(kbase() + 168); }
DI unsigned char* kws() { return *(unsigned char* const __attribute__((address_space(4)))*)(kbase() + 176); }
DI int kph_lo() { return *(const __attribute__((address_space(4))) int*)(kbase() + 184); }
DI int kph_hi() { return *(const __attribute__((address_space(4))) int*)(kbase() + 188); }
DI int otid() { int t = threadIdx.x; asm volatile("" : "+v"(t)); return t; }
DI float bflo(unsigned w) { return __uint_as_float(w << 16); }
DI float bfhi(unsigned w) { return __uint_as_float(w & 0xffff0000u); }
DI float bf2f(bf16_t b) { return __uint_as_float(((unsigned)b) << 16); }
typedef float f32x2_t __attribute__((ext_vector_type(2))); typedef __bf16 bf16x2_t __attribute__((ext_vector_type(2)));
DI unsigned pk2(float lo, float hi) { f32x2_t v = {lo, hi}; bf16x2_t r = __builtin_convertvector(v, bf16x2_t); return __builtin_bit_cast(unsigned, r); }
DI float sigm(float x) { return __builtin_amdgcn_rcpf(1.f + __expf(-x)); }
DI float silu(float x) { return x * sigm(x); }
DI float row_rstd(const float* sq, int row) {
    const f32x4* p = (const f32x4*)(sq + (size_t)row * 16); const f32x4 a = p[0], b = p[1], c = p[2], d = p[3];
    const float s = (((a.x + a.y) + (a.z + a.w)) + ((b.x + b.y) + (b.z + b.w))) + (((c.x + c.y) + (c.z + c.w)) + ((d.x + d.y) + (d.z + d.w)));
    return rsqrtf(s * (1.f / 1024.f) + EPS);
}
DI u32x4 pack8(const float* v) { u32x4 w; w.x = pk2(v[0], v[1]); w.y = pk2(v[2], v[3]); w.z = pk2(v[4], v[5]); w.w = pk2(v[6], v[7]); return w; }
DI void unpack8(u32x4 w, float* v) { v[0] = bflo(w.x); v[1] = bfhi(w.x); v[2] = bflo(w.y); v[3] = bfhi(w.y); v[4] = bflo(w.z); v[5] = bfhi(w.z); v[6] = bflo(w.w); v[7] = bfhi(w.w); }

enum { T_QA = 0, T_KA, T_VA, T_GA, T_RA, T_QB, T_KB, T_VB, T_GB, T_MGA, T_MGB };
struct EpiIn {
    static constexpr bool PERM = false, AFTER_DRAIN = false;
    int tile0, L; unsigned char* ws; float* out; const float *qg, *kg;
    template <int TYPE> DI void run(const pg8::f32x4 (&acc)[2][2][4][2], int pm, int tcol, int wr, int wc, int fr, int fq) const {
        constexpr size_t doff = TYPE == T_QA ? WS_OV + 2 * SLOT : TYPE == T_KA ? WS_OV + 2 * SLOT + (size_t)MT * 1024 : TYPE == T_VA ? WS_OV + SLOT : TYPE == T_GA ? WS_OV : TYPE == T_QB ? WS_OV + SLOT : TYPE == T_KB ? WS_OV + 2 * SLOT
                              : TYPE == T_VB ? WS_OV + 3 * SLOT : TYPE == T_GB ? WS_OV + 4 * SLOT : TYPE == T_MGA ? WS_OV + SLOT : WS_OV + 2 * SLOT;
        constexpr bool ANX = TYPE == T_QB || TYPE == T_KB || TYPE == T_VB || TYPE == T_GB || TYPE == T_MGA || TYPE == T_MGB;
        constexpr size_t aoff = WS_AX + (TYPE == T_QB ? 0 : TYPE == T_KB ? 1 : TYPE == T_VB ? 2 : TYPE == T_GB ? 3 : TYPE == T_MGA ? 4 : 5) * MiB;
        const bool srow = ANX && pm >= MP / 256;
        bf16_t* dst = (bf16_t*)(ws + (srow ? aoff : doff)); const int rsub = srow ? MP : 0; const float* sq = (const float*)(ws + WS_SQ2); float* RA = (float*)(ws + WS_RA);
        float* okp = out + (TYPE == T_KB ? O_KP : O_VP) + (size_t)L * 4 * 512 * 1024; float* oks = out + (TYPE == T_KB ? O_KS : O_VS) + (size_t)L * 8 * 512 * 1024;
        const int ld = (TYPE == T_QA || TYPE == T_KA) ? 512 : 1024;
        float gq[2][8];
        if (TYPE == T_QB || TYPE == T_KB) {
            const float* g = TYPE == T_QB ? qg : kg;
#pragma unroll
            for (int bj = 0; bj < 2; ++bj)
#pragma unroll
                for (int k = 0; k < 8; ++k) gq[bj][k] = g[32 * bj + 8 * fq + k] * (TYPE == T_QB ? 0.125f * LOG2E : 1.f);
        }
#pragma unroll
        for (int ai = 0; ai < 2; ++ai)
#pragma unroll
            for (int m = 0; m < 4; ++m) {
                const int row = pm * 256 + ai * 128 + wr * 64 + m * 16 + fr;
                const float rs = row_rstd(sq, row);
                float v[2][8];
#pragma unroll
                for (int bj = 0; bj < 2; ++bj)
#pragma unroll
                    for (int n = 0; n < 2; ++n)
#pragma unroll
                        for (int e = 0; e < 4; ++e) v[bj][4 * n + e] = acc[ai][bj][m][n][e] * rs;
                if (TYPE == T_RA) {
                    if (wc == 0 && fq < 2) { float* p = RA + (size_t)row * 16 + 8 * fq; *(f32x4*)p = (f32x4){v[0][0], v[0][1], v[0][2], v[0][3]}; *(f32x4*)(p + 4) = (f32x4){v[0][4], v[0][5], v[0][6], v[0][7]}; }
                    continue;
                }
                if (TYPE == T_QB || TYPE == T_KB) {
                    float ss = 0.f;
#pragma unroll
                    for (int bj = 0; bj < 2; ++bj)
#pragma unroll
                        for (int k = 0; k < 8; ++k) ss += v[bj][k] * v[bj][k];
                    ss += __shfl_xor(ss, 16); ss += __shfl_xor(ss, 32);
                    const float r = rsqrtf(ss * (1.f / 64.f) + EPS);
#pragma unroll
                    for (int bj = 0; bj < 2; ++bj)
#pragma unroll
                        for (int k = 0; k < 8; ++k) v[bj][k] *= r * gq[bj][k];
                }
                float* bo = nullptr;
                if (TYPE == T_KB || TYPE == T_VB) {
                    if (row < MP) { const int t = row & 4095; if (t >= 3584) bo = okp + ((size_t)(row >> 12) * 512 + (t - 3584)) * 1024; }
                    else { const int rr = row - MP; bo = oks + ((size_t)(rr >> 6) * 512 + 448 + (rr & 63)) * 1024; }
                }
#pragma unroll
                for (int bj = 0; bj < 2; ++bj) {
                    const int col = tcol * 256 + 64 * wc + 32 * bj + 8 * fq;
                    if (TYPE == T_QA) {
#pragma unroll
                        for (int k = 0; k < 8; ++k) v[bj][k] *= 0.08838834764831845f;
                    }
                    if (TYPE == T_GA || TYPE == T_GB) {
#pragma unroll
                        for (int k = 0; k < 8; ++k) v[bj][k] = silu(v[bj][k]);
                    }
                    if (TYPE == T_MGA || TYPE == T_MGB) {
#pragma unroll
                        for (int k = 0; k < 8; ++k) v[bj][k] = sigm(v[bj][k]);
                    }
                    if ((TYPE == T_KB || TYPE == T_VB) && bo) { *(f32x4*)(bo + col) = (f32x4){v[bj][0], v[bj][1], v[bj][2], v[bj][3]}; *(f32x4*)(bo + col + 4) = (f32x4){v[bj][4], v[bj][5], v[bj][6], v[bj][7]}; }
                    if (TYPE == T_VA) {
                        bf16_t* p = dst + ((size_t)((row >> 6) * 4 + tcol) * 256 + 64 * wc + 32 * bj + 8 * fq) * 64 + (row & 63);
#pragma unroll
                        for (int k = 0; k < 8; k += 2) { const unsigned w = pk2(v[bj][k], v[bj][k + 1]); p[k * 64] = (bf16_t)w; p[(k + 1) * 64] = (bf16_t)(w >> 16); }
                    } else if (TYPE == T_VB) {
                        bf16_t* p = dst + ((size_t)(((row - rsub) >> 6) * 16 + tcol * 4 + wc) * 64 + 32 * bj + 8 * fq) * 64 + (row & 63);
#pragma unroll
                        for (int k = 0; k < 8; k += 2) { const unsigned w = pk2(v[bj][k], v[bj][k + 1]); p[k * 64] = (bf16_t)w; p[(k + 1) * 64] = (bf16_t)(w >> 16); }
                    } else
                    *(u32x4*)(dst + (size_t)(row - rsub) * ld + col) = pack8(v[bj]);
                }
                asm volatile("" ::: "memory");
            }
    }
    DI void operator()(const pg8::f32x4 (&acc)[2][2][4][2], const pg8::Unit& u, int wr, int wc, int fr, int fq) const {
        asm volatile("" : "+v"(fr), "+v"(fq));
        const int gt = tile0 + u.pn;
        if (gt < 2) run<T_QA>(acc, u.pm, gt, wr, wc, fr, fq);
        else if (gt < 4) run<T_KA>(acc, u.pm, gt - 2, wr, wc, fr, fq);
        else if (gt < 8) run<T_VA>(acc, u.pm, gt - 4, wr, wc, fr, fq);
        else if (gt < 12) run<T_GA>(acc, u.pm, gt - 8, wr, wc, fr, fq);
        else if (gt == 12) run<T_RA>(acc, u.pm, 0, wr, wc, fr, fq);
        else if (gt < 17) run<T_QB>(acc, u.pm, gt - 13, wr, wc, fr, fq);
        else if (gt < 21) run<T_KB>(acc, u.pm, gt - 17, wr, wc, fr, fq);
        else if (gt < 25) run<T_VB>(acc, u.pm, gt - 21, wr, wc, fr, fq);
        else if (gt < 29) run<T_GB>(acc, u.pm, gt - 25, wr, wc, fr, fq);
        else if (gt < 33) run<T_MGA>(acc, u.pm, gt - 29, wr, wc, fr, fq);
        else run<T_MGB>(acc, u.pm, gt - 33, wr, wc, fr, fq);
    }
};
#define EPI_ROWS_BEGIN _Pragma("unroll") for (int ai = 0; ai < 2; ++ai) _Pragma("unroll") for (int m = 0; m < 4; ++m) { asm volatile("" ::: "memory"); const int row = u.pm * 256 + ai * 128 + wr * 64 + m * 16 + fr;
#define EPI_COLS_BEGIN _Pragma("unroll") for (int bj = 0; bj < 2; ++bj) { const int col = u.pn * 256 + 64 * wc + 32 * bj + 8 * fq; float v[8]; \
    _Pragma("unroll") for (int n = 0; n < 2; ++n) _Pragma("unroll") for (int e = 0; e < 4; ++e) v[4 * n + e] = acc[ai][bj][m][n][e];
struct EpiYA {
    static constexpr bool PERM = false, AFTER_DRAIN = false; bf16_t* G; int dry; bf16_t* Gs;
    DI void operator()(const pg8::f32x4 (&acc)[2][2][4][2], const pg8::Unit& u, int wr, int wc, int fr, int fq) const {
        asm volatile("" : "+v"(fr), "+v"(fq));
        EPI_ROWS_BEGIN EPI_COLS_BEGIN
            bf16_t* p = G + (size_t)row * 1024 + col; float g[8]; unpack8(*(const u32x4*)p, g);
#pragma unroll
            for (int k = 0; k < 8; ++k) v[k] *= g[k];
            if (!dry) *(u32x4*)p = pack8(v);
        } }
    }
    DI void mini(int row, int col, f32x4 s) const {
        bf16_t* p = Gs + (size_t)(row - MP) * 1024 + col; const u32x2 g = *(const u32x2*)p;
        u32x2 w; w.x = pk2(s.x * bflo(g.x), s.y * bfhi(g.x)); w.y = pk2(s.z * bflo(g.y), s.w * bfhi(g.y)); if (!dry) *(u32x2*)p = w;
    }
};
struct EpiYB {
    static constexpr bool PERM = false, AFTER_DRAIN = false; const bf16_t* YA; bf16_t* G; int dry; const bf16_t* YAs; bf16_t* Gs;
    DI void operator()(const pg8::f32x4 (&acc)[2][2][4][2], const pg8::Unit& u, int wr, int wc, int fr, int fq) const {
        asm volatile("" : "+v"(fr), "+v"(fq));
        EPI_ROWS_BEGIN EPI_COLS_BEGIN
            bf16_t* p = G + (size_t)row * 1024 + col; float g[8], ya[8]; unpack8(*(const u32x4*)p, g); unpack8(*(const u32x4*)(YA + (size_t)row * 1024 + col), ya);
#pragma unroll
            for (int k = 0; k < 8; ++k) v[k] = ya[k] + v[k] * g[k];
            if (!dry) *(u32x4*)p = pack8(v);
        } }
    }
    DI void mini(int row, int col, f32x4 s) const {
        bf16_t* p = Gs + (size_t)(row - MP) * 1024 + col; const u32x2 g = *(const u32x2*)p, y = *(const u32x2*)(YAs + (size_t)(row - MP) * 1024 + col);
        u32x2 w; w.x = pk2(bflo(y.x) + s.x * bflo(g.x), bfhi(y.x) + s.y * bfhi(g.x)); w.y = pk2(bflo(y.y) + s.z * bflo(g.y), bfhi(y.y) + s.w * bfhi(g.y)); if (!dry) *(u32x2*)p = w;
    }
};
struct EpiOut {
    static constexpr bool PERM = false, AFTER_DRAIN = false; const float* xp; const float* xs; float* out; bf16_t* xb; float* sq; int dry;
    DI void operator()(const pg8::f32x4 (&acc)[2][2][4][2], const pg8::Unit& u, int wr, int wc, int fr, int fq) const {
        asm volatile("" : "+v"(fr), "+v"(fq));
        EPI_ROWS_BEGIN
            const float* base = row < MP ? xp + (size_t)row * 1024 : xs + (size_t)(row - MP) * 1024; float ss = 0.f;
            EPI_COLS_BEGIN
                const f32x4 b0 = *(const f32x4*)(base + col), b1 = *(const f32x4*)(base + col + 4);
                v[0] += b0.x; v[1] += b0.y; v[2] += b0.z; v[3] += b0.w; v[4] += b1.x; v[5] += b1.y; v[6] += b1.z; v[7] += b1.w;
#pragma unroll
                for (int k = 0; k < 8; ++k) ss += v[k] * v[k];
                if (!dry) { float* o = out + (size_t)row * 1024 + col; *(f32x4*)o = (f32x4){v[0], v[1], v[2], v[3]}; *(f32x4*)(o + 4) = (f32x4){v[4], v[5], v[6], v[7]};
                *(u32x4*)(xb + (size_t)row * 1024 + col) = pack8(v); }
            }
            ss += __shfl_xor(ss, 16); ss += __shfl_xor(ss, 32);
            if (fq == 0 && !dry) sq[(size_t)row * 16 + 4 * u.pn + wc] = ss;
        }
    }
    DI void mini(int row, int col, f32x4 s) const {
        const float* base = row < MP ? xp + (size_t)row * 1024 : xs + (size_t)(row - MP) * 1024; const f32x4 b0 = *(const f32x4*)(base + col);
        const f32x4 x = s + b0; float ss = (x.x * x.x + x.y * x.y) + (x.z * x.z + x.w * x.w);
        ss += __shfl_xor(ss, 1); ss += __shfl_xor(ss, 2); ss += __shfl_xor(ss, 4); ss += __shfl_xor(ss, 8);
        if (!dry) { *(f32x4*)(out + (size_t)row * 1024 + col) = x; u32x2 w; w.x = pk2(x.x, x.y); w.y = pk2(x.z, x.w); *(u32x2*)(xb + (size_t)row * 1024 + col) = w;
            if ((col & 63) == 0) sq[(size_t)row * 16 + (col >> 6)] = ss; }
    }
};
struct EpiP {
    static constexpr bool PERM = false, AFTER_DRAIN = false; float* PT; int dry;
    DI void operator()(const pg8::f32x4 (&acc)[2][2][4][2], const pg8::Unit& u, int wr, int wc, int fr, int fq) const {
        asm volatile("" : "+v"(fr), "+v"(fq));
        EPI_ROWS_BEGIN EPI_COLS_BEGIN
            if (!dry) { float* o = PT + (size_t)row * 1024 + col; *(f32x4*)o = (f32x4){v[0], v[1], v[2], v[3]}; *(f32x4*)(o + 4) = (f32x4){v[4], v[5], v[6], v[7]}; }
        } }
    }
    DI void mini(int row, int col, f32x4 s) const { if (!dry) *(f32x4*)(PT + (size_t)row * 1024 + col) = s; }
};
struct EpiGate {
    static constexpr bool PERM = false, AFTER_DRAIN = false; const float* sq1; const float* PT; float* out; bf16_t* xb; float* sq2; int dry;
    DI void operator()(const pg8::f32x4 (&acc)[2][2][4][2], const pg8::Unit& u, int wr, int wc, int fr, int fq) const {
        asm volatile("" : "+v"(fr), "+v"(fq));
        EPI_ROWS_BEGIN
            const float rs = row_rstd(sq1, row); float ss = 0.f;
            EPI_COLS_BEGIN
                float* o = out + (size_t)row * 1024 + col; const float* pt = PT + (size_t)row * 1024 + col;
                const f32x4 b0 = *(const f32x4*)o, b1 = *(const f32x4*)(o + 4), p0 = *(const f32x4*)pt, p1 = *(const f32x4*)(pt + 4);
                const float xb_[8] = {b0.x, b0.y, b0.z, b0.w, b1.x, b1.y, b1.z, b1.w}, pp[8] = {p0.x, p0.y, p0.z, p0.w, p1.x, p1.y, p1.z, p1.w};
#pragma unroll
                for (int k = 0; k < 8; ++k) { v[k] = xb_[k] + sigm(v[k] * rs) * pp[k]; ss += v[k] * v[k]; }
                if (!dry) { *(f32x4*)o = (f32x4){v[0], v[1], v[2], v[3]}; *(f32x4*)(o + 4) = (f32x4){v[4], v[5], v[6], v[7]};
                *(u32x4*)(xb + (size_t)row * 1024 + col) = pack8(v); }
            }
            ss += __shfl_xor(ss, 16); ss += __shfl_xor(ss, 32);
            if (fq == 0 && !dry) sq2[(size_t)row * 16 + 4 * u.pn + wc] = ss;
        }
    }
    DI void mini(int row, int col, f32x4 s) const {
        const float rs = row_rstd(sq1, row); float* o = out + (size_t)row * 1024 + col; const f32x4 b0 = *(const f32x4*)o, p0 = *(const f32x4*)(PT + (size_t)row * 1024 + col);
        f32x4 x; x.x = b0.x + sigm(s.x * rs) * p0.x; x.y = b0.y + sigm(s.y * rs) * p0.y; x.z = b0.z + sigm(s.z * rs) * p0.z; x.w = b0.w + sigm(s.w * rs) * p0.w;
        float ss = (x.x * x.x + x.y * x.y) + (x.z * x.z + x.w * x.w);
        ss += __shfl_xor(ss, 1); ss += __shfl_xor(ss, 2); ss += __shfl_xor(ss, 4); ss += __shfl_xor(ss, 8);
        if (!dry) { *(f32x4*)o = x; u32x2 w; w.x = pk2(x.x, x.y); w.y = pk2(x.z, x.w); *(u32x2*)(xb + (size_t)row * 1024 + col) = w;
            if ((col & 63) == 0) sq2[(size_t)row * 16 + (col >> 6)] = ss; }
    }
};

struct OrderG {
    pg8::StaticOrder S; int G, c;
    DI void init(int G_, int c_) { S.init(MP, 13 * 256, G_, c_); G = G_; c = c_; }
    DI bool next(int i, pg8::Unit& u) const { if (S.next(i, u)) return true; const long s = (long)i * G + c - 64 * 13; if (s >= 2 * NWIN_T) return false; u.pm = 64 + (int)(s / NWIN_T); u.pn = (int)(s % NWIN_T); return true; }
    DI void a_ready(const pg8::Unit&) const {}
    DI void done(const pg8::Unit&) const {}
};
struct OrderM {
    pg8::StaticOrder S;
    DI void init(int G_, int c_) { S.init(MP, 1024, G_, c_); }
    DI bool next(int i, pg8::Unit& u) const { pg8::Unit v; if (!S.next(i >> 1, v)) return false; u.pm = v.pm; u.pn = 4 * (i & 1) + v.pn; return true; }
    DI void a_ready(const pg8::Unit&) const {}
    DI void done(const pg8::Unit&) const {}
};
template <class Epi> DI void run_gemm_m(LAS unsigned char* lds, const bf16_t* A, const bf16_t* Bt, const Epi& E) {
    int K = 1024; asm volatile("" : "+s"(K));
    pg8::Gemm g{A, Bt, MP, 8 * 256, K}; OrderM S; S.init((int)gridDim.x, (int)blockIdx.x);
    pg8::gemm_phase<Epi, OrderM, true, true>(lds, g, S, E);
}
template <class Epi> DI void run_gemm_g(LAS unsigned char* lds, const bf16_t* A, const bf16_t* Bt, const Epi& E) {
    int K = 1024; asm volatile("" : "+s"(K));
    pg8::Gemm g{A, Bt, MT, NWIN_T * 256, K}; OrderG S; S.init((int)gridDim.x, (int)blockIdx.x);
    pg8::gemm_phase<Epi, OrderG, true, true>(lds, g, S, E);
}
template <class Epi> DI void run_gemm(LAS unsigned char* lds, const bf16_t* A, const bf16_t* Bt, int M, int N, int K, const Epi& E) {
    asm volatile("" : "+s"(K), "+s"(N));
    pg8::Gemm g{A, Bt, M, N, K}; pg8::StaticOrder S; S.init(M, N, (int)gridDim.x, (int)blockIdx.x);
    pg8::gemm_phase<Epi, pg8::StaticOrder, true, true>(lds, g, S, E);
}

template <int K, class Epi> DI void mini_gemm(LAS unsigned char* lds, const bf16_t* A, const bf16_t* Wt, const Epi& E) {
    const int tid = otid(), lane = tid & 63, wave = __builtin_amdgcn_readfirstlane(tid >> 6), r = lane & 15, q = lane >> 4;
    constexpr int KW = K / 8;
    for (int mt = blockIdx.x; mt < 256; mt += gridDim.x) {
        const int row0 = 32 * (mt >> 4), cb = mt & 15, tile = cb >> 2, wcp = cb & 3, k0 = wave * KW;
        f32x4 acc[4][2];
#pragma unroll
        for (int ct = 0; ct < 4; ++ct) { acc[ct][0] = (f32x4){0.f, 0.f, 0.f, 0.f}; acc[ct][1] = (f32x4){0.f, 0.f, 0.f, 0.f}; }
#pragma unroll
        for (int ks = 0; ks < KW / 32; ++ks) {
            bf16x8 af[2], wf[4];
#pragma unroll
            for (int rt = 0; rt < 2; ++rt) af[rt] = *(const bf16x8*)(A + (size_t)(row0 + 16 * rt + r) * K + k0 + 32 * ks + 8 * q);
#pragma unroll
            for (int ct = 0; ct < 4; ++ct) { const int x = 16 * ct + r, p = 128 * (x >> 5) + 32 * wcp + 16 * ((x >> 2) & 1) + 4 * ((x >> 3) & 3) + (x & 3);
                wf[ct] = *(const bf16x8*)(Wt + (size_t)(tile * 256 + p) * K + k0 + 32 * ks + 8 * q); }
#pragma unroll
            for (int ct = 0; ct < 4; ++ct)
#pragma unroll
                for (int rt = 0; rt < 2; ++rt) acc[ct][rt] = __builtin_amdgcn_mfma_f32_16x16x32_bf16(wf[ct], af[rt], acc[ct][rt], 0, 0, 0);
        }
        LAS float* part = (LAS float*)lds + wave * (32 * 68);
#pragma unroll
        for (int ct = 0; ct < 4; ++ct)
#pragma unroll
            for (int rt = 0; rt < 2; ++rt) *(LAS f32x4*)(part + (16 * rt + r) * 68 + 16 * ct + 4 * q) = acc[ct][rt];
        __syncthreads();
        { const int row = tid >> 4, c4 = (tid & 15) * 4; f32x4 s = (f32x4){0.f, 0.f, 0.f, 0.f};
#pragma unroll
          for (int w = 0; w < 8; ++w) s += *(const LAS f32x4*)((const LAS float*)lds + w * (32 * 68) + row * 68 + c4);
          E.mini(MP + row0 + row, 64 * cb + c4, s); }
        __syncthreads();
    }
}

struct Args { const float* in[21]; float* out; unsigned char* ws; int ph_lo, ph_hi; };
static_assert(sizeof(Args) == 192, "Args layout (kin/kout/kws offsets)");
enum { I_XP = 0, I_XS, I_STATE, I_CK, I_CV, I_PP, I_PS, I_NORMG, I_WIN, I_WGU, I_BG, I_GLAG, I_QG, I_KG, I_RELB, I_WA, I_WB, I_WO, I_PLEG, I_WPG, I_WPLE };

DI void transpose_item(const float* W, int ldw, int srccol0, int nvalid, const float* gain, bf16_t* WT, int K, int rowbase, int k0, LAS float* scr, int lane) {
#pragma unroll 16
    for (int i = 0; i < 32; ++i) { const int kk = 2 * i + (lane >> 5), c = lane & 31;
        float w = 0.f; if (c < nvalid) w = W[(size_t)(k0 + kk) * ldw + srccol0 + c]; if (gain) w *= gain[k0 + kk];
        scr[kk * 33 + c] = w; }
    asm volatile("s_waitcnt lgkmcnt(0)" ::: "memory");
    const int c8 = lane & 7;
#pragma unroll
    for (int j = 0; j < 4; ++j) { const int n = (lane >> 3) + 8 * j; const LAS float* s = scr + (8 * c8) * 33 + n;
        u32x4 o; o.x = pk2(s[0 * 33], s[1 * 33]); o.y = pk2(s[2 * 33], s[3 * 33]); o.z = pk2(s[4 * 33], s[5 * 33]); o.w = pk2(s[6 * 33], s[7 * 33]);
        const int prow = 16 * ((n >> 2) & 1) + 4 * (n >> 3) + (n & 3);
        *(u32x4*)(WT + (size_t)(rowbase + prow) * K + k0 + 8 * c8) = o; }
    asm volatile("s_waitcnt lgkmcnt(0)" ::: "memory");
}
DI int win_src(int t, int& nvalid) {
    nvalid = 256;
    if (t < 2) return t * 256; if (t < 4) return 512 + (t - 2) * 256; if (t < 8) return 1024 + (t - 4) * 256; if (t < 12) return 2064 + (t - 8) * 256;
    if (t == 12) { nvalid = 16; return 2048; }
    if (t < 17) return 3088 + (t - 13) * 256; if (t < 21) return 4112 + (t - 17) * 256; if (t < 25) return 5136 + (t - 21) * 256; if (t < 29) return 6160 + (t - 25) * 256;
    if (t < 33) return 7184 + (t - 29) * 256; return 8208 + (t - 33) * 256;
}
DI void transpose_generic(const float* W, int ldw, int K, int ntile, bool is_win, const float* gain, bf16_t* WT, int item, LAS float* scr, int lane) {
    const int nkb = K / 64; const int kb = item % nkb, nb = (item / nkb) & 7, t = item / (nkb * 8);
    int nvalid = 256, src = t * 256; if (is_win) src = win_src(t, nvalid);
    int nv = nvalid - 32 * nb; nv = nv < 0 ? 0 : (nv > 32 ? 32 : nv);
    transpose_item(W, ldw, src + 32 * nb, nv, gain, WT, K, t * 256 + 128 * (nb & 1) + 32 * (nb >> 1), kb * 64, scr, lane);
}
constexpr int WIN_ITEMS = NWIN_T * 8 * 16, SQ_ITEMS = 4 * 8 * 16, PLE_ITEMS = 4 * 8 * 4;
constexpr int N_IN = 9232;
DI void prep_win(const Args& a, int L, int gw, int ngw, LAS float* scr, int lane) {
    bf16_t* WT = (bf16_t*)(kws() + WS_WIN);
    for (int it = gw; it < WIN_ITEMS; it += ngw) transpose_generic(kin(I_WIN) + (size_t)L * 1024 * N_IN, N_IN, 1024, NWIN_T, true, kin(I_NORMG) + L * 1024, WT, it, scr, lane);
}
DI bf16_t* wsm(const Args& a, int L, int which) { return (bf16_t*)(kws() + WS_WSM + (size_t)L * WSM_LAYER + (size_t)which * 2 * MiB); }
DI void prep_small(const Args& a, int gw, int ngw, LAS float* scr, int lane) {
    constexpr int PER_L = 4 * SQ_ITEMS + PLE_ITEMS;
    for (int it = gw; it < 2 * PER_L; it += ngw) {
        const int L = it / PER_L; int r = it % PER_L;
        if (r < SQ_ITEMS) { transpose_generic(kin(I_WA) + (size_t)L * 1048576, 1024, 1024, 4, false, nullptr, wsm(a, L, 0), r, scr, lane); continue; } r -= SQ_ITEMS;
        if (r < SQ_ITEMS) { transpose_generic(kin(I_WB) + (size_t)L * 1048576, 1024, 1024, 4, false, nullptr, wsm(a, L, 1), r, scr, lane); continue; } r -= SQ_ITEMS;
        if (r < SQ_ITEMS) { transpose_generic(kin(I_WO) + (size_t)L * 1048576, 1024, 1024, 4, false, nullptr, wsm(a, L, 2), r, scr, lane); continue; } r -= SQ_ITEMS;
        if (r < SQ_ITEMS) { transpose_generic(kin(I_WPG) + (size_t)L * 1048576, 1024, 1024, 4, false, kin(I_PLEG) + L * 1024, wsm(a, L, 3), r, scr, lane); continue; } r -= SQ_ITEMS;
        transpose_generic(kin(I_WPLE) + (size_t)L * 262144, 1024, 256, 4, false, nullptr, wsm(a, L, 4), r, scr, lane);
    }
}
DI float wave_sum(float v) {
#pragma unroll
    for (int o = 1; o < 64; o <<= 1) v += __shfl_xor(v, o);
    return v;
}
DI void prep_shift(int gw, int lane) {
    if (gw < 32) { const int L = gw >> 4, h = gw & 15;
        float mq = fabsf(kin(I_QG)[L * 64 + lane]), mk = fabsf(kin(I_KG)[L * 64 + lane]), mb = 0.f;
        for (int i = lane; i < 257; i += 64) mb = fmaxf(mb, fabsf(kin(I_RELB)[((size_t)L * 16 + h) * 257 + i]));
#pragma unroll
        for (int o = 1; o < 64; o <<= 1) { mq = fmaxf(mq, __shfl_xor(mq, o)); mk = fmaxf(mk, __shfl_xor(mk, o)); mb = fmaxf(mb, __shfl_xor(mb, o)); }
        if (lane == 0) ((float*)(kws() + WS_MSH))[gw] = (8.f * mq * mk + mb) * LOG2E; }
}
DI void prep_rows(const Args& a, int gw, int ngw, int lane) {
    bf16_t* XB = (bf16_t*)(kws() + WS_XB); float* SQ2 = (float*)(kws() + WS_SQ2);
    const float* xp = kin(I_XP); const float* xs = kin(I_XS);
    for (int row0 = gw; row0 < MT; row0 += 4 * ngw) {
        f32x4 v[4][4];
#pragma unroll
        for (int u = 0; u < 4; ++u) { const int row = row0 + u * ngw; if (row < MT) { const float* x = row < MP ? xp + (size_t)row * 1024 : xs + (size_t)(row - MP) * 1024;
#pragma unroll
            for (int j = 0; j < 4; ++j) v[u][j] = ((const f32x4*)x)[lane + 64 * j]; } }
#pragma unroll
        for (int u = 0; u < 4; ++u) { const int row = row0 + u * ngw; if (row < MT) { float s = 0.f;
#pragma unroll
            for (int j = 0; j < 4; ++j) s += (v[u][j].x * v[u][j].x + v[u][j].y * v[u][j].y) + (v[u][j].z * v[u][j].z + v[u][j].w * v[u][j].w);
            s = wave_sum(s);
            if (lane < 16) SQ2[(size_t)row * 16 + lane] = lane == 0 ? s : 0.f;
#pragma unroll
            for (int j = 0; j < 4; ++j) { u32x2 w; w.x = pk2(v[u][j].x, v[u][j].y); w.y = pk2(v[u][j].z, v[u][j].w); ((u32x2*)(XB + (size_t)row * 1024))[lane + 64 * j] = w; } } }
    }
}
DI void prep_misc(const Args& a, int gtid, int ngt) {
    bf16_t* PB = (bf16_t*)(kws() + WS_PB);
    const float* pp = kin(I_PP); const float* ps = kin(I_PS);
    for (int i0 = gtid; i0 < 2 * MT * 32; i0 += 4 * ngt) {
        f32x4 p0[4], p1[4];
#pragma unroll
        for (int k = 0; k < 4; ++k) { const int i = i0 + k * ngt; if (i < 2 * MT * 32) { const int c8 = i & 31, row = (i >> 5) % MT, L = (i >> 5) / MT;
            const float* src = row < MP ? pp + ((size_t)L * MP + row) * 256 + c8 * 8 : ps + ((size_t)L * MS + (row - MP)) * 256 + c8 * 8; p0[k] = *(const f32x4*)src; p1[k] = *(const f32x4*)(src + 4); } }
#pragma unroll
        for (int k = 0; k < 4; ++k) { const int i = i0 + k * ngt; if (i < 2 * MT * 32) { const int c8 = i & 31, row = (i >> 5) % MT, L = (i >> 5) / MT;
            u32x4 w; w.x = pk2(p0[k].x, p0[k].y); w.y = pk2(p0[k].z, p0[k].w); w.z = pk2(p1[k].x, p1[k].y); w.w = pk2(p1[k].z, p1[k].w);
            *(u32x4*)(PB + ((size_t)L * MT + row) * 256 + c8 * 8) = w; } }
    }
    constexpr int PER = 448 * 1024 / 4;
    const float* ck = kin(I_CK); const float* cv = kin(I_CV); float* out = kout();
    for (int i0 = gtid; i0 < 32 * PER; i0 += 8 * ngt) {
        f32x4 v[8];
#pragma unroll
        for (int k = 0; k < 8; ++k) { const int i = i0 + k * ngt; if (i < 32 * PER) { const int lb = i / PER, r = i % PER, kv = lb >> 4, l_b = lb & 15;
            v[k] = *((const f32x4*)((kv ? cv : ck) + (size_t)l_b * 512 * 1024 + 64 * 1024) + r); } }
#pragma unroll
        for (int k = 0; k < 8; ++k) { const int i = i0 + k * ngt; if (i < 32 * PER) { const int lb = i / PER, r = i % PER, kv = lb >> 4, l_b = lb & 15;
            *((f32x4*)(out + (kv ? O_VS : O_KS) + (size_t)l_b * 512 * 1024) + r) = v[k]; } }
    }
}

DI void gla_prep(const Args& a, int L, int c, int h, LAS float* totp, LAS float* ra_s, float (&b)[16], float& blast) {
    const int tid = otid(), d = tid & 127, jq = __builtin_amdgcn_readfirstlane(tid >> 7);
    if (tid < 256) *(LAS f32x4*)(ra_s + tid * 4) = *(const f32x4*)((const float*)(kws() + WS_RA) + (size_t)c * 64 * 16 + tid * 4);
    const float* wg = kin(I_WGU) + (size_t)L * 16 * 512 + h * 128 + d; float w[16];
#pragma unroll
    for (int r = 0; r < 16; ++r) w[r] = wg[r * 512];
    const float bg = kin(I_BG)[L * 512 + h * 128 + d];
    __syncthreads();
    float run = 0.f;
#pragma unroll
    for (int jj = 0; jj < 16; ++jj) {
        const LAS f32x4* rp = (const LAS f32x4*)(ra_s + (16 * jq + jj) * 16); const f32x4 r0 = rp[0], r1 = rp[1], r2 = rp[2], r3 = rp[3];
        float r = bg;
        r += r0.x * w[0]; r += r0.y * w[1]; r += r0.z * w[2]; r += r0.w * w[3]; r += r1.x * w[4]; r += r1.y * w[5]; r += r1.z * w[6]; r += r1.w * w[7];
        r += r2.x * w[8]; r += r2.y * w[9]; r += r2.z * w[10]; r += r2.w * w[11]; r += r3.x * w[12]; r += r3.y * w[13]; r += r3.z * w[14]; r += r3.w * w[15];
        const float lg = (fminf(r, 0.f) - __logf(1.f + __expf(-fabsf(r)))) * (1.f / 16.f);
        run += lg; b[jj] = run;
    }
    totp[jq * 128 + d] = run;
    __syncthreads();
    const float t0 = totp[d], t1 = totp[128 + d], t2 = totp[256 + d], t3 = totp[384 + d];
    const float off = jq == 0 ? 0.f : jq == 1 ? t0 : jq == 2 ? t0 + t1 : t0 + t1 + t2;
    blast = (t0 + t1) + (t2 + t3);
#pragma unroll
    for (int jj = 0; jj < 16; ++jj) b[jj] += off;
    if (jq == 0) totp[512 + d] = blast;
}
DI bf16x8 lds16(const LAS unsigned char* p) { return *(const LAS bf16x8*)p; }
DI s16x4 lds8(const LAS unsigned char* p) { return *(const LAS s16x4*)p; }
DI void vt_load(const bf16_t* VT, u32x4 (&vr)[4]) {
    const int tid = otid();
#pragma unroll
    for (int k = 0; k < 4; ++k) vr[k] = *(const u32x4*)(VT + (size_t)(tid + 512 * k) * 8);
}
DI void vt_store(const u32x4 (&vr)[4], LAS unsigned char* vt) {
    const int tid = otid();
#pragma unroll
    for (int k = 0; k < 4; ++k) { const int i = tid + 512 * k; *(LAS u32x4*)(vt + ((i >> 3) * 72 + (i & 7) * 8) * 2) = vr[k]; }
}
constexpr int GA_KT = 0, GA_VT = 18432, GA_TOT = 55296;
DI void gla_a_phase(const Args& a, int L, LAS unsigned char* lds, int item_lo, int item_hi, int first_wg) {
    const int tid = otid(), lane = tid & 63, wave = __builtin_amdgcn_readfirstlane(tid >> 6), r = lane & 15, q = lane >> 4;
    const bf16_t* KA = (const bf16_t*)(kws() + WS_OV + 2 * SLOT) + (size_t)MT * 512; const bf16_t* VA = (const bf16_t*)(kws() + WS_OV + 1 * SLOT);
    bf16_t* ST = (bf16_t*)(kws() + WS_OV + 3 * SLOT); float* DC = (float*)(kws() + WS_DC);
    LAS float* totp = (LAS float*)(lds + GA_TOT);
    int wg0_ = (int)blockIdx.x - first_wg; if (wg0_ < 0) wg0_ += (int)gridDim.x;
    for (int item = item_lo + wg0_; item < item_hi; item += gridDim.x) {
        const int c = item >> 2, h = item & 3;
        const int d = tid & 127, jq = tid >> 7;
        bf16_t kraw[16]; u32x4 vr[4];
#pragma unroll
        for (int jj = 0; jj < 16; ++jj) kraw[jj] = KA[((size_t)c * 64 + 16 * jq + jj) * 512 + h * 128 + d];
        vt_load(VA + (size_t)(c * 4 + h) * 16384, vr);
        float b[16], blast; gla_prep(a, L, c, h, totp, (LAS float*)(lds + GA_VT), b, blast);
        { float kd[16];
#pragma unroll
          for (int jj = 0; jj < 16; ++jj) kd[jj] = bf2f(kraw[jj]) * __expf(blast - b[jj]);
          LAS u32x4* o = (LAS u32x4*)(lds + GA_KT + (d * 72 + 16 * jq) * 2); o[0] = pack8(kd); o[1] = pack8(kd + 8); }
        if (jq == 0) DC[(size_t)item * 128 + d] = __expf(blast);
        vt_store(vr, lds + GA_VT);
        __syncthreads();
        f32x4 acc[8][2];
#pragma unroll
        for (int dt = 0; dt < 8; ++dt) { acc[dt][0] = (f32x4){0.f, 0.f, 0.f, 0.f}; acc[dt][1] = (f32x4){0.f, 0.f, 0.f, 0.f}; }
#pragma unroll
        for (int s = 0; s < 2; ++s) {
            bf16x8 bv[2];
#pragma unroll
            for (int vt = 0; vt < 2; ++vt) bv[vt] = lds16(lds + GA_VT + ((32 * wave + 16 * vt + r) * 72 + 32 * s + 8 * q) * 2);
#pragma unroll
            for (int dt = 0; dt < 8; ++dt) { const bf16x8 ak = lds16(lds + GA_KT + ((16 * dt + r) * 72 + 32 * s + 8 * q) * 2);
#pragma unroll
                for (int vt = 0; vt < 2; ++vt) acc[dt][vt] = __builtin_amdgcn_mfma_f32_16x16x32_bf16(ak, bv[vt], acc[dt][vt], 0, 0, 0); }
        }
        if (c < NPC) {
#pragma unroll
            for (int vt = 0; vt < 2; ++vt)
#pragma unroll
                for (int dt = 0; dt < 8; ++dt) { u32x2 w; w.x = pk2(acc[dt][vt][0], acc[dt][vt][1]); w.y = pk2(acc[dt][vt][2], acc[dt][vt][3]);
                    *(u32x2*)(ST + (size_t)item * 32768 + (32 * wave + 16 * vt + r) * 128 + 16 * dt + 4 * q) = w; }
        } else {
            const int bb = c - NPC; const size_t so = (((size_t)L * 8 + bb) * 4 + h) * 32768;
            const float* s0 = kin(I_STATE) + so; float* s1 = kout() + O_SS + so;
#pragma unroll
            for (int dt = 0; dt < 8; ++dt)
#pragma unroll
                for (int e = 0; e < 4; ++e) { const int dd = 16 * dt + 4 * q + e; const float dc = __expf(totp[512 + dd]);
#pragma unroll
                    for (int vt = 0; vt < 2; ++vt) { const int v = 32 * wave + 16 * vt + r; s1[dd * 256 + v] = dc * s0[dd * 256 + v] + acc[dt][vt][e]; } }
        }
        __syncthreads();
    }
}
template <int NG> DI void gla_scan_gts(int L, int dry, const int (&gts)[NG], bf16_t* ST, const float* DC) {
    int e4[NG], bb[NG], h[NG], d[NG]; float run[NG][4];
#pragma unroll
    for (int g = 0; g < NG; ++g) { const int bh = gts[g] >> 13; e4[g] = gts[g] & 8191; bb[g] = bh >> 2; h[g] = bh & 3; d[g] = (4 * e4[g]) & 127; run[g][0] = run[g][1] = run[g][2] = run[g][3] = 0.f; }
    for (int n0 = 0; n0 < 64; n0 += 8) {
        u32x2 cur[NG][8]; f32x4 dc[NG][8];
#pragma unroll
        for (int g = 0; g < NG; ++g)
#pragma unroll
            for (int k = 0; k < 8; ++k) { const size_t it = (size_t)(bb[g] * 64 + n0 + k) * 4 + h[g]; cur[g][k] = *(const u32x2*)(ST + it * 32768 + 4 * e4[g]); dc[g][k] = *(const f32x4*)(DC + it * 128 + d[g]); }
#pragma unroll
        for (int g = 0; g < NG; ++g)
#pragma unroll
            for (int k = 0; k < 8; ++k) { const size_t it = (size_t)(bb[g] * 64 + n0 + k) * 4 + h[g];
                u32x2 w; w.x = pk2(run[g][0], run[g][1]); w.y = pk2(run[g][2], run[g][3]); if (!dry || run[g][0] == 1.2345e30f) *(u32x2*)(ST + it * 32768 + 4 * e4[g]) = w;
                run[g][0] = dc[g][k].x * run[g][0] + bflo(cur[g][k].x); run[g][1] = dc[g][k].y * run[g][1] + bfhi(cur[g][k].x); run[g][2] = dc[g][k].z * run[g][2] + bflo(cur[g][k].y); run[g][3] = dc[g][k].w * run[g][3] + bfhi(cur[g][k].y); }
    }
#pragma unroll
    for (int g = 0; g < NG; ++g) { float* o = kout() + O_SP + (((size_t)L * 4 + bb[g]) * 4 + h[g]) * 32768; const int v = (4 * e4[g]) >> 7;
#pragma unroll
        for (int e = 0; e < 4; ++e) if (!dry || run[g][e] == 1.2345e30f) o[(d[g] + e) * 256 + v] = run[g][e]; }
}
DI void gla_scan_phase(const Args& a, int L, int dry) {
    bf16_t* ST = (bf16_t*)(kws() + WS_OV + 3 * SLOT); const float* DC = (const float*)(kws() + WS_DC);
    const int w = (int)blockIdx.x, G = (int)gridDim.x, tid = otid();
    if (G == 256) {
        if (w >= 128) { const int gts[2] = {(w - 128) * NTHREADS + tid, 65536 + (w - 128) * NTHREADS + tid}; gla_scan_gts<2>(L, dry, gts, ST, DC); }
    } else {
        for (int gt = w * NTHREADS + tid; gt < 16 * 8192; gt += G * NTHREADS) { const int gts[1] = {gt}; gla_scan_gts<1>(L, dry, gts, ST, DC); }
    }
}
constexpr int GC_QS = 0, GC_KS = 17408, GC_VT = 34816, GC_SS = 71680, GC_TOT = 141312, GC_RED = 143872;
DI void gla_c_phase(const Args& a, int L, LAS unsigned char* lds, int dry, int item_lo, int item_hi, int first_wg) {
    const int tid = otid(), lane = tid & 63, wave = __builtin_amdgcn_readfirstlane(tid >> 6), r = lane & 15, q = lane >> 4, it = wave & 3, vh = wave >> 2;
    const bf16_t* QA = (const bf16_t*)(kws() + WS_OV + 2 * SLOT); const bf16_t* KA = QA + (size_t)MT * 512; const bf16_t* VA = (const bf16_t*)(kws() + WS_OV + 1 * SLOT);
    bf16_t* SGA = (bf16_t*)(kws() + WS_OV); const bf16_t* ST = (const bf16_t*)(kws() + WS_OV + 3 * SLOT);
    LAS float* totp = (LAS float*)(lds + GC_TOT); LAS float* red = (LAS float*)(lds + GC_RED);
    const float* gg = kin(I_GLAG) + L * 256;
    int wg0_ = (int)blockIdx.x - first_wg; if (wg0_ < 0) wg0_ += (int)gridDim.x;
    for (int item = item_lo + wg0_; item < item_hi; item += gridDim.x) {
        const int c = item >> 2, h = item & 3;
        const int d = tid & 127, jq = tid >> 7;
        bf16_t qraw[16], kraw[16]; u32x4 vr[4], sr[8];
#pragma unroll
        for (int jj = 0; jj < 16; ++jj) { const size_t g = ((size_t)c * 64 + 16 * jq + jj) * 512 + h * 128 + d; qraw[jj] = QA[g]; kraw[jj] = KA[g]; }
        vt_load(VA + (size_t)(c * 4 + h) * 16384, vr);
        if (c < NPC) { const bf16_t* s = ST + (size_t)item * 32768;
#pragma unroll
            for (int k = 0; k < 8; ++k) sr[k] = *(const u32x4*)(s + (size_t)(tid + 512 * k) * 8); }
        float b[16], blast; gla_prep(a, L, c, h, totp, (LAS float*)(lds + GC_SS), b, blast);
#pragma unroll
        for (int jj = 0; jj < 16; ++jj) { const int j = 16 * jq + jj; const float eb = __expf(b[jj]);
            ((LAS bf16_t*)(lds + GC_QS))[j * 136 + d] = (bf16_t)pk2(bf2f(qraw[jj]) * eb, 0.f);
            ((LAS bf16_t*)(lds + GC_KS))[j * 136 + d] = (bf16_t)pk2(bf2f(kraw[jj]) * __builtin_amdgcn_rcpf(eb), 0.f); }
        vt_store(vr, lds + GC_VT);
        if (c < NPC) {
#pragma unroll
            for (int k = 0; k < 8; ++k) { const int i = tid + 512 * k, v = i >> 4, c8 = i & 15; *(LAS u32x4*)(lds + GC_SS + (v * 136 + c8 * 8) * 2) = sr[k]; }
        } else {
            const float* s0 = kin(I_STATE) + ((((size_t)L * 8 + (c - NPC)) * 4 + h) * 32768);
            for (int i = tid; i < 8192; i += NTHREADS) { const int dd = i & 127, v4 = i >> 7; const f32x4 s = *(const f32x4*)(s0 + dd * 256 + v4 * 4); LAS bf16_t* o = (LAS bf16_t*)(lds + GC_SS) + (v4 * 4) * 136 + dd;
                o[0] = (bf16_t)pk2(s.x, 0.f); o[136] = (bf16_t)pk2(s.y, 0.f); o[272] = (bf16_t)pk2(s.z, 0.f); o[408] = (bf16_t)pk2(s.w, 0.f); }
        }
        __syncthreads();
        bf16_t* orow = SGA + ((size_t)c * 64 + 16 * it + r) * 1024 + h * 256;
        u32x2 gate[8];
#pragma unroll
        for (int vt = 0; vt < 8; ++vt) gate[vt] = *(const u32x2*)(orow + 128 * vh + 16 * vt + 4 * q);
        bf16x8 bq[4];
#pragma unroll
        for (int ks = 0; ks < 4; ++ks) bq[ks] = lds16(lds + GC_QS + ((16 * it + r) * 136 + 32 * ks + 8 * q) * 2);
        f32x4 at[4];
#pragma unroll
        for (int jt = 0; jt < 4; ++jt) { at[jt] = (f32x4){0.f, 0.f, 0.f, 0.f};
            if (jt <= it) {
#pragma unroll
                for (int ks = 0; ks < 4; ++ks) at[jt] = __builtin_amdgcn_mfma_f32_16x16x32_bf16(lds16(lds + GC_KS + ((16 * jt + r) * 136 + 32 * ks + 8 * q) * 2), bq[ks], at[jt], 0, 0, 0);
                if (jt == it) {
#pragma unroll
                    for (int e = 0; e < 4; ++e) if (4 * q + e > r) at[jt][e] = 0.f;
                } } }
        bf16x8 bp[2];
#pragma unroll
        for (int s = 0; s < 2; ++s) { u32x4 w; w.x = pk2(at[2 * s][0], at[2 * s][1]); w.y = pk2(at[2 * s][2], at[2 * s][3]); w.z = pk2(at[2 * s + 1][0], at[2 * s + 1][1]); w.w = pk2(at[2 * s + 1][2], at[2 * s + 1][3]); bp[s] = __builtin_bit_cast(bf16x8, w); }
        f32x4 o[8];
#pragma unroll
        for (int vt = 0; vt < 8; ++vt) { o[vt] = (f32x4){0.f, 0.f, 0.f, 0.f}; const int v = 128 * vh + 16 * vt + r;
#pragma unroll
            for (int s = 0; s < 2; ++s) if (2 * s <= it) { const s16x4 lo = lds8(lds + GC_VT + (v * 72 + 32 * s + 4 * q) * 2), hi = lds8(lds + GC_VT + (v * 72 + 32 * s + 16 + 4 * q) * 2);
                const bf16x8 av = __builtin_shufflevector(lo, hi, 0, 1, 2, 3, 4, 5, 6, 7); o[vt] = __builtin_amdgcn_mfma_f32_16x16x32_bf16(av, bp[s], o[vt], 0, 0, 0); }
#pragma unroll
            for (int ks = 0; ks < 4; ++ks) o[vt] = __builtin_amdgcn_mfma_f32_16x16x32_bf16(lds16(lds + GC_SS + (v * 136 + 32 * ks + 8 * q) * 2), bq[ks], o[vt], 0, 0, 0); }
        float ss = 0.f;
#pragma unroll
        for (int vt = 0; vt < 8; ++vt) ss += (o[vt][0] * o[vt][0] + o[vt][1] * o[vt][1]) + (o[vt][2] * o[vt][2] + o[vt][3] * o[vt][3]);
        ss += __shfl_xor(ss, 16); ss += __shfl_xor(ss, 32);
        if (q == 0) red[vh * 64 + 16 * it + r] = ss;
        __syncthreads();
        const float rstd = rsqrtf((red[16 * it + r] + red[64 + 16 * it + r]) * (1.f / 256.f) + EPS);
#pragma unroll
        for (int vt = 0; vt < 8; ++vt) { const int v = 128 * vh + 16 * vt + 4 * q; const u32x2 g = gate[vt]; const f32x4 gn = *(const f32x4*)(gg + v);
            u32x2 w; w.x = pk2(o[vt][0] * rstd * gn.x * bflo(g.x), o[vt][1] * rstd * gn.y * bfhi(g.x)); w.y = pk2(o[vt][2] * rstd * gn.z * bflo(g.y), o[vt][3] * rstd * gn.w * bfhi(g.y));
            if (!dry || rstd == 1.2345e30f) *(u32x2*)(orow + v) = w; }
        __syncthreads();
    }
}

constexpr int AT_KS = 0, AT_VT = 36864, AT_BIAS = 73728, AT_BUF = 18432;
template <bool SAMPLE> DI void attn_load_k(int L, const bf16_t* KB, const float* ck, int bb, int n, int t, int hh, int sj, int sdq, u32x4& w0, u32x4& w1) {
    if (SAMPLE && t < 8) { const float* s = ck + (((size_t)L * 8 + bb) * 512 + t * 64 + sj) * 1024 + hh * 64 + 16 * sdq;
        const f32x4 f0 = *(const f32x4*)s, f1 = *(const f32x4*)(s + 4), f2 = *(const f32x4*)(s + 8), f3 = *(const f32x4*)(s + 12);
        w0.x = pk2(f0.x, f0.y); w0.y = pk2(f0.z, f0.w); w0.z = pk2(f1.x, f1.y); w0.w = pk2(f1.z, f1.w); w1.x = pk2(f2.x, f2.y); w1.y = pk2(f2.z, f2.w); w1.z = pk2(f3.x, f3.y); w1.w = pk2(f3.z, f3.w);
    } else { const size_t krow = SAMPLE ? (size_t)bb * 64 + sj : (size_t)bb * 4096 + (n - 8 + t) * 64 + sj; const bf16_t* s = KB + krow * 1024 + hh * 64 + 16 * sdq; w0 = *(const u32x4*)s; w1 = *(const u32x4*)(s + 8); }
}
template <bool SAMPLE> DI void attn_load_v(int L, const bf16_t* VBT, const float* cv, int bb, int n, int t, int hh, int tid, u32x4& w0, u32x4& w1) {
    if (SAMPLE && t < 8) { const int sj2 = tid & 63, dq2 = (tid >> 6) & 3; const float* s = cv + (((size_t)L * 8 + bb) * 512 + t * 64 + sj2) * 1024 + hh * 64 + 16 * dq2;
        const f32x4 f0 = *(const f32x4*)s, f1 = *(const f32x4*)(s + 4), f2 = *(const f32x4*)(s + 8), f3 = *(const f32x4*)(s + 12);
        w0.x = pk2(f0.x, f0.y); w0.y = pk2(f0.z, f0.w); w0.z = pk2(f1.x, f1.y); w0.w = pk2(f1.z, f1.w); w1.x = pk2(f2.x, f2.y); w1.y = pk2(f2.z, f2.w); w1.z = pk2(f3.x, f3.y); w1.w = pk2(f3.z, f3.w);
    } else { const int cc = SAMPLE ? bb : bb * 64 + (n - 8 + t); const bf16_t* s = VBT + ((size_t)cc * 16 + hh) * 4096 + (size_t)(tid & 255) * 8; w0 = *(const u32x4*)s; w1 = *(const u32x4*)(s + 2048); }
}
template <bool SAMPLE> DI void attn_item(const Args& a, int L, LAS unsigned char* lds, int dry, int item, bool stage_bias) {
    const int tid = otid(), lane = tid & 63, wave = __builtin_amdgcn_readfirstlane(tid >> 6), r = lane & 15, q = lane >> 4, g = wave >> 2, it = wave & 3;
    const bf16_t* QB = (const bf16_t*)(kws() + (SAMPLE ? WS_AX : WS_OV + 1 * SLOT)); const bf16_t* KB = (const bf16_t*)(kws() + (SAMPLE ? WS_AX + 1 * MiB : WS_OV + 2 * SLOT));
    const bf16_t* VB = (const bf16_t*)(kws() + (SAMPLE ? WS_AX + 2 * MiB : WS_OV + 3 * SLOT)); const bf16_t* GBs = (const bf16_t*)(kws() + (SAMPLE ? WS_AX + 3 * MiB : WS_OV + 4 * SLOT));
    bf16_t* SGB = (bf16_t*)(kws() + WS_OV + 4 * SLOT);
    const float* ck = kin(I_CK); const float* cv = kin(I_CV);
    LAS float* bias_s = (LAS float*)(lds + AT_BIAS);
    const int sg = tid >> 8, sj = (tid >> 2) & 63, sdq = tid & 3;
    const int c = item >> 3, hp = item & 7, h = 2 * hp + g;
    const int bb = SAMPLE ? c - NPC : c >> 6, n = SAMPLE ? 8 : c & 63, t0 = n >= 8 ? 0 : 8 - n;
    if (stage_bias) { const float* msh = (const float*)(kws() + WS_MSH) + L * 16 + 2 * hp;
    for (int i = tid; i < 2 * 257; i += NTHREADS) { const int g2 = i / 257, idx = i % 257; bias_s[g2 * 260 + idx] = kin(I_RELB)[((size_t)L * 16 + 2 * hp + g2) * 257 + idx] * LOG2E - msh[g2]; } }
    const size_t qrow = (size_t)c * 64 + 16 * it + r, qrl = SAMPLE ? qrow - MP : qrow;
    bf16x8 qf[2];
#pragma unroll
    for (int ks = 0; ks < 2; ++ks) qf[ks] = *(const bf16x8*)(QB + qrl * 1024 + h * 64 + 32 * ks + 8 * q);
    const int qi = 16 * it + r;
    bf16_t* orow = SGB + qrow * 1024 + h * 64;
    float l_run = 0.f;
    f32x4 o[4];
#pragma unroll
    for (int dt = 0; dt < 4; ++dt) o[dt] = (f32x4){0.f, 0.f, 0.f, 0.f};
    u32x4 k0, k1, v0, v1;
#define ATT_LOADT(T_) do { attn_load_k<SAMPLE>(L, KB, ck, bb, n, (T_), 2 * hp + sg, sj, sdq, k0, k1); attn_load_v<SAMPLE>(L, VB, cv, bb, n, (T_), 2 * hp + sg, tid, v0, v1); } while (0)
#define ATT_WRITE(T_, BUF_) do { const int bo_ = (BUF_) * AT_BUF; \
        LAS u32x4* ok = (LAS u32x4*)(lds + AT_KS + bo_ + ((sg * 64 + sj) * 72 + 16 * sdq) * 2); ok[0] = k0; ok[1] = k1; \
        if (SAMPLE && (T_) < 8) { const int sj2 = tid & 63, dq2 = (tid >> 6) & 3; LAS bf16_t* ov = (LAS bf16_t*)(lds + AT_VT + bo_) + (sg * 64 + 16 * dq2) * 72 + sj2; \
            ov[0] = (bf16_t)v0.x; ov[72] = (bf16_t)(v0.x >> 16); ov[144] = (bf16_t)v0.y; ov[216] = (bf16_t)(v0.y >> 16); ov[288] = (bf16_t)v0.z; ov[360] = (bf16_t)(v0.z >> 16); ov[432] = (bf16_t)v0.w; ov[504] = (bf16_t)(v0.w >> 16); \
            ov[576] = (bf16_t)v1.x; ov[648] = (bf16_t)(v1.x >> 16); ov[720] = (bf16_t)v1.y; ov[792] = (bf16_t)(v1.y >> 16); ov[864] = (bf16_t)v1.z; ov[936] = (bf16_t)(v1.z >> 16); ov[1008] = (bf16_t)v1.w; ov[1080] = (bf16_t)(v1.w >> 16); \
        } else { const int p0 = tid & 255, p1 = p0 + 256; \
            *(LAS u32x4*)(lds + AT_VT + bo_ + ((sg * 64 + (p0 >> 3)) * 72 + (p0 & 7) * 8) * 2) = v0; *(LAS u32x4*)(lds + AT_VT + bo_ + ((sg * 64 + (p1 >> 3)) * 72 + (p1 & 7) * 8) * 2) = v1; } } while (0)
    ATT_LOADT(t0);
    ATT_WRITE(t0, 0);
    if (t0 + 1 < 9) ATT_LOADT(t0 + 1);
    __syncthreads();
#pragma unroll 1
    for (int t = t0; t < 9; ++t) {
        const int cb = (t - t0) & 1;
        if (t + 1 < 9) { ATT_WRITE(t + 1, cb ^ 1); if (t + 2 < 9) ATT_LOADT(t + 2); }
        const LAS unsigned char* kb_ = lds + AT_KS + cb * AT_BUF; const LAS unsigned char* vb_ = lds + AT_VT + cb * AT_BUF;
        f32x4 sc[4];
#pragma unroll
        for (int jt = 0; jt < 4; ++jt) { f32x4 acc = (f32x4){0.f, 0.f, 0.f, 0.f};
#pragma unroll
            for (int ks = 0; ks < 2; ++ks) acc = __builtin_amdgcn_mfma_f32_16x16x32_bf16(lds16(kb_ + ((g * 64 + 16 * jt + r) * 72 + 32 * ks + 8 * q) * 2), qf[ks], acc, 0, 0, 0);
            sc[jt] = acc; }
        if (t >= 6) {
#pragma unroll
            for (int jt = 0; jt < 4; ++jt)
#pragma unroll
                for (int e = 0; e < 4; ++e) { int rel = 512 + qi - (64 * t + 16 * jt + 4 * q + e); rel = rel > 128 ? 128 : rel; rel = rel < -128 ? -128 : rel; sc[jt][e] += bias_s[g * 260 + rel + 128]; }
        } else { const float bfar = bias_s[g * 260 + 256];
#pragma unroll
            for (int jt = 0; jt < 4; ++jt) sc[jt] = sc[jt] + bfar;
        }
        float ps = 0.f;
#pragma unroll
        for (int jt = 0; jt < 4; ++jt)
#pragma unroll
            for (int e = 0; e < 4; ++e) { const float p = __builtin_amdgcn_exp2f(sc[jt][e]); sc[jt][e] = p; ps += p; }
        l_run += ps;
#pragma unroll
        for (int s = 0; s < 2; ++s) {
            u32x4 w; w.x = pk2(sc[2 * s][0], sc[2 * s][1]); w.y = pk2(sc[2 * s][2], sc[2 * s][3]); w.z = pk2(sc[2 * s + 1][0], sc[2 * s + 1][1]); w.w = pk2(sc[2 * s + 1][2], sc[2 * s + 1][3]);
            const bf16x8 bp = __builtin_bit_cast(bf16x8, w);
#pragma unroll
            for (int dt = 0; dt < 4; ++dt) { const LAS unsigned char* vp = vb_ + ((g * 64 + 16 * dt + r) * 72 + 32 * s + 4 * q) * 2;
                const s16x4 lo = lds8(vp), hi = lds8(vp + 32); const bf16x8 av = __builtin_shufflevector(lo, hi, 0, 1, 2, 3, 4, 5, 6, 7);
                o[dt] = __builtin_amdgcn_mfma_f32_16x16x32_bf16(av, bp, o[dt], 0, 0, 0); }
        }
        __syncthreads();
    }
#undef ATT_LOADT
#undef ATT_WRITE
    l_run += __shfl_xor(l_run, 16); l_run += __shfl_xor(l_run, 32);
    const float inv = __builtin_amdgcn_rcpf(l_run);
#pragma unroll
    for (int dt = 0; dt < 4; ++dt) { const int dd = 16 * dt + 4 * q; const u32x2 gv = *(const u32x2*)(GBs + qrl * 1024 + h * 64 + dd);
        u32x2 w; w.x = pk2(o[dt][0] * inv * bflo(gv.x), o[dt][1] * inv * bfhi(gv.x)); w.y = pk2(o[dt][2] * inv * bflo(gv.y), o[dt][3] * inv * bfhi(gv.y));
        if (!dry || inv == 1.2345e30f) *(u32x2*)(orow + dd) = w; }
}
DI void attn_phase(const Args& a, int L, LAS unsigned char* lds, int dry, int item_lo, int item_hi, int first_wg) {
    int wg0_ = (int)blockIdx.x - first_wg; if (wg0_ < 0) wg0_ += (int)gridDim.x;
    int prev_hp = -1;
    for (int item = item_lo + wg0_; item < item_hi; item += gridDim.x) { const bool sb = (item & 7) != prev_hp; prev_hp = item & 7;
        if ((item >> 3) >= NPC) attn_item<true>(a, L, lds, dry, item, sb); else attn_item<false>(a, L, lds, dry, item, sb); }
}

#define XB_TMO      128
#define XB_XCNT(j)  (256  + 64 * (j))
#define XB_XSUB(j)  (1280 + 64 * (j))
#define XB_XGEN(j)  (2304 + 64 * (j))
#define XB_TOP      3328
#define XB_TOPGEN   3392
#define XCD_BAR_WORDS 3456
#define XB_SPIN_CAP (1u << 18)

__device__ __forceinline__ unsigned xb_ld(unsigned* p)              { return __hip_atomic_load(p, __ATOMIC_RELAXED, __HIP_MEMORY_SCOPE_AGENT); }
__device__ __forceinline__ unsigned xb_add(unsigned* p, unsigned v) { return __hip_atomic_fetch_add(p, v, __ATOMIC_RELAXED, __HIP_MEMORY_SCOPE_AGENT); }
__device__ __forceinline__ unsigned xb_xcc_id() { return (unsigned)__builtin_amdgcn_s_getreg((3 << 11) | 20) & 0xFu; }
#define XB_SPIN(cond, bar) do { unsigned _sp = 0; while (cond) { __builtin_amdgcn_s_sleep(1); \
    if ((++_sp & 255u) == 0u) { if (xb_ld(&(bar)[XB_TMO])) break; if (_sp > XB_SPIN_CAP) { atomicAdd(&(bar)[XB_TMO], 1u); break; } } } } while (0)

struct XcdBarrier {
    unsigned* bar; unsigned x;
    volatile LAS unsigned* st;
};

__device__ __forceinline__ XcdBarrier xcd_barrier_post(unsigned* bar, volatile LAS unsigned* st) {
    XcdBarrier b; b.bar = bar; b.x = xb_xcc_id(); b.st = st;
    if (threadIdx.x == 0) (void)xb_add(&bar[XB_XCNT(b.x)], 1u);
    return b;
}
__device__ __forceinline__ void xcd_barrier_complete(unsigned* bar, unsigned x, unsigned& nloc, unsigned& nx) {
    const unsigned G = gridDim.x * gridDim.y * gridDim.z;
    unsigned sum, cnt, mine, sp = 0u;
    for (;;) {
        sum = 0u; cnt = 0u; mine = 0u;
#pragma unroll
        for (unsigned j = 0; j < 16; ++j) { const unsigned c = xb_ld(&bar[XB_XCNT(j)]); sum += c; cnt += (c > 0u) ? 1u : 0u; mine = (j == x) ? c : mine; }
        if (sum == G) break;
        __builtin_amdgcn_s_sleep(1);
        if ((++sp & 255u) == 0u) { if (xb_ld(&bar[XB_TMO])) break; if (sp > XB_SPIN_CAP) { atomicAdd(&bar[XB_TMO], 1u); break; } }
    }
    nloc = mine > 0u ? mine : 1u; nx = cnt > 0u ? cnt : 1u;
}

__device__ __forceinline__ void xcd_barrier(const XcdBarrier& b) {
    asm volatile("s_waitcnt vmcnt(0)" ::: "memory");
    __syncthreads();
    if (threadIdx.x == 0) {
        unsigned* bar = b.bar;
        __builtin_amdgcn_s_waitcnt(0);
        unsigned nloc = b.st[0], nx = b.st[1];
        if (nloc == 0u) { xcd_barrier_complete(bar, b.x, nloc, nx); b.st[0] = nloc; b.st[1] = nx; }
        const unsigned old = xb_add(&bar[XB_XSUB(b.x)], 1u);
        const unsigned gen = old / nloc;
        if (old + 1u == (gen + 1u) * nloc) {
            __builtin_amdgcn_fence(__ATOMIC_RELEASE, "agent");
            asm volatile("s_waitcnt vmcnt(0)" ::: "memory");
            const unsigned og = xb_add(&bar[XB_TOP], 1u);
            const unsigned tg = og / nx;
            if (og + 1u == (tg + 1u) * nx) xb_add(&bar[XB_TOPGEN], 1u);
            else XB_SPIN(xb_ld(&bar[XB_TOPGEN]) == tg, bar);
            __builtin_amdgcn_fence(__ATOMIC_ACQUIRE, "agent");
            xb_add(&bar[XB_XGEN(b.x)], 1u);
            asm volatile("s_waitcnt vmcnt(0)" ::: "memory");
        } else {
            XB_SPIN(xb_ld(&bar[XB_XGEN(b.x)]) == gen, bar);
            __builtin_amdgcn_fence(__ATOMIC_ACQUIRE, "agent");
            asm volatile("s_waitcnt vmcnt(0)" ::: "memory");
        }
    }
    __syncthreads();
}

#ifndef PROBE_REP
#define PROBE_REP 0
#endif
#ifndef EN_CH
#define EN_CH 31
#endif
#ifndef EN_PREP
#define EN_PREP 1
#endif
#ifndef EN_GIN
#define EN_GIN 1
#endif
#ifndef EN_GLAA
#define EN_GLAA 1
#endif
#ifndef EN_SCAN
#define EN_SCAN 1
#endif
#ifndef EN_GLAC
#define EN_GLAC 1
#endif
#ifndef EN_ATTN
#define EN_ATTN 1
#endif
#ifndef EN_CHAIN
#define EN_CHAIN 1
#endif
constexpr int PH_PER_LAYER = 10, N_PHASES = 1 + 2 * PH_PER_LAYER;
constexpr int MISC_OFF = LDS_BYTES - 64;
#define REPS(k) (((PROBE_REP >> (k)) & 1) ? 2 : 1)
__global__ void __launch_bounds__(NTHREADS, 2) fwd_kernel(Args a) {
    extern __shared__ __attribute__((aligned(16))) unsigned char lds_raw[];
    LAS unsigned char* lds = (LAS unsigned char*)lds_raw;
    const int tid = otid(), lane = tid & 63, wave = __builtin_amdgcn_readfirstlane(tid >> 6);
    const int gw = blockIdx.x * 8 + wave, ngw = gridDim.x * 8, gtid = blockIdx.x * NTHREADS + tid, ngt = gridDim.x * NTHREADS;
    LAS float* scr = (LAS float*)(lds + wave * 16384);
    const int lo = kph_lo(), hi = kph_hi();
    volatile LAS unsigned* MISC = (volatile LAS unsigned*)(lds + MISC_OFF);
    if (tid < 16) MISC[tid] = 0u;
    __syncthreads();
    XcdBarrier bar; bar.bar = (unsigned*)kws(); bar.x = 0; bar.st = nullptr;
    if (hi - lo > 1) bar = xcd_barrier_post((unsigned*)kws(), MISC);
#define IN_PH(k) (lo <= (k) && (k) < hi)
#define SEAM(k) do { if (IN_PH(k) && IN_PH((k) + 1)) { xcd_barrier(bar); if ((PROBE_REP >> 11) & 1) xcd_barrier(bar); } } while (0)
    if (lo < 0) { __threadfence(); cg::this_grid().sync(); }
    if (EN_PREP && IN_PH(0)) for (int rep = 0; rep < REPS(10); ++rep) { prep_small(a, gw, ngw, scr, lane); prep_win(a, 0, gw, ngw, scr, lane); prep_rows(a, gw, ngw, lane); prep_shift(gw, lane); prep_misc(a, gtid, ngt); __syncthreads(); }
    SEAM(0);
    for (int L = 0; L < 2; ++L) {
        const int pb = 1 + L * PH_PER_LAYER;
        unsigned char* ws = kws();
        bf16_t* XB = (bf16_t*)(ws + WS_XB); float* SQ1 = (float*)(ws + WS_SQ1); float* SQ2 = (float*)(ws + WS_SQ2);
        bf16_t* S0 = (bf16_t*)(ws + WS_OV); bf16_t* S1 = (bf16_t*)(ws + WS_OV + SLOT); bf16_t* S2 = (bf16_t*)(ws + WS_OV + 2 * SLOT); bf16_t* S3 = (bf16_t*)(ws + WS_OV + 3 * SLOT); bf16_t* S4 = (bf16_t*)(ws + WS_OV + 4 * SLOT);
        const bf16_t* WIN = (const bf16_t*)(ws + WS_WIN);
        EpiIn ein; ein.L = L; ein.ws = ws; ein.out = kout(); ein.qg = kin(I_QG) + L * 64; ein.kg = kin(I_KG) + L * 64;
        if (EN_GIN && IN_PH(pb + 0)) for (int rep = 0; rep < REPS(0); ++rep) { ein.tile0 = 0; run_gemm_g(lds, XB, WIN, ein); }
        SEAM(pb + 0);
        if (EN_GLAA && IN_PH(pb + 1)) for (int rep = 0; rep < REPS(1); ++rep) gla_a_phase(a, L, lds, 0, NPC * 4, 0);
        SEAM(pb + 1);
        if (EN_SCAN && IN_PH(pb + 2)) for (int rep = 0; rep < REPS(2); ++rep) {
            gla_a_phase(a, L, lds, NPC * 4, NCH * 4, 0); gla_c_phase(a, L, lds, rep + 1 < REPS(2), NPC * 4, NCH * 4, 32);
            attn_phase(a, L, lds, rep + 1 < REPS(2), NPC * 8, NCH * 8, 64);
            gla_scan_phase(a, L, rep + 1 < REPS(2)); }
        SEAM(pb + 2);
        if (EN_GLAC && IN_PH(pb + 3)) for (int rep = 0; rep < REPS(3); ++rep) gla_c_phase(a, L, lds, rep + 1 < REPS(3), 0, NPC * 4, 0);
        SEAM(pb + 3);
        if (EN_GIN && IN_PH(pb + 4)) for (int rep = 0; rep < REPS(4); ++rep) { ein.tile0 = 13; run_gemm(lds, XB, WIN + (size_t)13 * 256 * 1024, MP, 16 * 256, 1024, ein); }
        SEAM(pb + 4);
        if (EN_ATTN && IN_PH(pb + 5)) for (int rep = 0; rep < REPS(5); ++rep) attn_phase(a, L, lds, rep + 1 < REPS(5), 0, NPC * 8, 0);
        SEAM(pb + 5);
        if (EN_GIN && IN_PH(pb + 6)) for (int rep = 0; rep < REPS(6); ++rep) { ein.tile0 = 29; run_gemm_m(lds, XB, WIN + (size_t)29 * 256 * 1024, ein); }
        if (!(IN_PH(pb + 6) && IN_PH(pb + 7))) SEAM(pb + 6);
        if (EN_CHAIN && IN_PH(pb + 7)) for (int rep = 0; rep < REPS(7); ++rep) { const int dry = rep + 1 < REPS(7);
            if (EN_CH & 1) { bf16_t* AXA = (bf16_t*)(ws + WS_AX + 4 * MiB); EpiYA ea{S1, dry, AXA}; run_gemm(lds, S0, wsm(a, L, 0), MP, 1024, 1024, ea); mini_gemm<1024>(lds, S0 + (size_t)MP * 1024, wsm(a, L, 0), ea); }
            if (EN_CH & 2) { bf16_t* AXA = (bf16_t*)(ws + WS_AX + 4 * MiB); bf16_t* AXB = (bf16_t*)(ws + WS_AX + 5 * MiB); EpiYB eb{S1, S2, dry, AXA, AXB}; run_gemm(lds, S4, wsm(a, L, 1), MP, 1024, 1024, eb); mini_gemm<1024>(lds, S4 + (size_t)MP * 1024, wsm(a, L, 1), eb); }
        }
        SEAM(pb + 7);
        if (EN_CHAIN && IN_PH(pb + 8)) {
            if (L == 0) { prep_win(a, 1, gw, ngw, scr, lane); __syncthreads(); }
            for (int rep = 0; rep < REPS(8); ++rep) {
            EpiOut eo; eo.xp = L == 0 ? kin(I_XP) : kout(); eo.xs = L == 0 ? kin(I_XS) : kout() + (size_t)MP * 1024; eo.out = kout(); eo.xb = S3; eo.sq = SQ1; eo.dry = rep + 1 < REPS(8);
            if (EN_CH & 4) { run_gemm(lds, S2, wsm(a, L, 2), MP, 1024, 1024, eo); mini_gemm<1024>(lds, (const bf16_t*)(ws + WS_AX + 5 * MiB), wsm(a, L, 2), eo); } }
        }
        SEAM(pb + 8);
        if (EN_CHAIN && IN_PH(pb + 9)) for (int rep = 0; rep < REPS(9); ++rep) { const int dry = rep + 1 < REPS(9);
            if (EN_CH & 8) { EpiP ep{(float*)S0, dry}; run_gemm(lds, (const bf16_t*)(ws + WS_PB) + (size_t)L * MT * 256, wsm(a, L, 4), MP, 1024, 256, ep); mini_gemm<256>(lds, (const bf16_t*)(ws + WS_PB) + ((size_t)L * MT + MP) * 256, wsm(a, L, 4), ep); }
            EpiGate eg; eg.sq1 = SQ1; eg.PT = (const float*)S0; eg.out = kout(); eg.xb = XB; eg.sq2 = SQ2; eg.dry = dry;
            if (EN_CH & 16) { run_gemm(lds, S3, wsm(a, L, 3), MP, 1024, 1024, eg); mini_gemm<1024>(lds, S3 + (size_t)MP * 1024, wsm(a, L, 3), eg); }
        }
        SEAM(pb + 9);
    }
}

#ifndef MK_ONE_LAUNCH
#define MK_ONE_LAUNCH 1
#endif
extern "C" void kernel_launch(void* const* d_in, const int* in_sizes, int n_in, void* d_out, int out_size, void* d_ws, size_t ws_size, hipStream_t stream) {
    static int grid = 0;
    if (grid == 0) {
        if (n_in != 21 || ws_size < WS_END) { fprintf(stderr, "kernel_launch: unexpected n_in %d or ws_size %zu (< %zu)\n", n_in, ws_size, (size_t)WS_END); grid = -1; return; }
        int dev = 0, cus = 0, per_cu = 0;
        (void)hipGetDevice(&dev); (void)hipDeviceGetAttribute(&cus, hipDeviceAttributeMultiprocessorCount, dev);
        (void)hipFuncSetAttribute((const void*)fwd_kernel, hipFuncAttributeMaxDynamicSharedMemorySize, LDS_BYTES);
        (void)hipOccupancyMaxActiveBlocksPerMultiprocessor(&per_cu, (const void*)fwd_kernel, NTHREADS, LDS_BYTES);
        (void)hipGetLastError();
        if (per_cu < 1) { fprintf(stderr, "kernel_launch: occupancy query says %d blocks/CU\n", per_cu); per_cu = 1; }
        grid = cus;
    }
    if (grid < 0) return;
    Args a{};
    for (int i = 0; i < 21; ++i) a.in[i] = (const float*)d_in[i];
    a.out = (float*)d_out; a.ws = (unsigned char*)d_ws;
#if MK_ONE_LAUNCH
    (void)hipMemsetAsync(d_ws, 0, 16384, stream);
    a.ph_lo = 0; a.ph_hi = N_PHASES;
    void* args[] = {&a};
    hipError_t e = hipLaunchCooperativeKernel((const void*)fwd_kernel, dim3(grid), dim3(NTHREADS), args, LDS_BYTES, stream);
    if (e != hipSuccess) fprintf(stderr, "cooperative launch failed: %s (grid %d)\n", hipGetErrorString(e), grid);
#else
    for (int p = 0; p < N_PHASES; ++p) { a.ph_lo = p; a.ph_hi = p + 1; hipLaunchKernelGGL(fwd_kernel, dim3(grid), dim3(NTHREADS), LDS_BYTES, stream, a); }
#endif
}
```

```cpp
#include <hip/hip_runtime.h>
#include <hip/hip_cooperative_groups.h>
#include <cstdio>
#include <cstdint>
namespace cg = cooperative_groups;
namespace pg8 {
#define PG8_LAS __attribute__((address_space(3)))
typedef unsigned short bf16_t;
typedef short bf16x8 __attribute__((ext_vector_type(8)));
typedef float f32x4 __attribute__((ext_vector_type(4)));
typedef unsigned u32x4 __attribute__((ext_vector_type(4)));
constexpr int BM = 256, BK = 64, HALF = 128, HTB = HALF * BK * 2  , STAGE_BYTES = 8 * HTB, NXCD = 8, WGM = 8;

__host__ __device__ __forceinline__ int lds_byte(int r, int c) { const int st = (r >> 4) * 2 + (c >> 5), rr = r & 15, cc = c & 31, ob = rr * 64 + cc * 2; return st * 1024 + (ob ^ (((ob >> 9) & 1) << 5)); }
__host__ __device__ __forceinline__ void stage_rc(int b, int& R, int& C) { const int st = b / 1024, sb = b % 1024, swz = sb ^ (((sb >> 9) & 1) << 5); R = (st >> 1) * 16 + swz / 64; C = (st & 1) * 32 + (swz % 64) / 2; }
__host__ __device__ __forceinline__ int perm32(int rho) { const int n = rho >> 4, i = rho & 15; return 8 * (i >> 2) + 4 * n + (i & 3); }

struct Unit { int pm, pn; };
struct Gemm { const bf16_t* A; const bf16_t* Bt; int M, N, K; };

struct StaticOrder {
    int nM, nN, nwg, G, c;
    __host__ __device__ void init(int M, int N, int G_, int c_) { nM = M / BM; nN = N / BM; nwg = nM * nN; G = G_; c = c_; }
    __host__ __device__ bool next(int i, Unit& u) const {
        const long L = (long)i * G + c; if (L >= nwg) return false;
        int wgid = (int)L; { const int q = nwg / NXCD, r = nwg % NXCD, xcd = wgid % NXCD, off = wgid / NXCD; wgid = (xcd < r ? xcd * (q + 1) : r * (q + 1) + (xcd - r) * q) + off; }
        const int nig = WGM * nN, gid = wgid / nig, fm = gid * WGM, gsz = (nM - fm) < WGM ? (nM - fm) : WGM;
        u.pm = fm + ((wgid % nig) % gsz); u.pn = (wgid % nig) / gsz; return true;
    }
    __device__ __forceinline__ void a_ready(const Unit&) const {}
    __device__ __forceinline__ void done(const Unit&) const {}
};
__device__ __forceinline__ unsigned cvt_pk_bf16(float lo, float hi) { unsigned r; asm volatile("v_cvt_pk_bf16_f32 %0, %1, %2" : "=v"(r) : "v"(lo), "v"(hi)); return r; }
template <class Epi, class Sched, bool ALIGN_EPI = false, bool SP2 = false>
__device__ __forceinline__ void gemm_phase(PG8_LAS unsigned char* lds, const Gemm g, const Sched& S, const Epi& E) {
    int tid_ = threadIdx.x; asm volatile("" : "+v"(tid_));
    const int tid = tid_, wid = __builtin_amdgcn_readfirstlane(tid >> 6), lane = tid & 63, wr = wid >> 2, wc = wid & 3, fr = lane & 15, fq = lane >> 4;
    const int K = g.K, nt = K / BK;
    unsigned voffA[2], voffB[2];
#pragma unroll
    for (int i = 0; i < 2; ++i) { int R, C; stage_rc(tid * 16 + i * 8192, R, C); const int Rb = Epi::PERM ? ((R & ~31) + perm32(R & 31)) : R;
        voffA[i] = (unsigned)(R * K + C) * 2u; voffB[i] = (unsigned)(Rb * K + C) * 2u; }
    const size_t kstep = (size_t)(BK * 2);
    const size_t hstep = (size_t)HALF * K * 2;
    const size_t tstep = 2 * hstep;
    const unsigned ldsw = (unsigned)wid * 1024u;
    const int aoff = lds_byte(wr * 64 + fr, fq * 8), boff = lds_byte(wc * 32 + fr, fq * 8);
#define PG8_SA(b, h) (((b) * 2 + (h)) * HTB)
#define PG8_SB(b, h) ((4 + (b) * 2 + (h)) * HTB)
#define PG8_STAGE(bufoff, gbase, voff) do { _Pragma("unroll") for (int _i = 0; _i < 2; ++_i) \
        __builtin_amdgcn_global_load_lds((const unsigned*)((const char*)(gbase) + (voff)[_i]), (PG8_LAS unsigned*)(lds + (bufoff) + ldsw + _i * 8192), 16, 0, 0); } while (0)
#define PG8_LDA(dst, b, h) do { _Pragma("unroll") for (int m = 0; m < 4; ++m) _Pragma("unroll") for (int k = 0; k < 2; ++k) dst[m][k] = *(const PG8_LAS bf16x8*)(lds + PG8_SA(b, h) + aoff + m * 2048 + k * 1024); } while (0)
#define PG8_LDB(dst, b, h) do { _Pragma("unroll") for (int n = 0; n < 2; ++n) _Pragma("unroll") for (int k = 0; k < 2; ++k) dst[n][k] = *(const PG8_LAS bf16x8*)(lds + PG8_SB(b, h) + boff + n * 2048 + k * 1024); } while (0)
#define PG8_MMA(ai, bj, At, Bt) do { __builtin_amdgcn_s_setprio(1); _Pragma("unroll") for (int m = 0; m < 4; ++m) _Pragma("unroll") for (int n = 0; n < 2; ++n) _Pragma("unroll") for (int k = 0; k < 2; ++k) \
        acc[ai][bj][m][n] = __builtin_amdgcn_mfma_f32_16x16x32_bf16(Bt[n][k], At[m][k], acc[ai][bj][m][n], 0, 0, 0); __builtin_amdgcn_s_setprio(0); } while (0)
#define PG8_WAIT_V(n) asm volatile("s_waitcnt vmcnt(" #n ")" ::: "memory")
#define PG8_WAIT_L(n) asm volatile("s_waitcnt lgkmcnt(" #n ")" ::: "memory")
#define PG8_BAR __builtin_amdgcn_s_barrier()
#define PG8_SCHED __builtin_amdgcn_sched_barrier(0)
    Unit cur, nxt; int ui = 0;
    if (!S.next(0, cur)) return;
    f32x4 acc[2][2][4][2];
#pragma unroll
    for (int a = 0; a < 2; ++a)
#pragma unroll
        for (int b = 0; b < 2; ++b)
#pragma unroll
            for (int m = 0; m < 4; ++m)
#pragma unroll
                for (int n = 0; n < 2; ++n) acc[a][b][m][n] = (f32x4){0.f, 0.f, 0.f, 0.f};
    bf16x8 At[4][2], B0[2][2], B1[2][2];
    const char* cA = (const char*)g.A + (size_t)cur.pm * tstep; const char* cB = (const char*)g.Bt + (size_t)cur.pn * tstep;
    S.a_ready(cur);
    if constexpr (SP2) {
        PG8_STAGE(PG8_SB(0, 0), cB, voffB); PG8_STAGE(PG8_SB(0, 1), cB + hstep, voffB); PG8_STAGE(PG8_SA(0, 0), cA, voffA); PG8_STAGE(PG8_SA(0, 1), cA + hstep, voffA);
        if (wr == 1) PG8_BAR;
        PG8_WAIT_V(2); PG8_BAR;
        PG8_STAGE(PG8_SB(1, 0), cB + kstep, voffB); PG8_STAGE(PG8_SA(1, 0), cA + kstep, voffA); PG8_STAGE(PG8_SB(1, 1), cB + hstep + kstep, voffB);
        PG8_WAIT_V(6); PG8_BAR;
    } else {
        PG8_STAGE(PG8_SB(0, 0), cB, voffB); PG8_STAGE(PG8_SA(0, 0), cA, voffA); PG8_STAGE(PG8_SB(0, 1), cB + hstep, voffB); PG8_STAGE(PG8_SA(0, 1), cA + hstep, voffA);
        if (wr == 1) PG8_BAR;
        PG8_WAIT_V(4); PG8_BAR;
        PG8_STAGE(PG8_SB(1, 0), cB + kstep, voffB); PG8_STAGE(PG8_SA(1, 0), cA + kstep, voffA); PG8_STAGE(PG8_SB(1, 1), cB + hstep + kstep, voffB);
        PG8_WAIT_V(6); PG8_BAR;
    }
    for (;;) {
        const bool has_next = S.next(ui + 1, nxt);
        const char* nA = has_next ? (const char*)g.A + (size_t)nxt.pm * tstep : cA; const char* nB = has_next ? (const char*)g.Bt + (size_t)nxt.pn * tstep : cB;
        for (int t = 0; t < nt; t += 2) {
            const bool last = (t == nt - 2);
            const char* a1 = cA + (size_t)(t + 1) * kstep;
            const char* a2 = last ? nA : cA + (size_t)(t + 2) * kstep; const char* b2 = last ? nB : cB + (size_t)(t + 2) * kstep;
            const char* a3 = a2 + kstep; const char* b3 = b2 + kstep;
            if (last && has_next) S.a_ready(nxt);
            if constexpr (SP2) {
            PG8_LDB(B0, 0, 0); PG8_LDB(B1, 0, 1); PG8_SCHED; PG8_LDA(At, 0, 0); PG8_STAGE(PG8_SA(1, 1), a1 + hstep, voffA);
            PG8_WAIT_V(8); PG8_WAIT_L(0); PG8_BAR; PG8_MMA(0, 0, At, B0); PG8_MMA(0, 1, At, B1); PG8_BAR; PG8_SCHED;
            PG8_LDA(At, 0, 1); PG8_STAGE(PG8_SB(0, 0), b2, voffB); PG8_STAGE(PG8_SB(0, 1), b2 + hstep, voffB); PG8_STAGE(PG8_SA(0, 0), a2, voffA);
            PG8_WAIT_V(8); PG8_WAIT_L(0); PG8_BAR; PG8_MMA(1, 0, At, B0); PG8_MMA(1, 1, At, B1); PG8_BAR; PG8_SCHED;
            PG8_LDB(B0, 1, 0); PG8_LDB(B1, 1, 1); PG8_SCHED; PG8_LDA(At, 1, 0); PG8_STAGE(PG8_SA(0, 1), a2 + hstep, voffA);
            PG8_WAIT_V(8); PG8_WAIT_L(0); PG8_BAR; PG8_MMA(0, 0, At, B0); PG8_MMA(0, 1, At, B1); PG8_BAR; PG8_SCHED;
            PG8_LDA(At, 1, 1); PG8_STAGE(PG8_SB(1, 0), b3, voffB); PG8_STAGE(PG8_SB(1, 1), b3 + hstep, voffB); PG8_STAGE(PG8_SA(1, 0), a3, voffA);
            PG8_WAIT_V(8); PG8_WAIT_L(0); PG8_BAR; PG8_MMA(1, 0, At, B0); PG8_MMA(1, 1, At, B1); PG8_BAR; PG8_SCHED;
            } else {
            PG8_LDB(B0, 0, 0); PG8_SCHED; PG8_LDA(At, 0, 0); PG8_STAGE(PG8_SA(1, 1), a1 + hstep, voffA);
            PG8_WAIT_L(8); PG8_BAR; PG8_WAIT_L(0); PG8_MMA(0, 0, At, B0); PG8_BAR; PG8_SCHED;
            PG8_LDB(B1, 0, 1); PG8_STAGE(PG8_SB(0, 0), b2, voffB);
            PG8_BAR; PG8_WAIT_L(0); PG8_MMA(0, 1, At, B1); PG8_BAR;
            PG8_LDA(At, 0, 1); PG8_STAGE(PG8_SA(0, 0), a2, voffA);
            PG8_BAR; PG8_WAIT_L(0); PG8_MMA(1, 0, At, B0); PG8_BAR; PG8_SCHED;
            PG8_STAGE(PG8_SB(0, 1), b2 + hstep, voffB);
            PG8_WAIT_V(6); PG8_BAR; PG8_MMA(1, 1, At, B1); PG8_BAR;
            PG8_LDB(B0, 1, 0); PG8_SCHED; PG8_LDA(At, 1, 0); PG8_STAGE(PG8_SA(0, 1), a2 + hstep, voffA);
            PG8_WAIT_L(8); PG8_BAR; PG8_WAIT_L(0); PG8_MMA(0, 0, At, B0); PG8_BAR; PG8_SCHED;
            PG8_LDB(B1, 1, 1); PG8_STAGE(PG8_SB(1, 0), b3, voffB);
            PG8_BAR; PG8_WAIT_L(0); PG8_MMA(0, 1, At, B1); PG8_BAR;
            PG8_LDA(At, 1, 1); PG8_STAGE(PG8_SA(1, 0), a3, voffA);
            PG8_BAR; PG8_WAIT_L(0); PG8_MMA(1, 0, At, B0); PG8_BAR; PG8_SCHED;
            PG8_STAGE(PG8_SB(1, 1), b3 + hstep, voffB);
            PG8_WAIT_V(6); PG8_BAR; PG8_MMA(1, 1, At, B1); PG8_BAR;
            }
        }
        if constexpr (ALIGN_EPI) { if (wr == 0) PG8_BAR; }
        if constexpr (!Epi::AFTER_DRAIN) { E(acc, cur, wr, wc, fr, fq); S.done(cur); }
        if (!has_next) break;
#pragma unroll
        for (int a = 0; a < 2; ++a)
#pragma unroll
            for (int b = 0; b < 2; ++b)
#pragma unroll
                for (int m = 0; m < 4; ++m)
#pragma unroll
                    for (int n = 0; n < 2; ++n) acc[a][b][m][n] = (f32x4){0.f, 0.f, 0.f, 0.f};
        cur = nxt; cA = nA; cB = nB; ++ui;
        if constexpr (ALIGN_EPI) { if (wr == 1) PG8_BAR; }
    }
    PG8_WAIT_V(0);
    if constexpr (!ALIGN_EPI) { if (wr == 0) PG8_BAR; }
    PG8_BAR;
    if constexpr (Epi::AFTER_DRAIN) { E.fused(acc, cur, wr, wc, fr, fq, lds, wid, lane); S.done(cur); }
#undef PG8_SA
#undef PG8_SB
#undef PG8_STAGE
#undef PG8_LDA
#undef PG8_LDB
#undef PG8_MMA
#undef PG8_WAIT_V
#undef PG8_WAIT_L
#undef PG8_BAR
#undef PG8_SCHED
}
}

#define DI __device__ __forceinline__
#define LAS __attribute__((address_space(3)))
typedef unsigned short bf16_t;
typedef short bf16x8 __attribute__((ext_vector_type(8)));
typedef short s16x4 __attribute__((ext_vector_type(4)));
typedef float f32x4 __attribute__((ext_vector_type(4)));
typedef unsigned u32x4 __attribute__((ext_vector_type(4)));
typedef unsigned u32x2 __attribute__((ext_vector_type(2)));

constexpr int DM = 1024, MP = 16384, MS = 512, MT = MP + MS;
constexpr int NPC = 256, NCH = 264;
constexpr float EPS = 1e-6f, LOG2E = 1.4426950408889634f;
constexpr int NWIN_T = 37;
constexpr int NTHREADS = 512;
constexpr int LDS_BYTES = 147456;

constexpr size_t MiB = 1u << 20;
constexpr size_t SLOT = 33 * MiB;
constexpr size_t WS_MSH = 65536;
constexpr size_t WS_SQ1 = 1 * MiB, WS_SQ2 = 5 * MiB / 2, WS_RA = 4 * MiB, WS_DC = 6 * MiB, WS_WSM = 7 * MiB, WSM_LAYER = 17 * MiB / 2;
constexpr size_t WS_WIN = 24 * MiB, WS_PB = 43 * MiB, WS_XB = 60 * MiB, WS_OV = 93 * MiB, WS_AX = WS_OV + 5 * SLOT, WS_END = WS_AX + 6 * MiB;
constexpr size_t O_Y = 0, O_SP = 17301504, O_KP = 18350080, O_VP = 22544384, O_SS = 26738688, O_KS = 28835840, O_VS = 37224448;


typedef const __attribute__((address_space(4))) unsigned char* kargp_t;
DI kargp_t kbase() { kargp_t k = (kargp_t)__builtin_amdgcn_kernarg_segment_ptr(); asm volatile("" : "+s"(k)); return k; }
DI const float* kin(int i) { return *(const float* const __attribute__((address_space(4)))*)(kbase() + 8 * i); }
DI float* kout() { return *(float* const __attribute__((address_space(4)))*)(kbase() + 168); }
DI unsigned char* kws() { return *(unsigned char* const __attribute__((address_space(4)))*)(kbase() + 176); }
DI int kph_lo() { return *(const __attribute__((address_space(4))) int*)(kbase() + 184); }
DI int kph_hi() { return *(const __attribute__((address_space(4))) int*)(kbase() + 188); }
DI int otid() { int t = threadIdx.x; asm volatile("" : "+v"(t)); return t; }
DI float bflo(unsigned w) { return __uint_as_float(w << 16); }
DI float bfhi(unsigned w) { return __uint_as_float(w & 0xffff0000u); }
DI float bf2f(bf16_t b) { return __uint_as_float(((unsigned)b) << 16); }
typedef float f32x2_t __attribute__((ext_vector_type(2))); typedef __bf16 bf16x2_t __attribute__((ext_vector_type(2)));
DI unsigned pk2(float lo, float hi) { f32x2_t v = {lo, hi}; bf16x2_t r = __builtin_convertvector(v, bf16x2_t); return __builtin_bit_cast(unsigned, r); }
DI float sigm(float x) { return __builtin_amdgcn_rcpf(1.f + __expf(-x)); }
DI float silu(float x) { return x * sigm(x); }
DI float row_rstd(const float* sq, int row) {
    const f32x4* p = (const f32x4*)(sq + (size_t)row * 16); const f32x4 a = p[0], b = p[1], c = p[2], d = p[3];
    const float s = (((a.x + a.y) + (a.z + a.w)) + ((b.x + b.y) + (b.z + b.w))) + (((c.x + c.y) + (c.z + c.w)) + ((d.x + d.y) + (d.z + d.w)));
    return rsqrtf(s * (1.f / 1024.f) + EPS);
}
DI u32x4 pack8(const float* v) { u32x4 w; w.x = pk2(v[0], v[1]); w.y = pk2(v[2], v[3]); w.z = pk2(v[4], v[5]); w.w = pk2(v[6], v[7]); return w; }
DI void unpack8(u32x4 w, float* v) { v[0] = bflo(w.x); v[1] = bfhi(w.x); v[2] = bflo(w.y); v[3] = bfhi(w.y); v[4] = bflo(w.z); v[5] = bfhi(w.z); v[6] = bflo(w.w); v[7] = bfhi(w.w); }

enum { T_QA = 0, T_KA, T_VA, T_GA, T_RA, T_QB, T_KB, T_VB, T_GB, T_MGA, T_MGB };
struct EpiIn {
    static constexpr bool PERM = false, AFTER_DRAIN = false;
    int tile0, L; unsigned char* ws; float* out; const float *qg, *kg;
    template <int TYPE> DI void run(const pg8::f32x4 (&acc)[2][2][4][2], int pm, int tcol, int wr, int wc, int fr, int fq) const {
        constexpr size_t doff = TYPE == T_QA ? WS_OV + 2 * SLOT : TYPE == T_KA ? WS_OV + 2 * SLOT + (size_t)MT * 1024 : TYPE == T_VA ? WS_OV + SLOT : TYPE == T_GA ? WS_OV : TYPE == T_QB ? WS_OV + SLOT : TYPE == T_KB ? WS_OV + 2 * SLOT
                              : TYPE == T_VB ? WS_OV + 3 * SLOT : TYPE == T_GB ? WS_OV + 4 * SLOT : TYPE == T_MGA ? WS_OV + SLOT : WS_OV + 2 * SLOT;
        constexpr bool ANX = TYPE == T_QB || TYPE == T_KB || TYPE == T_VB || TYPE == T_GB || TYPE == T_MGA || TYPE == T_MGB;
        constexpr size_t aoff = WS_AX + (TYPE == T_QB ? 0 : TYPE == T_KB ? 1 : TYPE == T_VB ? 2 : TYPE == T_GB ? 3 : TYPE == T_MGA ? 4 : 5) * MiB;
        const bool srow = ANX && pm >= MP / 256;
        bf16_t* dst = (bf16_t*)(ws + (srow ? aoff : doff)); const int rsub = srow ? MP : 0; const float* sq = (const float*)(ws + WS_SQ2); float* RA = (float*)(ws + WS_RA);
        float* okp = out + (TYPE == T_KB ? O_KP : O_VP) + (size_t)L * 4 * 512 * 1024; float* oks = out + (TYPE == T_KB ? O_KS : O_VS) + (size_t)L * 8 * 512 * 1024;
        const int ld = (TYPE == T_QA || TYPE == T_KA) ? 512 : 1024;
        float gq[2][8];
        if (TYPE == T_QB || TYPE == T_KB) {
            const float* g = TYPE == T_QB ? qg : kg;
#pragma unroll
            for (int bj = 0; bj < 2; ++bj)
#pragma unroll
                for (int k = 0; k < 8; ++k) gq[bj][k] = g[32 * bj + 8 * fq + k] * (TYPE == T_QB ? 0.125f * LOG2E : 1.f);
        }
#pragma unroll
        for (int ai = 0; ai < 2; ++ai)
#pragma unroll
            for (int m = 0; m < 4; ++m) {
                const int row = pm * 256 + ai * 128 + wr * 64 + m * 16 + fr;
                const float rs = row_rstd(sq, row);
                float v[2][8];
#pragma unroll
                for (int bj = 0; bj < 2; ++bj)
#pragma unroll
                    for (int n = 0; n < 2; ++n)
#pragma unroll
                        for (int e = 0; e < 4; ++e) v[bj][4 * n + e] = acc[ai][bj][m][n][e] * rs;
                if (TYPE == T_RA) {
                    if (wc == 0 && fq < 2) { float* p = RA + (size_t)row * 16 + 8 * fq; *(f32x4*)p = (f32x4){v[0][0], v[0][1], v[0][2], v[0][3]}; *(f32x4*)(p + 4) = (f32x4){v[0][4], v[0][5], v[0][6], v[0][7]}; }
                    continue;
                }
                if (TYPE == T_QB || TYPE == T_KB) {
                    float ss = 0.f;
#pragma unroll
                    for (int bj = 0; bj < 2; ++bj)
#pragma unroll
                        for (int k = 0; k < 8; ++k) ss += v[bj][k] * v[bj][k];
                    ss += __shfl_xor(ss, 16); ss += __shfl_xor(ss, 32);
                    const float r = rsqrtf(ss * (1.f / 64.f) + EPS);
#pragma unroll
                    for (int bj = 0; bj < 2; ++bj)
#pragma unroll
                        for (int k = 0; k < 8; ++k) v[bj][k] *= r * gq[bj][k];
                }
                float* bo = nullptr;
                if (TYPE == T_KB || TYPE == T_VB) {
                    if (row < MP) { const int t = row & 4095; if (t >= 3584) bo = okp + ((size_t)(row >> 12) * 512 + (t - 3584)) * 1024; }
                    else { const int rr = row - MP; bo = oks + ((size_t)(rr >> 6) * 512 + 448 + (rr & 63)) * 1024; }
                }
#pragma unroll
                for (int bj = 0; bj < 2; ++bj) {
                    const int col = tcol * 256 + 64 * wc + 32 * bj + 8 * fq;
                    if (TYPE == T_QA) {
#pragma unroll
                        for (int k = 0; k < 8; ++k) v[bj][k] *= 0.08838834764831845f;
                    }
                    if (TYPE == T_GA || TYPE == T_GB) {
#pragma unroll
                        for (int k = 0; k < 8; ++k) v[bj][k] = silu(v[bj][k]);
                    }
                    if (TYPE == T_MGA || TYPE == T_MGB) {
#pragma unroll
                        for (int k = 0; k < 8; ++k) v[bj][k] = sigm(v[bj][k]);
                    }
                    if ((TYPE == T_KB || TYPE == T_VB) && bo) { *(f32x4*)(bo + col) = (f32x4){v[bj][0], v[bj][1], v[bj][2], v[bj][3]}; *(f32x4*)(bo + col + 4) = (f32x4){v[bj][4], v[bj][5], v[bj][6], v[bj][7]}; }
                    if (TYPE == T_VA) {
                        bf16_t* p = dst + ((size_t)((row >> 6) * 4 + tcol) * 256 + 64 * wc + 32 * bj + 8 * fq) * 64 + (row & 63);
#pragma unroll
                        for (int k = 0; k < 8; k += 2) { const unsigned w = pk2(v[bj][k], v[bj][k + 1]); p[k * 64] = (bf16_t)w; p[(k + 1) * 64] = (bf16_t)(w >> 16); }
                    } else if (TYPE == T_VB) {
                        bf16_t* p = dst + ((size_t)(((row - rsub) >> 6) * 16 + tcol * 4 + wc) * 64 + 32 * bj + 8 * fq) * 64 + (row & 63);
#pragma unroll
                        for (int k = 0; k < 8; k += 2) { const unsigned w = pk2(v[bj][k], v[bj][k + 1]); p[k * 64] = (bf16_t)w; p[(k + 1) * 64] = (bf16_t)(w >> 16); }
                    } else
                    *(u32x4*)(dst + (size_t)(row - rsub) * ld + col) = pack8(v[bj]);
                }
                asm volatile("" ::: "memory");
            }
    }
    DI void operator()(const pg8::f32x4 (&acc)[2][2][4][2], const pg8::Unit& u, int wr, int wc, int fr, int fq) const {
        asm volatile("" : "+v"(fr), "+v"(fq));
        const int gt = tile0 + u.pn;
        if (gt < 2) run<T_QA>(acc, u.pm, gt, wr, wc, fr, fq);
        else if (gt < 4) run<T_KA>(acc, u.pm, gt - 2, wr, wc, fr, fq);
        else if (gt < 8) run<T_VA>(acc, u.pm, gt - 4, wr, wc, fr, fq);
        else if (gt < 12) run<T_GA>(acc, u.pm, gt - 8, wr, wc, fr, fq);
        else if (gt == 12) run<T_RA>(acc, u.pm, 0, wr, wc, fr, fq);
        else if (gt < 17) run<T_QB>(acc, u.pm, gt - 13, wr, wc, fr, fq);
        else if (gt < 21) run<T_KB>(acc, u.pm, gt - 17, wr, wc, fr, fq);
        else if (gt < 25) run<T_VB>(acc, u.pm, gt - 21, wr, wc, fr, fq);
        else if (gt < 29) run<T_GB>(acc, u.pm, gt - 25, wr, wc, fr, fq);
        else if (gt < 33) run<T_MGA>(acc, u.pm, gt - 29, wr, wc, fr, fq);
        else run<T_MGB>(acc, u.pm, gt - 33, wr, wc, fr, fq);
    }
};
#define EPI_ROWS_BEGIN _Pragma("unroll") for (int ai = 0; ai < 2; ++ai) _Pragma("unroll") for (int m = 0; m < 4; ++m) { asm volatile("" ::: "memory"); const int row = u.pm * 256 + ai * 128 + wr * 64 + m * 16 + fr;
#define EPI_COLS_BEGIN _Pragma("unroll") for (int bj = 0; bj < 2; ++bj) { const int col = u.pn * 256 + 64 * wc + 32 * bj + 8 * fq; float v[8]; \
    _Pragma("unroll") for (int n = 0; n < 2; ++n) _Pragma("unroll") for (int e = 0; e < 4; ++e) v[4 * n + e] = acc[ai][bj][m][n][e];
struct EpiYA {
    static constexpr bool PERM = false, AFTER_DRAIN = false; bf16_t* G; int dry; bf16_t* Gs;
    DI void operator()(const pg8::f32x4 (&acc)[2][2][4][2], const pg8::Unit& u, int wr, int wc, int fr, int fq) const {
        asm volatile("" : "+v"(fr), "+v"(fq));
        EPI_ROWS_BEGIN EPI_COLS_BEGIN
            bf16_t* p = G + (size_t)row * 1024 + col; float g[8]; unpack8(*(const u32x4*)p, g);
#pragma unroll
            for (int k = 0; k < 8; ++k) v[k] *= g[k];
            if (!dry) *(u32x4*)p = pack8(v);
        } }
    }
    DI void mini(int row, int col, f32x4 s) const {
        bf16_t* p = Gs + (size_t)(row - MP) * 1024 + col; const u32x2 g = *(const u32x2*)p;
        u32x2 w; w.x = pk2(s.x * bflo(g.x), s.y * bfhi(g.x)); w.y = pk2(s.z * bflo(g.y), s.w * bfhi(g.y)); if (!dry) *(u32x2*)p = w;
    }
};
struct EpiYB {
    static constexpr bool PERM = false, AFTER_DRAIN = false; const bf16_t* YA; bf16_t* G; int dry; const bf16_t* YAs; bf16_t* Gs;
    DI void operator()(const pg8::f32x4 (&acc)[2][2][4][2], const pg8::Unit& u, int wr, int wc, int fr, int fq) const {
        asm volatile("" : "+v"(fr), "+v"(fq));
        EPI_ROWS_BEGIN EPI_COLS_BEGIN
            bf16_t* p = G + (size_t)row * 1024 + col; float g[8], ya[8]; unpack8(*(const u32x4*)p, g); unpack8(*(const u32x4*)(YA + (size_t)row * 1024 + col), ya);
#pragma unroll
            for (int k = 0; k < 8; ++k) v[k] = ya[k] + v[k] * g[k];
            if (!dry) *(u32x4*)p = pack8(v);
        } }
    }
    DI void mini(int row, int col, f32x4 s) const {
        bf16_t* p = Gs + (size_t)(row - MP) * 1024 + col; const u32x2 g = *(const u32x2*)p, y = *(const u32x2*)(YAs + (size_t)(row - MP) * 1024 + col);
        u32x2 w; w.x = pk2(bflo(y.x) + s.x * bflo(g.x), bfhi(y.x) + s.y * bfhi(g.x)); w.y = pk2(bflo(y.y) + s.z * bflo(g.y), bfhi(y.y) + s.w * bfhi(g.y)); if (!dry) *(u32x2*)p = w;
    }
};
struct EpiOut {
    static constexpr bool PERM = false, AFTER_DRAIN = false; const float* xp; const float* xs; float* out; bf16_t* xb; float* sq; int dry;
    DI void operator()(const pg8::f32x4 (&acc)[2][2][4][2], const pg8::Unit& u, int wr, int wc, int fr, int fq) const {
        asm volatile("" : "+v"(fr), "+v"(fq));
        EPI_ROWS_BEGIN
            const float* base = row < MP ? xp + (size_t)row * 1024 : xs + (size_t)(row - MP) * 1024; float ss = 0.f;
            EPI_COLS_BEGIN
                const f32x4 b0 = *(const f32x4*)(base + col), b1 = *(const f32x4*)(base + col + 4);
                v[0] += b0.x; v[1] += b0.y; v[2] += b0.z; v[3] += b0.w; v[4] += b1.x; v[5] += b1.y; v[6] += b1.z; v[7] += b1.w;
#pragma unroll
                for (int k = 0; k < 8; ++k) ss += v[k] * v[k];
                if (!dry) { float* o = out + (size_t)row * 1024 + col; *(f32x4*)o = (f32x4){v[0], v[1], v[2], v[3]}; *(f32x4*)(o + 4) = (f32x4){v[4], v[5], v[6], v[7]};
                *(u32x4*)(xb + (size_t)row * 1024 + col) = pack8(v); }
            }
            ss += __shfl_xor(ss, 16); ss += __shfl_xor(ss, 32);
            if (fq == 0 && !dry) sq[(size_t)row * 16 + 4 * u.pn + wc] = ss;
        }
    }
    DI void mini(int row, int col, f32x4 s) const {
        const float* base = row < MP ? xp + (size_t)row * 1024 : xs + (size_t)(row - MP) * 1024; const f32x4 b0 = *(const f32x4*)(base + col);
        const f32x4 x = s + b0; float ss = (x.x * x.x + x.y * x.y) + (x.z * x.z + x.w * x.w);
        ss += __shfl_xor(ss, 1); ss += __shfl_xor(ss, 2); ss += __shfl_xor(ss, 4); ss += __shfl_xor(ss, 8);
        if (!dry) { *(f32x4*)(out + (size_t)row * 1024 + col) = x; u32x2 w; w.x = pk2(x.x, x.y); w.y = pk2(x.z, x.w); *(u32x2*)(xb + (size_t)row * 1024 + col) = w;
            if ((col & 63) == 0) sq[(size_t)row * 16 + (col >> 6)] = ss; }
    }
};
struct EpiP {
    static constexpr bool PERM = false, AFTER_DRAIN = false; float* PT; int dry;
    DI void operator()(const pg8::f32x4 (&acc)[2][2][4][2], const pg8::Unit& u, int wr, int wc, int fr, int fq) const {
        asm volatile("" : "+v"(fr), "+v"(fq));
        EPI_ROWS_BEGIN EPI_COLS_BEGIN
            if (!dry) { float* o = PT + (size_t)row * 1024 + col; *(f32x4*)o = (f32x4){v[0], v[1], v[2], v[3]}; *(f32x4*)(o + 4) = (f32x4){v[4], v[5], v[6], v[7]}; }
        } }
    }
    DI void mini(int row, int col, f32x4 s) const { if (!dry) *(f32x4*)(PT + (size_t)row * 1024 + col) = s; }
};
struct EpiGate {
    static constexpr bool PERM = false, AFTER_DRAIN = false; const float* sq1; const float* PT; float* out; bf16_t* xb; float* sq2; int dry;
    DI void operator()(const pg8::f32x4 (&acc)[2][2][4][2], const pg8::Unit& u, int wr, int wc, int fr, int fq) const {
        asm volatile("" : "+v"(fr), "+v"(fq));
        EPI_ROWS_BEGIN
            const float rs = row_rstd(sq1, row); float ss = 0.f;
            EPI_COLS_BEGIN
                float* o = out + (size_t)row * 1024 + col; const float* pt = PT + (size_t)row * 1024 + col;
                const f32x4 b0 = *(const f32x4*)o, b1 = *(const f32x4*)(o + 4), p0 = *(const f32x4*)pt, p1 = *(const f32x4*)(pt + 4);
                const float xb_[8] = {b0.x, b0.y, b0.z, b0.w, b1.x, b1.y, b1.z, b1.w}, pp[8] = {p0.x, p0.y, p0.z, p0.w, p1.x, p1.y, p1.z, p1.w};
#pragma unroll
                for (int k = 0; k < 8; ++k) { v[k] = xb_[k] + sigm(v[k] * rs) * pp[k]; ss += v[k] * v[k]; }
                if (!dry) { *(f32x4*)o = (f32x4){v[0], v[1], v[2], v[3]}; *(f32x4*)(o + 4) = (f32x4){v[4], v[5], v[6], v[7]};
                *(u32x4*)(xb + (size_t)row * 1024 + col) = pack8(v); }
            }
            ss += __shfl_xor(ss, 16); ss += __shfl_xor(ss, 32);
            if (fq == 0 && !dry) sq2[(size_t)row * 16 + 4 * u.pn + wc] = ss;
        }
    }
    DI void mini(int row, int col, f32x4 s) const {
        const float rs = row_rstd(sq1, row); float* o = out + (size_t)row * 1024 + col; const f32x4 b0 = *(const f32x4*)o, p0 = *(const f32x4*)(PT + (size_t)row * 1024 + col);
        f32x4 x; x.x = b0.x + sigm(s.x * rs) * p0.x; x.y = b0.y + sigm(s.y * rs) * p0.y; x.z = b0.z + sigm(s.z * rs) * p0.z; x.w = b0.w + sigm(s.w * rs) * p0.w;
        float ss = (x.x * x.x + x.y * x.y) + (x.z * x.z + x.w * x.w);
        ss += __shfl_xor(ss, 1); ss += __shfl_xor(ss, 2); ss += __shfl_xor(ss, 4); ss += __shfl_xor(ss, 8);
        if (!dry) { *(f32x4*)o = x; u32x2 w; w.x = pk2(x.x, x.y); w.y = pk2(x.z, x.w); *(u32x2*)(xb + (size_t)row * 1024 + col) = w;
            if ((col & 63) == 0) sq2[(size_t)row * 16 + (col >> 6)] = ss; }
    }
};

struct OrderG {
    pg8::StaticOrder S; int G, c;
    DI void init(int G_, int c_) { S.init(MP, 13 * 256, G_, c_); G = G_; c = c_; }
    DI bool next(int i, pg8::Unit& u) const { if (S.next(i, u)) return true; const long s = (long)i * G + c - 64 * 13; if (s >= 2 * NWIN_T) return false; u.pm = 64 + (int)(s / NWIN_T); u.pn = (int)(s % NWIN_T); return true; }
    DI void a_ready(const pg8::Unit&) const {}
    DI void done(const pg8::Unit&) const {}
};
struct OrderM {
    pg8::StaticOrder S;
    DI void init(int G_, int c_) { S.init(MP, 1024, G_, c_); }
    DI bool next(int i, pg8::Unit& u) const { pg8::Unit v; if (!S.next(i >> 1, v)) return false; u.pm = v.pm; u.pn = 4 * (i & 1) + v.pn; return true; }
    DI void a_ready(const pg8::Unit&) const {}
    DI void done(const pg8::Unit&) const {}
};
template <class Epi> DI void run_gemm_m(LAS unsigned char* lds, const bf16_t* A, const bf16_t* Bt, const Epi& E) {
    int K = 1024; asm volatile("" : "+s"(K));
    pg8::Gemm g{A, Bt, MP, 8 * 256, K}; OrderM S; S.init((int)gridDim.x, (int)blockIdx.x);
    pg8::gemm_phase<Epi, OrderM, true, true>(lds, g, S, E);
}
template <class Epi> DI void run_gemm_g(LAS unsigned char* lds, const bf16_t* A, const bf16_t* Bt, const Epi& E) {
    int K = 1024; asm volatile("" : "+s"(K));
    pg8::Gemm g{A, Bt, MT, NWIN_T * 256, K}; OrderG S; S.init((int)gridDim.x, (int)blockIdx.x);
    pg8::gemm_phase<Epi, OrderG, true, true>(lds, g, S, E);
}
template <class Epi> DI void run_gemm(LAS unsigned char* lds, const bf16_t* A, const bf16_t* Bt, int M, int N, int K, const Epi& E) {
    asm volatile("" : "+s"(K), "+s"(N));
    pg8::Gemm g{A, Bt, M, N, K}; pg8::StaticOrder S; S.init(M, N, (int)gridDim.x, (int)blockIdx.x);
    pg8::gemm_phase<Epi, pg8::StaticOrder, true, true>(lds, g, S, E);
}

template <int K, class Epi> DI void mini_gemm(LAS unsigned char* lds, const bf16_t* A, const bf16_t* Wt, const Epi& E) {
    const int tid = otid(), lane = tid & 63, wave = __builtin_amdgcn_readfirstlane(tid >> 6), r = lane & 15, q = lane >> 4;
    constexpr int KW = K / 8;
    for (int mt = blockIdx.x; mt < 256; mt += gridDim.x) {
        const int row0 = 32 * (mt >> 4), cb = mt & 15, tile = cb >> 2, wcp = cb & 3, k0 = wave * KW;
        f32x4 acc[4][2];
#pragma unroll
        for (int ct = 0; ct < 4; ++ct) { acc[ct][0] = (f32x4){0.f, 0.f, 0.f, 0.f}; acc[ct][1] = (f32x4){0.f, 0.f, 0.f, 0.f}; }
#pragma unroll
        for (int ks = 0; ks < KW / 32; ++ks) {
            bf16x8 af[2], wf[4];
#pragma unroll
            for (int rt = 0; rt < 2; ++rt) af[rt] = *(const bf16x8*)(A + (size_t)(row0 + 16 * rt + r) * K + k0 + 32 * ks + 8 * q);
#pragma unroll
            for (int ct = 0; ct < 4; ++ct) { const int x = 16 * ct + r, p = 128 * (x >> 5) + 32 * wcp + 16 * ((x >> 2) & 1) + 4 * ((x >> 3) & 3) + (x & 3);
                wf[ct] = *(const bf16x8*)(Wt + (size_t)(tile * 256 + p) * K + k0 + 32 * ks + 8 * q); }
#pragma unroll
            for (int ct = 0; ct < 4; ++ct)
#pragma unroll
                for (int rt = 0; rt < 2; ++rt) acc[ct][rt] = __builtin_amdgcn_mfma_f32_16x16x32_bf16(wf[ct], af[rt], acc[ct][rt], 0, 0, 0);
        }
        LAS float* part = (LAS float*)lds + wave * (32 * 68);
#pragma unroll
        for (int ct = 0; ct < 4; ++ct)
#pragma unroll
            for (int rt = 0; rt < 2; ++rt) *(LAS f32x4*)(part + (16 * rt + r) * 68 + 16 * ct + 4 * q) = acc[ct][rt];
        __syncthreads();
        { const int row = tid >> 4, c4 = (tid & 15) * 4; f32x4 s = (f32x4){0.f, 0.f, 0.f, 0.f};
#pragma unroll
          for (int w = 0; w < 8; ++w) s += *(const LAS f32x4*)((const LAS float*)lds + w * (32 * 68) + row * 68 + c4);
          E.mini(MP + row0 + row, 64 * cb + c4, s); }
        __syncthreads();
    }
}

struct Args { const float* in[21]; float* out; unsigned char* ws; int ph_lo, ph_hi; };
static_assert(sizeof(Args) == 192, "Args layout (kin/kout/kws offsets)");
enum { I_XP = 0, I_XS, I_STATE, I_CK, I_CV, I_PP, I_PS, I_NORMG, I_WIN, I_WGU, I_BG, I_GLAG, I_QG, I_KG, I_RELB, I_WA, I_WB, I_WO, I_PLEG, I_WPG, I_WPLE };

DI void transpose_item(const float* W, int ldw, int srccol0, int nvalid, const float* gain, bf16_t* WT, int K, int rowbase, int k0, LAS float* scr, int lane) {
#pragma unroll 16
    for (int i = 0; i < 32; ++i) { const int kk = 2 * i + (lane >> 5), c = lane & 31;
        float w = 0.f; if (c < nvalid) w = __builtin_nontemporal_load(&W[(size_t)(k0 + kk) * ldw + srccol0 + c]); if (gain) w *= gain[k0 + kk];
        scr[kk * 33 + c] = w; }
    asm volatile("s_waitcnt lgkmcnt(0)" ::: "memory");
    const int c8 = lane & 7;
#pragma unroll
    for (int j = 0; j < 4; ++j) { const int n = (lane >> 3) + 8 * j; const LAS float* s = scr + (8 * c8) * 33 + n;
        u32x4 o; o.x = pk2(s[0 * 33], s[1 * 33]); o.y = pk2(s[2 * 33], s[3 * 33]); o.z = pk2(s[4 * 33], s[5 * 33]); o.w = pk2(s[6 * 33], s[7 * 33]);
        const int prow = 16 * ((n >> 2) & 1) + 4 * (n >> 3) + (n & 3);
        *(u32x4*)(WT + (size_t)(rowbase + prow) * K + k0 + 8 * c8) = o; }
    asm volatile("s_waitcnt lgkmcnt(0)" ::: "memory");
}
DI int win_src(int t, int& nvalid) {
    nvalid = 256;
    if (t < 2) return t * 256; if (t < 4) return 512 + (t - 2) * 256; if (t < 8) return 1024 + (t - 4) * 256; if (t < 12) return 2064 + (t - 8) * 256;
    if (t == 12) { nvalid = 16; return 2048; }
    if (t < 17) return 3088 + (t - 13) * 256; if (t < 21) return 4112 + (t - 17) * 256; if (t < 25) return 5136 + (t - 21) * 256; if (t < 29) return 6160 + (t - 25) * 256;
    if (t < 33) return 7184 + (t - 29) * 256; return 8208 + (t - 33) * 256;
}
DI void transpose_generic(const float* W, int ldw, int K, int ntile, bool is_win, const float* gain, bf16_t* WT, int item, LAS float* scr, int lane) {
    const int nkb = K / 64; const int kb = item % nkb, nb = (item / nkb) & 7, t = item / (nkb * 8);
    int nvalid = 256, src = t * 256; if (is_win) src = win_src(t, nvalid);
    int nv = nvalid - 32 * nb; nv = nv < 0 ? 0 : (nv > 32 ? 32 : nv);
    transpose_item(W, ldw, src + 32 * nb, nv, gain, WT, K, t * 256 + 128 * (nb & 1) + 32 * (nb >> 1), kb * 64, scr, lane);
}
constexpr int WIN_ITEMS = NWIN_T * 8 * 16, SQ_ITEMS = 4 * 8 * 16, PLE_ITEMS = 4 * 8 * 4;
constexpr int N_IN = 9232;
DI void prep_win(const Args& a, int L, int gw, int ngw, LAS float* scr, int lane) {
    bf16_t* WT = (bf16_t*)(kws() + WS_WIN);
    for (int it = gw; it < WIN_ITEMS; it += ngw) transpose_generic(kin(I_WIN) + (size_t)L * 1024 * N_IN, N_IN, 1024, NWIN_T, true, kin(I_NORMG) + L * 1024, WT, it, scr, lane);
}
DI bf16_t* wsm(const Args& a, int L, int which) { return (bf16_t*)(kws() + WS_WSM + (size_t)L * WSM_LAYER + (size_t)which * 2 * MiB); }
DI void prep_small(const Args& a, int gw, int ngw, LAS float* scr, int lane) {
    constexpr int PER_L = 4 * SQ_ITEMS + PLE_ITEMS;
    for (int it = gw; it < 2 * PER_L; it += ngw) {
        const int L = it / PER_L; int r = it % PER_L;
        if (r < SQ_ITEMS) { transpose_generic(kin(I_WA) + (size_t)L * 1048576, 1024, 1024, 4, false, nullptr, wsm(a, L, 0), r, scr, lane); continue; } r -= SQ_ITEMS;
        if (r < SQ_ITEMS) { transpose_generic(kin(I_WB) + (size_t)L * 1048576, 1024, 1024, 4, false, nullptr, wsm(a, L, 1), r, scr, lane); continue; } r -= SQ_ITEMS;
        if (r < SQ_ITEMS) { transpose_generic(kin(I_WO) + (size_t)L * 1048576, 1024, 1024, 4, false, nullptr, wsm(a, L, 2), r, scr, lane); continue; } r -= SQ_ITEMS;
        if (r < SQ_ITEMS) { transpose_generic(kin(I_WPG) + (size_t)L * 1048576, 1024, 1024, 4, false, kin(I_PLEG) + L * 1024, wsm(a, L, 3), r, scr, lane); continue; } r -= SQ_ITEMS;
        transpose_generic(kin(I_WPLE) + (size_t)L * 262144, 1024, 256, 4, false, nullptr, wsm(a, L, 4), r, scr, lane);
    }
}
DI float wave_sum(float v) {
#pragma unroll
    for (int o = 1; o < 64; o <<= 1) v += __shfl_xor(v, o);
    return v;
}
DI void prep_shift(int gw, int lane) {
    if (gw < 32) { const int L = gw >> 4, h = gw & 15;
        float mq = fabsf(kin(I_QG)[L * 64 + lane]), mk = fabsf(kin(I_KG)[L * 64 + lane]), mb = 0.f;
        for (int i = lane; i < 257; i += 64) mb = fmaxf(mb, fabsf(kin(I_RELB)[((size_t)L * 16 + h) * 257 + i]));
#pragma unroll
        for (int o = 1; o < 64; o <<= 1) { mq = fmaxf(mq, __shfl_xor(mq, o)); mk = fmaxf(mk, __shfl_xor(mk, o)); mb = fmaxf(mb, __shfl_xor(mb, o)); }
        if (lane == 0) ((float*)(kws() + WS_MSH))[gw] = (8.f * mq * mk + mb) * LOG2E; }
}
DI void prep_rows(const Args& a, int gw, int ngw, int lane) {
    bf16_t* XB = (bf16_t*)(kws() + WS_XB); float* SQ2 = (float*)(kws() + WS_SQ2);
    const float* xp = kin(I_XP); const float* xs = kin(I_XS);
    for (int row0 = gw; row0 < MT; row0 += 4 * ngw) {
        f32x4 v[4][4];
#pragma unroll
        for (int u = 0; u < 4; ++u) { const int row = row0 + u * ngw; if (row < MT) { const float* x = row < MP ? xp + (size_t)row * 1024 : xs + (size_t)(row - MP) * 1024;
#pragma unroll
            for (int j = 0; j < 4; ++j) v[u][j] = __builtin_nontemporal_load((const f32x4*)x + lane + 64 * j); } }
#pragma unroll
        for (int u = 0; u < 4; ++u) { const int row = row0 + u * ngw; if (row < MT) { float s = 0.f;
#pragma unroll
            for (int j = 0; j < 4; ++j) s += (v[u][j].x * v[u][j].x + v[u][j].y * v[u][j].y) + (v[u][j].z * v[u][j].z + v[u][j].w * v[u][j].w);
            s = wave_sum(s);
            if (lane < 16) SQ2[(size_t)row * 16 + lane] = lane == 0 ? s : 0.f;
#pragma unroll
            for (int j = 0; j < 4; ++j) { u32x2 w; w.x = pk2(v[u][j].x, v[u][j].y); w.y = pk2(v[u][j].z, v[u][j].w); ((u32x2*)(XB + (size_t)row * 1024))[lane + 64 * j] = w; } } }
    }
}
DI void prep_misc(const Args& a, int gtid, int ngt) {
    bf16_t* PB = (bf16_t*)(kws() + WS_PB);
    const float* pp = kin(I_PP); const float* ps = kin(I_PS);
    for (int i0 = gtid; i0 < 2 * MT * 32; i0 += 4 * ngt) {
        f32x4 p0[4], p1[4];
#pragma unroll
        for (int k = 0; k < 4; ++k) { const int i = i0 + k * ngt; if (i < 2 * MT * 32) { const int c8 = i & 31, row = (i >> 5) % MT, L = (i >> 5) / MT;
            const float* src = row < MP ? pp + ((size_t)L * MP + row) * 256 + c8 * 8 : ps + ((size_t)L * MS + (row - MP)) * 256 + c8 * 8; p0[k] = __builtin_nontemporal_load((const f32x4*)src); p1[k] = __builtin_nontemporal_load((const f32x4*)(src + 4)); } }
#pragma unroll
        for (int k = 0; k < 4; ++k) { const int i = i0 + k * ngt; if (i < 2 * MT * 32) { const int c8 = i & 31, row = (i >> 5) % MT, L = (i >> 5) / MT;
            u32x4 w; w.x = pk2(p0[k].x, p0[k].y); w.y = pk2(p0[k].z, p0[k].w); w.z = pk2(p1[k].x, p1[k].y); w.w = pk2(p1[k].z, p1[k].w);
            *(u32x4*)(PB + ((size_t)L * MT + row) * 256 + c8 * 8) = w; } }
    }
    constexpr int PER = 448 * 1024 / 4;
    const float* ck = kin(I_CK); const float* cv = kin(I_CV); float* out = kout();
    for (int i0 = gtid; i0 < 32 * PER; i0 += 8 * ngt) {
        f32x4 v[8];
#pragma unroll
        for (int k = 0; k < 8; ++k) { const int i = i0 + k * ngt; if (i < 32 * PER) { const int lb = i / PER, r = i % PER, kv = lb >> 4, l_b = lb & 15;
            v[k] = __builtin_nontemporal_load((const f32x4*)((kv ? cv : ck) + (size_t)l_b * 512 * 1024 + 64 * 1024) + r); } }
#pragma unroll
        for (int k = 0; k < 8; ++k) { const int i = i0 + k * ngt; if (i < 32 * PER) { const int lb = i / PER, r = i % PER, kv = lb >> 4, l_b = lb & 15;
            __builtin_nontemporal_store(v[k], (f32x4*)(out + (kv ? O_VS : O_KS) + (size_t)l_b * 512 * 1024) + r); } }
    }
}

DI void gla_prep(const Args& a, int L, int c, int h, LAS float* totp, LAS float* ra_s, float (&b)[16], float& blast) {
    const int tid = otid(), d = tid & 127, jq = __builtin_amdgcn_readfirstlane(tid >> 7);
    if (tid < 256) *(LAS f32x4*)(ra_s + tid * 4) = *(const f32x4*)((const float*)(kws() + WS_RA) + (size_t)c * 64 * 16 + tid * 4);
    const float* wg = kin(I_WGU) + (size_t)L * 16 * 512 + h * 128 + d; float w[16];
#pragma unroll
    for (int r = 0; r < 16; ++r) w[r] = wg[r * 512];
    const float bg = kin(I_BG)[L * 512 + h * 128 + d];
    __syncthreads();
    float run = 0.f;
#pragma unroll
    for (int jj = 0; jj < 16; ++jj) {
        const LAS f32x4* rp = (const LAS f32x4*)(ra_s + (16 * jq + jj) * 16); const f32x4 r0 = rp[0], r1 = rp[1], r2 = rp[2], r3 = rp[3];
        float r = bg;
        r += r0.x * w[0]; r += r0.y * w[1]; r += r0.z * w[2]; r += r0.w * w[3]; r += r1.x * w[4]; r += r1.y * w[5]; r += r1.z * w[6]; r += r1.w * w[7];
        r += r2.x * w[8]; r += r2.y * w[9]; r += r2.z * w[10]; r += r2.w * w[11]; r += r3.x * w[12]; r += r3.y * w[13]; r += r3.z * w[14]; r += r3.w * w[15];
        const float lg = (fminf(r, 0.f) - __logf(1.f + __expf(-fabsf(r)))) * (1.f / 16.f);
        run += lg; b[jj] = run;
    }
    totp[jq * 128 + d] = run;
    __syncthreads();
    const float t0 = totp[d], t1 = totp[128 + d], t2 = totp[256 + d], t3 = totp[384 + d];
    const float off = jq == 0 ? 0.f : jq == 1 ? t0 : jq == 2 ? t0 + t1 : t0 + t1 + t2;
    blast = (t0 + t1) + (t2 + t3);
#pragma unroll
    for (int jj = 0; jj < 16; ++jj) b[jj] += off;
    if (jq == 0) totp[512 + d] = blast;
}
DI bf16x8 lds16(const LAS unsigned char* p) { return *(const LAS bf16x8*)p; }
DI s16x4 lds8(const LAS unsigned char* p) { return *(const LAS s16x4*)p; }
DI void vt_load(const bf16_t* VT, u32x4 (&vr)[4]) {
    const int tid = otid();
#pragma unroll
    for (int k = 0; k < 4; ++k) vr[k] = *(const u32x4*)(VT + (size_t)(tid + 512 * k) * 8);
}
DI void vt_store(const u32x4 (&vr)[4], LAS unsigned char* vt) {
    const int tid = otid();
#pragma unroll
    for (int k = 0; k < 4; ++k) { const int i = tid + 512 * k; *(LAS u32x4*)(vt + ((i >> 3) * 72 + (i & 7) * 8) * 2) = vr[k]; }
}
constexpr int GA_KT = 0, GA_VT = 18432, GA_TOT = 55296;
DI void gla_a_phase(const Args& a, int L, LAS unsigned char* lds, int item_lo, int item_hi, int first_wg) {
    const int tid = otid(), lane = tid & 63, wave = __builtin_amdgcn_readfirstlane(tid >> 6), r = lane & 15, q = lane >> 4;
    const bf16_t* KA = (const bf16_t*)(kws() + WS_OV + 2 * SLOT) + (size_t)MT * 512; const bf16_t* VA = (const bf16_t*)(kws() + WS_OV + 1 * SLOT);
    bf16_t* ST = (bf16_t*)(kws() + WS_OV + 3 * SLOT); float* DC = (float*)(kws() + WS_DC);
    LAS float* totp = (LAS float*)(lds + GA_TOT);
    int wg0_ = (int)blockIdx.x - first_wg; if (wg0_ < 0) wg0_ += (int)gridDim.x;
    for (int item = item_lo + wg0_; item < item_hi; item += gridDim.x) {
        const int c = item >> 2, h = item & 3;
        const int d = tid & 127, jq = tid >> 7;
        bf16_t kraw[16]; u32x4 vr[4];
#pragma unroll
        for (int jj = 0; jj < 16; ++jj) kraw[jj] = KA[((size_t)c * 64 + 16 * jq + jj) * 512 + h * 128 + d];
        vt_load(VA + (size_t)(c * 4 + h) * 16384, vr);
        float b[16], blast; gla_prep(a, L, c, h, totp, (LAS float*)(lds + GA_VT), b, blast);
        { float kd[16];
#pragma unroll
          for (int jj = 0; jj < 16; ++jj) kd[jj] = bf2f(kraw[jj]) * __expf(blast - b[jj]);
          LAS u32x4* o = (LAS u32x4*)(lds + GA_KT + (d * 72 + 16 * jq) * 2); o[0] = pack8(kd); o[1] = pack8(kd + 8); }
        if (jq == 0) DC[(size_t)item * 128 + d] = __expf(blast);
        vt_store(vr, lds + GA_VT);
        __syncthreads();
        f32x4 acc[8][2];
#pragma unroll
        for (int dt = 0; dt < 8; ++dt) { acc[dt][0] = (f32x4){0.f, 0.f, 0.f, 0.f}; acc[dt][1] = (f32x4){0.f, 0.f, 0.f, 0.f}; }
#pragma unroll
        for (int s = 0; s < 2; ++s) {
            bf16x8 bv[2];
#pragma unroll
            for (int vt = 0; vt < 2; ++vt) bv[vt] = lds16(lds + GA_VT + ((32 * wave + 16 * vt + r) * 72 + 32 * s + 8 * q) * 2);
#pragma unroll
            for (int dt = 0; dt < 8; ++dt) { const bf16x8 ak = lds16(lds + GA_KT + ((16 * dt + r) * 72 + 32 * s + 8 * q) * 2);
#pragma unroll
                for (int vt = 0; vt < 2; ++vt) acc[dt][vt] = __builtin_amdgcn_mfma_f32_16x16x32_bf16(ak, bv[vt], acc[dt][vt], 0, 0, 0); }
        }
        if (c < NPC) {
#pragma unroll
            for (int vt = 0; vt < 2; ++vt)
#pragma unroll
                for (int dt = 0; dt < 8; ++dt) { u32x2 w; w.x = pk2(acc[dt][vt][0], acc[dt][vt][1]); w.y = pk2(acc[dt][vt][2], acc[dt][vt][3]);
                    *(u32x2*)(ST + (size_t)item * 32768 + (32 * wave + 16 * vt + r) * 128 + 16 * dt + 4 * q) = w; }
        } else {
            const int bb = c - NPC; const size_t so = (((size_t)L * 8 + bb) * 4 + h) * 32768;
            const float* s0 = kin(I_STATE) + so; float* s1 = kout() + O_SS + so;
#pragma unroll
            for (int dt = 0; dt < 8; ++dt)
#pragma unroll
                for (int e = 0; e < 4; ++e) { const int dd = 16 * dt + 4 * q + e; const float dc = __expf(totp[512 + dd]);
#pragma unroll
                    for (int vt = 0; vt < 2; ++vt) { const int v = 32 * wave + 16 * vt + r; s1[dd * 256 + v] = dc * s0[dd * 256 + v] + acc[dt][vt][e]; } }
        }
        __syncthreads();
    }
}
template <int NG> DI void gla_scan_gts(int L, int dry, const int (&gts)[NG], bf16_t* ST, const float* DC) {
    int e4[NG], bb[NG], h[NG], d[NG]; float run[NG][4];
#pragma unroll
    for (int g = 0; g < NG; ++g) { const int bh = gts[g] >> 13; e4[g] = gts[g] & 8191; bb[g] = bh >> 2; h[g] = bh & 3; d[g] = (4 * e4[g]) & 127; run[g][0] = run[g][1] = run[g][2] = run[g][3] = 0.f; }
    for (int n0 = 0; n0 < 64; n0 += 8) {
        u32x2 cur[NG][8]; f32x4 dc[NG][8];
#pragma unroll
        for (int g = 0; g < NG; ++g)
#pragma unroll
            for (int k = 0; k < 8; ++k) { const size_t it = (size_t)(bb[g] * 64 + n0 + k) * 4 + h[g]; cur[g][k] = *(const u32x2*)(ST + it * 32768 + 4 * e4[g]); dc[g][k] = *(const f32x4*)(DC + it * 128 + d[g]); }
#pragma unroll
        for (int g = 0; g < NG; ++g)
#pragma unroll
            for (int k = 0; k < 8; ++k) { const size_t it = (size_t)(bb[g] * 64 + n0 + k) * 4 + h[g];
                u32x2 w; w.x = pk2(run[g][0], run[g][1]); w.y = pk2(run[g][2], run[g][3]); if (!dry || run[g][0] == 1.2345e30f) *(u32x2*)(ST + it * 32768 + 4 * e4[g]) = w;
                run[g][0] = dc[g][k].x * run[g][0] + bflo(cur[g][k].x); run[g][1] = dc[g][k].y * run[g][1] + bfhi(cur[g][k].x); run[g][2] = dc[g][k].z * run[g][2] + bflo(cur[g][k].y); run[g][3] = dc[g][k].w * run[g][3] + bfhi(cur[g][k].y); }
    }
#pragma unroll
    for (int g = 0; g < NG; ++g) { float* o = kout() + O_SP + (((size_t)L * 4 + bb[g]) * 4 + h[g]) * 32768; const int v = (4 * e4[g]) >> 7;
#pragma unroll
        for (int e = 0; e < 4; ++e) if (!dry || run[g][e] == 1.2345e30f) o[(d[g] + e) * 256 + v] = run[g][e]; }
}
DI void gla_scan_phase(const Args& a, int L, int dry) {
    bf16_t* ST = (bf16_t*)(kws() + WS_OV + 3 * SLOT); const float* DC = (const float*)(kws() + WS_DC);
    const int w = (int)blockIdx.x, G = (int)gridDim.x, tid = otid();
    if (G == 256) {
        if (w >= 128) { const int gts[2] = {(w - 128) * NTHREADS + tid, 65536 + (w - 128) * NTHREADS + tid}; gla_scan_gts<2>(L, dry, gts, ST, DC); }
    } else {
        for (int gt = w * NTHREADS + tid; gt < 16 * 8192; gt += G * NTHREADS) { const int gts[1] = {gt}; gla_scan_gts<1>(L, dry, gts, ST, DC); }
    }
}
constexpr int GC_QS = 0, GC_KS = 17408, GC_VT = 34816, GC_SS = 71680, GC_TOT = 141312, GC_RED = 143872;
DI void gla_c_phase(const Args& a, int L, LAS unsigned char* lds, int dry, int item_lo, int item_hi, int first_wg) {
    const int tid = otid(), lane = tid & 63, wave = __builtin_amdgcn_readfirstlane(tid >> 6), r = lane & 15, q = lane >> 4, it = wave & 3, vh = wave >> 2;
    const bf16_t* QA = (const bf16_t*)(kws() + WS_OV + 2 * SLOT); const bf16_t* KA = QA + (size_t)MT * 512; const bf16_t* VA = (const bf16_t*)(kws() + WS_OV + 1 * SLOT);
    bf16_t* SGA = (bf16_t*)(kws() + WS_OV); const bf16_t* ST = (const bf16_t*)(kws() + WS_OV + 3 * SLOT);
    LAS float* totp = (LAS float*)(lds + GC_TOT); LAS float* red = (LAS float*)(lds + GC_RED);
    const float* gg = kin(I_GLAG) + L * 256;
    int wg0_ = (int)blockIdx.x - first_wg; if (wg0_ < 0) wg0_ += (int)gridDim.x;
    for (int item = item_lo + wg0_; item < item_hi; item += gridDim.x) {
        const int c = item >> 2, h = item & 3;
        const int d = tid & 127, jq = tid >> 7;
        bf16_t qraw[16], kraw[16]; u32x4 vr[4], sr[8];
#pragma unroll
        for (int jj = 0; jj < 16; ++jj) { const size_t g = ((size_t)c * 64 + 16 * jq + jj) * 512 + h * 128 + d; qraw[jj] = QA[g]; kraw[jj] = KA[g]; }
        vt_load(VA + (size_t)(c * 4 + h) * 16384, vr);
        if (c < NPC) { const bf16_t* s = ST + (size_t)item * 32768;
#pragma unroll
            for (int k = 0; k < 8; ++k) sr[k] = *(const u32x4*)(s + (size_t)(tid + 512 * k) * 8); }
        float b[16], blast; gla_prep(a, L, c, h, totp, (LAS float*)(lds + GC_SS), b, blast);
#pragma unroll
        for (int jj = 0; jj < 16; ++jj) { const int j = 16 * jq + jj; const float eb = __expf(b[jj]);
            ((LAS bf16_t*)(lds + GC_QS))[j * 136 + d] = (bf16_t)pk2(bf2f(qraw[jj]) * eb, 0.f);
            ((LAS bf16_t*)(lds + GC_KS))[j * 136 + d] = (bf16_t)pk2(bf2f(kraw[jj]) * __builtin_amdgcn_rcpf(eb), 0.f); }
        vt_store(vr, lds + GC_VT);
        if (c < NPC) {
#pragma unroll
            for (int k = 0; k < 8; ++k) { const int i = tid + 512 * k, v = i >> 4, c8 = i & 15; *(LAS u32x4*)(lds + GC_SS + (v * 136 + c8 * 8) * 2) = sr[k]; }
        } else {
            const float* s0 = kin(I_STATE) + ((((size_t)L * 8 + (c - NPC)) * 4 + h) * 32768);
            for (int i = tid; i < 8192; i += NTHREADS) { const int dd = i & 127, v4 = i >> 7; const f32x4 s = *(const f32x4*)(s0 + dd * 256 + v4 * 4); LAS bf16_t* o = (LAS bf16_t*)(lds + GC_SS) + (v4 * 4) * 136 + dd;
                o[0] = (bf16_t)pk2(s.x, 0.f); o[136] = (bf16_t)pk2(s.y, 0.f); o[272] = (bf16_t)pk2(s.z, 0.f); o[408] = (bf16_t)pk2(s.w, 0.f); }
        }
        __syncthreads();
        bf16_t* orow = SGA + ((size_t)c * 64 + 16 * it + r) * 1024 + h * 256;
        u32x2 gate[8];
#pragma unroll
        for (int vt = 0; vt < 8; ++vt) gate[vt] = *(const u32x2*)(orow + 128 * vh + 16 * vt + 4 * q);
        bf16x8 bq[4];
#pragma unroll
        for (int ks = 0; ks < 4; ++ks) bq[ks] = lds16(lds + GC_QS + ((16 * it + r) * 136 + 32 * ks + 8 * q) * 2);
        f32x4 at[4];
#pragma unroll
        for (int jt = 0; jt < 4; ++jt) { at[jt] = (f32x4){0.f, 0.f, 0.f, 0.f};
            if (jt <= it) {
#pragma unroll
                for (int ks = 0; ks < 4; ++ks) at[jt] = __builtin_amdgcn_mfma_f32_16x16x32_bf16(lds16(lds + GC_KS + ((16 * jt + r) * 136 + 32 * ks + 8 * q) * 2), bq[ks], at[jt], 0, 0, 0);
                if (jt == it) {
#pragma unroll
                    for (int e = 0; e < 4; ++e) if (4 * q + e > r) at[jt][e] = 0.f;
                } } }
        bf16x8 bp[2];
#pragma unroll
        for (int s = 0; s < 2; ++s) { u32x4 w; w.x = pk2(at[2 * s][0], at[2 * s][1]); w.y = pk2(at[2 * s][2], at[2 * s][3]); w.z = pk2(at[2 * s + 1][0], at[2 * s + 1][1]); w.w = pk2(at[2 * s + 1][2], at[2 * s + 1][3]); bp[s] = __builtin_bit_cast(bf16x8, w); }
        f32x4 o[8];
#pragma unroll
        for (int vt = 0; vt < 8; ++vt) { o[vt] = (f32x4){0.f, 0.f, 0.f, 0.f}; const int v = 128 * vh + 16 * vt + r;
#pragma unroll
            for (int s = 0; s < 2; ++s) if (2 * s <= it) { const s16x4 lo = lds8(lds + GC_VT + (v * 72 + 32 * s + 4 * q) * 2), hi = lds8(lds + GC_VT + (v * 72 + 32 * s + 16 + 4 * q) * 2);
                const bf16x8 av = __builtin_shufflevector(lo, hi, 0, 1, 2, 3, 4, 5, 6, 7); o[vt] = __builtin_amdgcn_mfma_f32_16x16x32_bf16(av, bp[s], o[vt], 0, 0, 0); }
#pragma unroll
            for (int ks = 0; ks < 4; ++ks) o[vt] = __builtin_amdgcn_mfma_f32_16x16x32_bf16(lds16(lds + GC_SS + (v * 136 + 32 * ks + 8 * q) * 2), bq[ks], o[vt], 0, 0, 0); }
        float ss = 0.f;
#pragma unroll
        for (int vt = 0; vt < 8; ++vt) ss += (o[vt][0] * o[vt][0] + o[vt][1] * o[vt][1]) + (o[vt][2] * o[vt][2] + o[vt][3] * o[vt][3]);
        ss += __shfl_xor(ss, 16); ss += __shfl_xor(ss, 32);
        if (q == 0) red[vh * 64 + 16 * it + r] = ss;
        __syncthreads();
        const float rstd = rsqrtf((red[16 * it + r] + red[64 + 16 * it + r]) * (1.f / 256.f) + EPS);
#pragma unroll
        for (int vt = 0; vt < 8; ++vt) { const int v = 128 * vh + 16 * vt + 4 * q; const u32x2 g = gate[vt]; const f32x4 gn = *(const f32x4*)(gg + v);
            u32x2 w; w.x = pk2(o[vt][0] * rstd * gn.x * bflo(g.x), o[vt][1] * rstd * gn.y * bfhi(g.x)); w.y = pk2(o[vt][2] * rstd * gn.z * bflo(g.y), o[vt][3] * rstd * gn.w * bfhi(g.y));
            if (!dry || rstd == 1.2345e30f) *(u32x2*)(orow + v) = w; }
        __syncthreads();
    }
}

constexpr int AT_KS = 0, AT_VT = 36864, AT_BIAS = 73728, AT_BUF = 18432;
template <bool SAMPLE> DI void attn_load_k(int L, const bf16_t* KB, const float* ck, int bb, int n, int t, int hh, int sj, int sdq, u32x4& w0, u32x4& w1) {
    if (SAMPLE && t < 8) { const float* s = ck + (((size_t)L * 8 + bb) * 512 + t * 64 + sj) * 1024 + hh * 64 + 16 * sdq;
        const f32x4 f0 = *(const f32x4*)s, f1 = *(const f32x4*)(s + 4), f2 = *(const f32x4*)(s + 8), f3 = *(const f32x4*)(s + 12);
        w0.x = pk2(f0.x, f0.y); w0.y = pk2(f0.z, f0.w); w0.z = pk2(f1.x, f1.y); w0.w = pk2(f1.z, f1.w); w1.x = pk2(f2.x, f2.y); w1.y = pk2(f2.z, f2.w); w1.z = pk2(f3.x, f3.y); w1.w = pk2(f3.z, f3.w);
    } else { const size_t krow = SAMPLE ? (size_t)bb * 64 + sj : (size_t)bb * 4096 + (n - 8 + t) * 64 + sj; const bf16_t* s = KB + krow * 1024 + hh * 64 + 16 * sdq; w0 = *(const u32x4*)s; w1 = *(const u32x4*)(s + 8); }
}
template <bool SAMPLE> DI void attn_load_v(int L, const bf16_t* VBT, const float* cv, int bb, int n, int t, int hh, int tid, u32x4& w0, u32x4& w1) {
    if (SAMPLE && t < 8) { const int sj2 = tid & 63, dq2 = (tid >> 6) & 3; const float* s = cv + (((size_t)L * 8 + bb) * 512 + t * 64 + sj2) * 1024 + hh * 64 + 16 * dq2;
        const f32x4 f0 = *(const f32x4*)s, f1 = *(const f32x4*)(s + 4), f2 = *(const f32x4*)(s + 8), f3 = *(const f32x4*)(s + 12);
        w0.x = pk2(f0.x, f0.y); w0.y = pk2(f0.z, f0.w); w0.z = pk2(f1.x, f1.y); w0.w = pk2(f1.z, f1.w); w1.x = pk2(f2.x, f2.y); w1.y = pk2(f2.z, f2.w); w1.z = pk2(f3.x, f3.y); w1.w = pk2(f3.z, f3.w);
    } else { const int cc = SAMPLE ? bb : bb * 64 + (n - 8 + t); const bf16_t* s = VBT + ((size_t)cc * 16 + hh) * 4096 + (size_t)(tid & 255) * 8; w0 = *(const u32x4*)s; w1 = *(const u32x4*)(s + 2048); }
}
template <bool SAMPLE> DI void attn_item(const Args& a, int L, LAS unsigned char* lds, int dry, int item, bool stage_bias) {
    const int tid = otid(), lane = tid & 63, wave = __builtin_amdgcn_readfirstlane(tid >> 6), r = lane & 15, q = lane >> 4, g = wave >> 2, it = wave & 3;
    const bf16_t* QB = (const bf16_t*)(kws() + (SAMPLE ? WS_AX : WS_OV + 1 * SLOT)); const bf16_t* KB = (const bf16_t*)(kws() + (SAMPLE ? WS_AX + 1 * MiB : WS_OV + 2 * SLOT));
    const bf16_t* VB = (const bf16_t*)(kws() + (SAMPLE ? WS_AX + 2 * MiB : WS_OV + 3 * SLOT)); const bf16_t* GBs = (const bf16_t*)(kws() + (SAMPLE ? WS_AX + 3 * MiB : WS_OV + 4 * SLOT));
    bf16_t* SGB = (bf16_t*)(kws() + WS_OV + 4 * SLOT);
    const float* ck = kin(I_CK); const float* cv = kin(I_CV);
    LAS float* bias_s = (LAS float*)(lds + AT_BIAS);
    const int sg = tid >> 8, sj = (tid >> 2) & 63, sdq = tid & 3;
    const int c = item >> 3, hp = item & 7, h = 2 * hp + g;
    const int bb = SAMPLE ? c - NPC : c >> 6, n = SAMPLE ? 8 : c & 63, t0 = n >= 8 ? 0 : 8 - n;
    if (stage_bias) { const float* msh = (const float*)(kws() + WS_MSH) + L * 16 + 2 * hp;
    for (int i = tid; i < 2 * 257; i += NTHREADS) { const int g2 = i / 257, idx = i % 257; bias_s[g2 * 260 + idx] = kin(I_RELB)[((size_t)L * 16 + 2 * hp + g2) * 257 + idx] * LOG2E - msh[g2]; } }
    const size_t qrow = (size_t)c * 64 + 16 * it + r, qrl = SAMPLE ? qrow - MP : qrow;
    bf16x8 qf[2];
#pragma unroll
    for (int ks = 0; ks < 2; ++ks) qf[ks] = *(const bf16x8*)(QB + qrl * 1024 + h * 64 + 32 * ks + 8 * q);
    const int qi = 16 * it + r;
    bf16_t* orow = SGB + qrow * 1024 + h * 64;
    float l_run = 0.f;
    f32x4 o[4];
#pragma unroll
    for (int dt = 0; dt < 4; ++dt) o[dt] = (f32x4){0.f, 0.f, 0.f, 0.f};
    u32x4 k0, k1, v0, v1;
#define ATT_LOADT(T_) do { attn_load_k<SAMPLE>(L, KB, ck, bb, n, (T_), 2 * hp + sg, sj, sdq, k0, k1); attn_load_v<SAMPLE>(L, VB, cv, bb, n, (T_), 2 * hp + sg, tid, v0, v1); } while (0)
#define ATT_WRITE(T_, BUF_) do { const int bo_ = (BUF_) * AT_BUF; \
        LAS u32x4* ok = (LAS u32x4*)(lds + AT_KS + bo_ + ((sg * 64 + sj) * 72 + 16 * sdq) * 2); ok[0] = k0; ok[1] = k1; \
        if (SAMPLE && (T_) < 8) { const int sj2 = tid & 63, dq2 = (tid >> 6) & 3; LAS bf16_t* ov = (LAS bf16_t*)(lds + AT_VT + bo_) + (sg * 64 + 16 * dq2) * 72 + sj2; \
            ov[0] = (bf16_t)v0.x; ov[72] = (bf16_t)(v0.x >> 16); ov[144] = (bf16_t)v0.y; ov[216] = (bf16_t)(v0.y >> 16); ov[288] = (bf16_t)v0.z; ov[360] = (bf16_t)(v0.z >> 16); ov[432] = (bf16_t)v0.w; ov[504] = (bf16_t)(v0.w >> 16); \
            ov[576] = (bf16_t)v1.x; ov[648] = (bf16_t)(v1.x >> 16); ov[720] = (bf16_t)v1.y; ov[792] = (bf16_t)(v1.y >> 16); ov[864] = (bf16_t)v1.z; ov[936] = (bf16_t)(v1.z >> 16); ov[1008] = (bf16_t)v1.w; ov[1080] = (bf16_t)(v1.w >> 16); \
        } else { const int p0 = tid & 255, p1 = p0 + 256; \
            *(LAS u32x4*)(lds + AT_VT + bo_ + ((sg * 64 + (p0 >> 3)) * 72 + (p0 & 7) * 8) * 2) = v0; *(LAS u32x4*)(lds + AT_VT + bo_ + ((sg * 64 + (p1 >> 3)) * 72 + (p1 & 7) * 8) * 2) = v1; } } while (0)
    ATT_LOADT(t0);
    ATT_WRITE(t0, 0);
    if (t0 + 1 < 9) ATT_LOADT(t0 + 1);
    __syncthreads();
#pragma unroll 1
    for (int t = t0; t < 9; ++t) {
        const int cb = (t - t0) & 1;
        if (t + 1 < 9) { ATT_WRITE(t + 1, cb ^ 1); if (t + 2 < 9) ATT_LOADT(t + 2); }
        const LAS unsigned char* kb_ = lds + AT_KS + cb * AT_BUF; const LAS unsigned char* vb_ = lds + AT_VT + cb * AT_BUF;
        f32x4 sc[4];
#pragma unroll
        for (int jt = 0; jt < 4; ++jt) { f32x4 acc = (f32x4){0.f, 0.f, 0.f, 0.f};
#pragma unroll
            for (int ks = 0; ks < 2; ++ks) acc = __builtin_amdgcn_mfma_f32_16x16x32_bf16(lds16(kb_ + ((g * 64 + 16 * jt + r) * 72 + 32 * ks + 8 * q) * 2), qf[ks], acc, 0, 0, 0);
            sc[jt] = acc; }
        if (t >= 6) {
#pragma unroll
            for (int jt = 0; jt < 4; ++jt)
#pragma unroll
                for (int e = 0; e < 4; ++e) { int rel = 512 + qi - (64 * t + 16 * jt + 4 * q + e); rel = rel > 128 ? 128 : rel; rel = rel < -128 ? -128 : rel; sc[jt][e] += bias_s[g * 260 + rel + 128]; }
        } else { const float bfar = bias_s[g * 260 + 256];
#pragma unroll
            for (int jt = 0; jt < 4; ++jt) sc[jt] = sc[jt] + bfar;
        }
        float ps = 0.f;
#pragma unroll
        for (int jt = 0; jt < 4; ++jt)
#pragma unroll
            for (int e = 0; e < 4; ++e) { const float p = __builtin_amdgcn_exp2f(sc[jt][e]); sc[jt][e] = p; ps += p; }
        l_run += ps;
#pragma unroll
        for (int s = 0; s < 2; ++s) {
            u32x4 w; w.x = pk2(sc[2 * s][0], sc[2 * s][1]); w.y = pk2(sc[2 * s][2], sc[2 * s][3]); w.z = pk2(sc[2 * s + 1][0], sc[2 * s + 1][1]); w.w = pk2(sc[2 * s + 1][2], sc[2 * s + 1][3]);
            const bf16x8 bp = __builtin_bit_cast(bf16x8, w);
#pragma unroll
            for (int dt = 0; dt < 4; ++dt) { const LAS unsigned char* vp = vb_ + ((g * 64 + 16 * dt + r) * 72 + 32 * s + 4 * q) * 2;
                const s16x4 lo = lds8(vp), hi = lds8(vp + 32); const bf16x8 av = __builtin_shufflevector(lo, hi, 0, 1, 2, 3, 4, 5, 6, 7);
                o[dt] = __builtin_amdgcn_mfma_f32_16x16x32_bf16(av, bp, o[dt], 0, 0, 0); }
        }
        __syncthreads();
    }
#undef ATT_LOADT
#undef ATT_WRITE
    l_run += __shfl_xor(l_run, 16); l_run += __shfl_xor(l_run, 32);
    const float inv = __builtin_amdgcn_rcpf(l_run);
#pragma unroll
    for (int dt = 0; dt < 4; ++dt) { const int dd = 16 * dt + 4 * q; const u32x2 gv = *(const u32x2*)(GBs + qrl * 1024 + h * 64 + dd);
        u32x2 w; w.x = pk2(o[dt][0] * inv * bflo(gv.x), o[dt][1] * inv * bfhi(gv.x)); w.y = pk2(o[dt][2] * inv * bflo(gv.y), o[dt][3] * inv * bfhi(gv.y));
        if (!dry || inv == 1.2345e30f) *(u32x2*)(orow + dd) = w; }
}
DI void attn_phase(const Args& a, int L, LAS unsigned char* lds, int dry, int item_lo, int item_hi, int first_wg) {
    int wg0_ = (int)blockIdx.x - first_wg; if (wg0_ < 0) wg0_ += (int)gridDim.x;
    int prev_hp = -1;
    for (int item = item_lo + wg0_; item < item_hi; item += gridDim.x) { const bool sb = (item & 7) != prev_hp; prev_hp = item & 7;
        if ((item >> 3) >= NPC) attn_item<true>(a, L, lds, dry, item, sb); else attn_item<false>(a, L, lds, dry, item, sb); }
}

#define XB_TMO      128
#define XB_XCNT(j)  (256  + 64 * (j))
#define XB_XSUB(j)  (1280 + 64 * (j))
#define XB_XGEN(j)  (2304 + 64 * (j))
#define XB_TOP      3328
#define XB_TOPGEN   3392
#define XCD_BAR_WORDS 3456
#define XB_SPIN_CAP (1u << 18)

__device__ __forceinline__ unsigned xb_ld(unsigned* p)              { return __hip_atomic_load(p, __ATOMIC_RELAXED, __HIP_MEMORY_SCOPE_AGENT); }
__device__ __forceinline__ unsigned xb_add(unsigned* p, unsigned v) { return __hip_atomic_fetch_add(p, v, __ATOMIC_RELAXED, __HIP_MEMORY_SCOPE_AGENT); }
__device__ __forceinline__ unsigned xb_xcc_id() { return (unsigned)__builtin_amdgcn_s_getreg((3 << 11) | 20) & 0xFu; }
#define XB_SPIN(cond, bar) do { unsigned _sp = 0; while (cond) { __builtin_amdgcn_s_sleep(1); \
    if ((++_sp & 255u) == 0u) { if (xb_ld(&(bar)[XB_TMO])) break; if (_sp > XB_SPIN_CAP) { atomicAdd(&(bar)[XB_TMO], 1u); break; } } } } while (0)

struct XcdBarrier {
    unsigned* bar; unsigned x;
    volatile LAS unsigned* st;
};

__device__ __forceinline__ XcdBarrier xcd_barrier_post(unsigned* bar, volatile LAS unsigned* st) {
    XcdBarrier b; b.bar = bar; b.x = xb_xcc_id(); b.st = st;
    if (threadIdx.x == 0) (void)xb_add(&bar[XB_XCNT(b.x)], 1u);
    return b;
}
__device__ __forceinline__ void xcd_barrier_complete(unsigned* bar, unsigned x, unsigned& nloc, unsigned& nx) {
    const unsigned G = gridDim.x * gridDim.y * gridDim.z;
    unsigned sum, cnt, mine, sp = 0u;
    for (;;) {
        sum = 0u; cnt = 0u; mine = 0u;
#pragma unroll
        for (unsigned j = 0; j < 16; ++j) { const unsigned c = xb_ld(&bar[XB_XCNT(j)]); sum += c; cnt += (c > 0u) ? 1u : 0u; mine = (j == x) ? c : mine; }
        if (sum == G) break;
        __builtin_amdgcn_s_sleep(1);
        if ((++sp & 255u) == 0u) { if (xb_ld(&bar[XB_TMO])) break; if (sp > XB_SPIN_CAP) { atomicAdd(&bar[XB_TMO], 1u); break; } }
    }
    nloc = mine > 0u ? mine : 1u; nx = cnt > 0u ? cnt : 1u;
}

__device__ __forceinline__ void xcd_barrier(const XcdBarrier& b) {
    asm volatile("s_waitcnt vmcnt(0)" ::: "memory");
    __syncthreads();
    if (threadIdx.x == 0) {
        unsigned* bar = b.bar;
        __builtin_amdgcn_s_waitcnt(0);
        unsigned nloc = b.st[0], nx = b.st[1];
        if (nloc == 0u) { xcd_barrier_complete(bar, b.x, nloc, nx); b.st[0] = nloc; b.st[1] = nx; }
        const unsigned old = xb_add(&bar[XB_XSUB(b.x)], 1u);
        const unsigned gen = old / nloc;
        if (old + 1u == (gen + 1u) * nloc) {
            __builtin_amdgcn_fence(__ATOMIC_RELEASE, "agent");
            asm volatile("s_waitcnt vmcnt(0)" ::: "memory");
            const unsigned og = xb_add(&bar[XB_TOP], 1u);
            const unsigned tg = og / nx;
            if (og + 1u == (tg + 1u) * nx) xb_add(&bar[XB_TOPGEN], 1u);
            else XB_SPIN(xb_ld(&bar[XB_TOPGEN]) == tg, bar);
            __builtin_amdgcn_fence(__ATOMIC_ACQUIRE, "agent");
            xb_add(&bar[XB_XGEN(b.x)], 1u);
            asm volatile("s_waitcnt vmcnt(0)" ::: "memory");
        } else {
            XB_SPIN(xb_ld(&bar[XB_XGEN(b.x)]) == gen, bar);
            __builtin_amdgcn_fence(__ATOMIC_ACQUIRE, "agent");
            asm volatile("s_waitcnt vmcnt(0)" ::: "memory");
        }
    }
    __syncthreads();
}

#ifndef PROBE_REP
#define PROBE_REP 0
#endif
#ifndef EN_CH
#define EN_CH 31
#endif
#ifndef EN_PREP
#define EN_PREP 1
#endif
#ifndef EN_GIN
#define EN_GIN 1
#endif
#ifndef EN_GLAA
#define EN_GLAA 1
#endif
#ifndef EN_SCAN
#define EN_SCAN 1
#endif
#ifndef EN_GLAC
#define EN_GLAC 1
#endif
#ifndef EN_ATTN
#define EN_ATTN 1
#endif
#ifndef EN_CHAIN
#define EN_CHAIN 1
#endif
constexpr int PH_PER_LAYER = 10, N_PHASES = 1 + 2 * PH_PER_LAYER;
constexpr int MISC_OFF = LDS_BYTES - 64;
#define REPS(k) (((PROBE_REP >> (k)) & 1) ? 2 : 1)
__global__ void __launch_bounds__(NTHREADS, 2) fwd_kernel(Args a) {
    extern __shared__ __attribute__((aligned(16))) unsigned char lds_raw[];
    LAS unsigned char* lds = (LAS unsigned char*)lds_raw;
    const int tid = otid(), lane = tid & 63, wave = __builtin_amdgcn_readfirstlane(tid >> 6);
    const int gw = blockIdx.x * 8 + wave, ngw = gridDim.x * 8, gtid = blockIdx.x * NTHREADS + tid, ngt = gridDim.x * NTHREADS;
    LAS float* scr = (LAS float*)(lds + wave * 16384);
    const int lo = kph_lo(), hi = kph_hi();
    volatile LAS unsigned* MISC = (volatile LAS unsigned*)(lds + MISC_OFF);
    if (tid < 16) MISC[tid] = 0u;
    __syncthreads();
    XcdBarrier bar; bar.bar = (unsigned*)kws(); bar.x = 0; bar.st = nullptr;
    if (hi - lo > 1) bar = xcd_barrier_post((unsigned*)kws(), MISC);
#define IN_PH(k) (lo <= (k) && (k) < hi)
#define SEAM(k) do { if (IN_PH(k) && IN_PH((k) + 1)) { xcd_barrier(bar); if ((PROBE_REP >> 11) & 1) xcd_barrier(bar); } } while (0)
    if (lo < 0) { __threadfence(); cg::this_grid().sync(); }
    if (EN_PREP && IN_PH(0)) for (int rep = 0; rep < REPS(10); ++rep) { prep_small(a, gw, ngw, scr, lane); prep_win(a, 0, gw, ngw, scr, lane); prep_rows(a, gw, ngw, lane); prep_shift(gw, lane); prep_misc(a, gtid, ngt); __syncthreads(); }
    SEAM(0);
    for (int L = 0; L < 2; ++L) {
        const int pb = 1 + L * PH_PER_LAYER;
        unsigned char* ws = kws();
        bf16_t* XB = (bf16_t*)(ws + WS_XB); float* SQ1 = (float*)(ws + WS_SQ1); float* SQ2 = (float*)(ws + WS_SQ2);
        bf16_t* S0 = (bf16_t*)(ws + WS_OV); bf16_t* S1 = (bf16_t*)(ws + WS_OV + SLOT); bf16_t* S2 = (bf16_t*)(ws + WS_OV + 2 * SLOT); bf16_t* S3 = (bf16_t*)(ws + WS_OV + 3 * SLOT); bf16_t* S4 = (bf16_t*)(ws + WS_OV + 4 * SLOT);
        const bf16_t* WIN = (const bf16_t*)(ws + WS_WIN);
        EpiIn ein; ein.L = L; ein.ws = ws; ein.out = kout(); ein.qg = kin(I_QG) + L * 64; ein.kg = kin(I_KG) + L * 64;
        if (EN_GIN && IN_PH(pb + 0)) for (int rep = 0; rep < REPS(0); ++rep) { ein.tile0 = 0; run_gemm_g(lds, XB, WIN, ein); }
        SEAM(pb + 0);
        if (EN_GLAA && IN_PH(pb + 1)) for (int rep = 0; rep < REPS(1); ++rep) gla_a_phase(a, L, lds, 0, NPC * 4, 0);
        SEAM(pb + 1);
        if (EN_SCAN && IN_PH(pb + 2)) for (int rep = 0; rep < REPS(2); ++rep) {
            gla_a_phase(a, L, lds, NPC * 4, NCH * 4, 0); gla_c_phase(a, L, lds, rep + 1 < REPS(2), NPC * 4, NCH * 4, 32);
            attn_phase(a, L, lds, rep + 1 < REPS(2), NPC * 8, NCH * 8, 64);
            gla_scan_phase(a, L, rep + 1 < REPS(2)); }
        SEAM(pb + 2);
        if (EN_GLAC && IN_PH(pb + 3)) for (int rep = 0; rep < REPS(3); ++rep) gla_c_phase(a, L, lds, rep + 1 < REPS(3), 0, NPC * 4, 0);
        SEAM(pb + 3);
        if (EN_GIN && IN_PH(pb + 4)) for (int rep = 0; rep < REPS(4); ++rep) { ein.tile0 = 13; run_gemm(lds, XB, WIN + (size_t)13 * 256 * 1024, MP, 16 * 256, 1024, ein); }
        SEAM(pb + 4);
        if (EN_ATTN && IN_PH(pb + 5)) for (int rep = 0; rep < REPS(5); ++rep) attn_phase(a, L, lds, rep + 1 < REPS(5), 0, NPC * 8, 0);
        SEAM(pb + 5);
        if (EN_GIN && IN_PH(pb + 6)) for (int rep = 0; rep < REPS(6); ++rep) { ein.tile0 = 29; run_gemm_m(lds, XB, WIN + (size_t)29 * 256 * 1024, ein); }
        if (!(IN_PH(pb + 6) && IN_PH(pb + 7))) SEAM(pb + 6);
        if (EN_CHAIN && IN_PH(pb + 7)) for (int rep = 0; rep < REPS(7); ++rep) { const int dry = rep + 1 < REPS(7);
            if (EN_CH & 1) { bf16_t* AXA = (bf16_t*)(ws + WS_AX + 4 * MiB); EpiYA ea{S1, dry, AXA}; run_gemm(lds, S0, wsm(a, L, 0), MP, 1024, 1024, ea); mini_gemm<1024>(lds, S0 + (size_t)MP * 1024, wsm(a, L, 0), ea); }
            if (EN_CH & 2) { bf16_t* AXA = (bf16_t*)(ws + WS_AX + 4 * MiB); bf16_t* AXB = (bf16_t*)(ws + WS_AX + 5 * MiB); EpiYB eb{S1, S2, dry, AXA, AXB}; run_gemm(lds, S4, wsm(a, L, 1), MP, 1024, 1024, eb); mini_gemm<1024>(lds, S4 + (size_t)MP * 1024, wsm(a, L, 1), eb); }
        }
        SEAM(pb + 7);
        if (EN_CHAIN && IN_PH(pb + 8)) {
            if (L == 0) { prep_win(a, 1, gw, ngw, scr, lane); __syncthreads(); }
            for (int rep = 0; rep < REPS(8); ++rep) {
            EpiOut eo; eo.xp = L == 0 ? kin(I_XP) : kout(); eo.xs = L == 0 ? kin(I_XS) : kout() + (size_t)MP * 1024; eo.out = kout(); eo.xb = S3; eo.sq = SQ1; eo.dry = rep + 1 < REPS(8);
            if (EN_CH & 4) { run_gemm(lds, S2, wsm(a, L, 2), MP, 1024, 1024, eo); mini_gemm<1024>(lds, (const bf16_t*)(ws + WS_AX + 5 * MiB), wsm(a, L, 2), eo); } }
        }
        SEAM(pb + 8);
        if (EN_CHAIN && IN_PH(pb + 9)) for (int rep = 0; rep < REPS(9); ++rep) { const int dry = rep + 1 < REPS(9);
            if (EN_CH & 8) { EpiP ep{(float*)S0, dry}; run_gemm(lds, (const bf16_t*)(ws + WS_PB) + (size_t)L * MT * 256, wsm(a, L, 4), MP, 1024, 256, ep); mini_gemm<256>(lds, (const bf16_t*)(ws + WS_PB) + ((size_t)L * MT + MP) * 256, wsm(a, L, 4), ep); }
            EpiGate eg; eg.sq1 = SQ1; eg.PT = (const float*)S0; eg.out = kout(); eg.xb = XB; eg.sq2 = SQ2; eg.dry = dry;
            if (EN_CH & 16) { run_gemm(lds, S3, wsm(a, L, 3), MP, 1024, 1024, eg); mini_gemm<1024>(lds, S3 + (size_t)MP * 1024, wsm(a, L, 3), eg); }
        }
        SEAM(pb + 9);
    }
}

#ifndef MK_ONE_LAUNCH
#define MK_ONE_LAUNCH 1
#endif
extern "C" void kernel_launch(void* const* d_in, const int* in_sizes, int n_in, void* d_out, int out_size, void* d_ws, size_t ws_size, hipStream_t stream) {
    static int grid = 0;
    if (grid == 0) {
        if (n_in != 21 || ws_size < WS_END) { fprintf(stderr, "kernel_launch: unexpected n_in %d or ws_size %zu (< %zu)\n", n_in, ws_size, (size_t)WS_END); grid = -1; return; }
        int dev = 0, cus = 0, per_cu = 0;
        (void)hipGetDevice(&dev); (void)hipDeviceGetAttribute(&cus, hipDeviceAttributeMultiprocessorCount, dev);
        (void)hipFuncSetAttribute((const void*)fwd_kernel, hipFuncAttributeMaxDynamicSharedMemorySize, LDS_BYTES);
        (void)hipOccupancyMaxActiveBlocksPerMultiprocessor(&per_cu, (const void*)fwd_kernel, NTHREADS, LDS_BYTES);
        (void)hipGetLastError();
        if (per_cu < 1) { fprintf(stderr, "kernel_launch: occupancy query says %d blocks/CU\n", per_cu); per_cu = 1; }
        grid = cus;
    }
    if (grid < 0) return;
    Args a{};
    for (int i = 0; i < 21; ++i) a.in[i] = (const float*)d_in[i];
    a.out = (float*)d_out; a.ws = (unsigned char*)d_ws;
#if MK_ONE_LAUNCH
    (void)hipMemsetAsync(d_ws, 0, 16384, stream);
    a.ph_lo = 0; a.ph_hi = N_PHASES;
    void* args[] = {&a};
    hipError_t e = hipLaunchCooperativeKernel((const void*)fwd_kernel, dim3(grid), dim3(NTHREADS), args, LDS_BYTES, stream);
    if (e != hipSuccess) fprintf(stderr, "cooperative launch failed: %s (grid %d)\n", hipGetErrorString(e), grid);
#else
    for (int p = 0; p < N_PHASES; ++p) { a.ph_lo = p; a.ph_hi = p + 1; hipLaunchKernelGGL(fwd_kernel, dim3(grid), dim3(NTHREADS), LDS_BYTES, stream, a); }
#endif
}
```

```cpp
#include <hip/hip_runtime.h>
#include <hip/hip_cooperative_groups.h>
#include <cstdio>
#include <cstdint>
namespace cg = cooperative_groups;
namespace pg8 {
#define PG8_LAS __attribute__((address_space(3)))
typedef unsigned short bf16_t;
typedef short bf16x8 __attribute__((ext_vector_type(8)));
typedef float f32x4 __attribute__((ext_vector_type(4)));
typedef unsigned u32x4 __attribute__((ext_vector_type(4)));
constexpr int BM = 256, BK = 64, HALF = 128, HTB = HALF * BK * 2  , STAGE_BYTES = 8 * HTB, NXCD = 8, WGM = 8;

__host__ __device__ __forceinline__ int lds_byte(int r, int c) { const int st = (r >> 4) * 2 + (c >> 5), rr = r & 15, cc = c & 31, ob = rr * 64 + cc * 2; return st * 1024 + (ob ^ (((ob >> 9) & 1) << 5)); }
__host__ __device__ __forceinline__ void stage_rc(int b, int& R, int& C) { const int st = b / 1024, sb = b % 1024, swz = sb ^ (((sb >> 9) & 1) << 5); R = (st >> 1) * 16 + swz / 64; C = (st & 1) * 32 + (swz % 64) / 2; }
__host__ __device__ __forceinline__ int perm32(int rho) { const int n = rho >> 4, i = rho & 15; return 8 * (i >> 2) + 4 * n + (i & 3); }

struct Unit { int pm, pn; };
struct Gemm { const bf16_t* A; const bf16_t* Bt; int M, N, K; };

struct StaticOrder {
    int nM, nN, nwg, G, c;
    __host__ __device__ void init(int M, int N, int G_, int c_) { nM = M / BM; nN = N / BM; nwg = nM * nN; G = G_; c = c_; }
    __host__ __device__ bool next(int i, Unit& u) const {
        const long L = (long)i * G + c; if (L >= nwg) return false;
        int wgid = (int)L; { const int q = nwg / NXCD, r = nwg % NXCD, xcd = wgid % NXCD, off = wgid / NXCD; wgid = (xcd < r ? xcd * (q + 1) : r * (q + 1) + (xcd - r) * q) + off; }
        const int nig = WGM * nN, gid = wgid / nig, fm = gid * WGM, gsz = (nM - fm) < WGM ? (nM - fm) : WGM;
        u.pm = fm + ((wgid % nig) % gsz); u.pn = (wgid % nig) / gsz; return true;
    }
    __device__ __forceinline__ void a_ready(const Unit&) const {}
    __device__ __forceinline__ void done(const Unit&) const {}
};
__device__ __forceinline__ unsigned cvt_pk_bf16(float lo, float hi) { unsigned r; asm volatile("v_cvt_pk_bf16_f32 %0, %1, %2" : "=v"(r) : "v"(lo), "v"(hi)); return r; }
template <class Epi, class Sched, bool ALIGN_EPI = false, bool SP2 = false>
__device__ __forceinline__ void gemm_phase(PG8_LAS unsigned char* lds, const Gemm g, const Sched& S, const Epi& E) {
    int tid_ = threadIdx.x; asm volatile("" : "+v"(tid_));
    const int tid = tid_, wid = __builtin_amdgcn_readfirstlane(tid >> 6), lane = tid & 63, wr = wid >> 2, wc = wid & 3, fr = lane & 15, fq = lane >> 4;
    const int K = g.K, nt = K / BK;
    unsigned voffA[2], voffB[2];
#pragma unroll
    for (int i = 0; i < 2; ++i) { int R, C; stage_rc(tid * 16 + i * 8192, R, C); const int Rb = Epi::PERM ? ((R & ~31) + perm32(R & 31)) : R;
        voffA[i] = (unsigned)(R * K + C) * 2u; voffB[i] = (unsigned)(Rb * K + C) * 2u; }
    const size_t kstep = (size_t)(BK * 2);
    const size_t hstep = (size_t)HALF * K * 2;
    const size_t tstep = 2 * hstep;
    const unsigned ldsw = (unsigned)wid * 1024u;
    const int aoff = lds_byte(wr * 64 + fr, fq * 8), boff = lds_byte(wc * 32 + fr, fq * 8);
#define PG8_SA(b, h) (((b) * 2 + (h)) * HTB)
#define PG8_SB(b, h) ((4 + (b) * 2 + (h)) * HTB)
#define PG8_STAGE(bufoff, gbase, voff) do { _Pragma("unroll") for (int _i = 0; _i < 2; ++_i) \
        __builtin_amdgcn_global_load_lds((const unsigned*)((const char*)(gbase) + (voff)[_i]), (PG8_LAS unsigned*)(lds + (bufoff) + ldsw + _i * 8192), 16, 0, 0); } while (0)
#define PG8_LDA(dst, b, h) do { _Pragma("unroll") for (int m = 0; m < 4; ++m) _Pragma("unroll") for (int k = 0; k < 2; ++k) dst[m][k] = *(const PG8_LAS bf16x8*)(lds + PG8_SA(b, h) + aoff + m * 2048 + k * 1024); } while (0)
#define PG8_LDB(dst, b, h) do { _Pragma("unroll") for (int n = 0; n < 2; ++n) _Pragma("unroll") for (int k = 0; k < 2; ++k) dst[n][k] = *(const PG8_LAS bf16x8*)(lds + PG8_SB(b, h) + boff + n * 2048 + k * 1024); } while (0)
#define PG8_MMA(ai, bj, At, Bt) do { __builtin_amdgcn_s_setprio(1); _Pragma("unroll") for (int m = 0; m < 4; ++m) _Pragma("unroll") for (int n = 0; n < 2; ++n) _Pragma("unroll") for (int k = 0; k < 2; ++k) \
        acc[ai][bj][m][n] = __builtin_amdgcn_mfma_f32_16x16x32_bf16(Bt[n][k], At[m][k], acc[ai][bj][m][n], 0, 0, 0); __builtin_amdgcn_s_setprio(0); } while (0)
#define PG8_WAIT_V(n) asm volatile("s_waitcnt vmcnt(" #n ")" ::: "memory")
#define PG8_WAIT_L(n) asm volatile("s_waitcnt lgkmcnt(" #n ")" ::: "memory")
#define PG8_BAR __builtin_amdgcn_s_barrier()
#define PG8_SCHED __builtin_amdgcn_sched_barrier(0)
    Unit cur, nxt; int ui = 0;
    if (!S.next(0, cur)) return;
    f32x4 acc[2][2][4][2];
#pragma unroll
    for (int a = 0; a < 2; ++a)
#pragma unroll
        for (int b = 0; b < 2; ++b)
#pragma unroll
            for (int m = 0; m < 4; ++m)
#pragma unroll
                for (int n = 0; n < 2; ++n) acc[a][b][m][n] = (f32x4){0.f, 0.f, 0.f, 0.f};
    bf16x8 At[4][2], B0[2][2], B1[2][2];
    const char* cA = (const char*)g.A + (size_t)cur.pm * tstep; const char* cB = (const char*)g.Bt + (size_t)cur.pn * tstep;
    S.a_ready(cur);
    if constexpr (SP2) {
        PG8_STAGE(PG8_SB(0, 0), cB, voffB); PG8_STAGE(PG8_SB(0, 1), cB + hstep, voffB); PG8_STAGE(PG8_SA(0, 0), cA, voffA); PG8_STAGE(PG8_SA(0, 1), cA + hstep, voffA);
        if (wr == 1) PG8_BAR;
        PG8_WAIT_V(2); PG8_BAR;
        PG8_STAGE(PG8_SB(1, 0), cB + kstep, voffB); PG8_STAGE(PG8_SA(1, 0), cA + kstep, voffA); PG8_STAGE(PG8_SB(1, 1), cB + hstep + kstep, voffB);
        PG8_WAIT_V(6); PG8_BAR;
    } else {
        PG8_STAGE(PG8_SB(0, 0), cB, voffB); PG8_STAGE(PG8_SA(0, 0), cA, voffA); PG8_STAGE(PG8_SB(0, 1), cB + hstep, voffB); PG8_STAGE(PG8_SA(0, 1), cA + hstep, voffA);
        if (wr == 1) PG8_BAR;
        PG8_WAIT_V(4); PG8_BAR;
        PG8_STAGE(PG8_SB(1, 0), cB + kstep, voffB); PG8_STAGE(PG8_SA(1, 0), cA + kstep, voffA); PG8_STAGE(PG8_SB(1, 1), cB + hstep + kstep, voffB);
        PG8_WAIT_V(6); PG8_BAR;
    }
    for (;;) {
        const bool has_next = S.next(ui + 1, nxt);
        const char* nA = has_next ? (const char*)g.A + (size_t)nxt.pm * tstep : cA; const char* nB = has_next ? (const char*)g.Bt + (size_t)nxt.pn * tstep : cB;
        for (int t = 0; t < nt; t += 2) {
            const bool last = (t == nt - 2);
            const char* a1 = cA + (size_t)(t + 1) * kstep;
            const char* a2 = last ? nA : cA + (size_t)(t + 2) * kstep; const char* b2 = last ? nB : cB + (size_t)(t + 2) * kstep;
            const char* a3 = a2 + kstep; const char* b3 = b2 + kstep;
            if (last && has_next) S.a_ready(nxt);
            if constexpr (SP2) {
            PG8_LDB(B0, 0, 0); PG8_LDB(B1, 0, 1); PG8_SCHED; PG8_LDA(At, 0, 0); PG8_STAGE(PG8_SA(1, 1), a1 + hstep, voffA);
            PG8_WAIT_V(8); PG8_WAIT_L(0); PG8_BAR; PG8_MMA(0, 0, At, B0); PG8_MMA(0, 1, At, B1); PG8_BAR; PG8_SCHED;
            PG8_LDA(At, 0, 1); PG8_STAGE(PG8_SB(0, 0), b2, voffB); PG8_STAGE(PG8_SB(0, 1), b2 + hstep, voffB); PG8_STAGE(PG8_SA(0, 0), a2, voffA);
            PG8_WAIT_V(8); PG8_WAIT_L(0); PG8_BAR; PG8_MMA(1, 0, At, B0); PG8_MMA(1, 1, At, B1); PG8_BAR; PG8_SCHED;
            PG8_LDB(B0, 1, 0); PG8_LDB(B1, 1, 1); PG8_SCHED; PG8_LDA(At, 1, 0); PG8_STAGE(PG8_SA(0, 1), a2 + hstep, voffA);
            PG8_WAIT_V(8); PG8_WAIT_L(0); PG8_BAR; PG8_MMA(0, 0, At, B0); PG8_MMA(0, 1, At, B1); PG8_BAR; PG8_SCHED;
            PG8_LDA(At, 1, 1); PG8_STAGE(PG8_SB(1, 0), b3, voffB); PG8_STAGE(PG8_SB(1, 1), b3 + hstep, voffB); PG8_STAGE(PG8_SA(1, 0), a3, voffA);
            PG8_WAIT_V(8); PG8_WAIT_L(0); PG8_BAR; PG8_MMA(1, 0, At, B0); PG8_MMA(1, 1, At, B1); PG8_BAR; PG8_SCHED;
            } else {
            PG8_LDB(B0, 0, 0); PG8_SCHED; PG8_LDA(At, 0, 0); PG8_STAGE(PG8_SA(1, 1), a1 + hstep, voffA);
            PG8_WAIT_L(8); PG8_BAR; PG8_WAIT_L(0); PG8_MMA(0, 0, At, B0); PG8_BAR; PG8_SCHED;
            PG8_LDB(B1, 0, 1); PG8_STAGE(PG8_SB(0, 0), b2, voffB);
            PG8_BAR; PG8_WAIT_L(0); PG8_MMA(0, 1, At, B1); PG8_BAR;
            PG8_LDA(At, 0, 1); PG8_STAGE(PG8_SA(0, 0), a2, voffA);
            PG8_BAR; PG8_WAIT_L(0); PG8_MMA(1, 0, At, B0); PG8_BAR; PG8_SCHED;
            PG8_STAGE(PG8_SB(0, 1), b2 + hstep, voffB);
            PG8_WAIT_V(6); PG8_BAR; PG8_MMA(1, 1, At, B1); PG8_BAR;
            PG8_LDB(B0, 1, 0); PG8_SCHED; PG8_LDA(At, 1, 0); PG8_STAGE(PG8_SA(0, 1), a2 + hstep, voffA);
            PG8_WAIT_L(8); PG8_BAR; PG8_WAIT_L(0); PG8_MMA(0, 0, At, B0); PG8_BAR; PG8_SCHED;
            PG8_LDB(B1, 1, 1); PG8_STAGE(PG8_SB(1, 0), b3, voffB);
            PG8_BAR; PG8_WAIT_L(0); PG8_MMA(0, 1, At, B1); PG8_BAR;
            PG8_LDA(At, 1, 1); PG8_STAGE(PG8_SA(1, 0), a3, voffA);
            PG8_BAR; PG8_WAIT_L(0); PG8_MMA(1, 0, At, B0); PG8_BAR; PG8_SCHED;
            PG8_STAGE(PG8_SB(1, 1), b3 + hstep, voffB);
            PG8_WAIT_V(6); PG8_BAR; PG8_MMA(1, 1, At, B1); PG8_BAR;
            }
        }
        if constexpr (ALIGN_EPI) { if (wr == 0) PG8_BAR; }
        if constexpr (!Epi::AFTER_DRAIN) { E(acc, cur, wr, wc, fr, fq); S.done(cur); }
        if (!has_next) break;
#pragma unroll
        for (int a = 0; a < 2; ++a)
#pragma unroll
            for (int b = 0; b < 2; ++b)
#pragma unroll
                for (int m = 0; m < 4; ++m)
#pragma unroll
                    for (int n = 0; n < 2; ++n) acc[a][b][m][n] = (f32x4){0.f, 0.f, 0.f, 0.f};
        cur = nxt; cA = nA; cB = nB; ++ui;
        if constexpr (ALIGN_EPI) { if (wr == 1) PG8_BAR; }
    }
    PG8_WAIT_V(0);
    if constexpr (!ALIGN_EPI) { if (wr == 0) PG8_BAR; }
    PG8_BAR;
    if constexpr (Epi::AFTER_DRAIN) { E.fused(acc, cur, wr, wc, fr, fq, lds, wid, lane); S.done(cur); }
#undef PG8_SA
#undef PG8_SB
#undef PG8_STAGE
#undef PG8_LDA
#undef PG8_LDB
#undef PG8_MMA
#undef PG8_WAIT_V
#undef PG8_WAIT_L
#undef PG8_BAR
#undef PG8_SCHED
}
}

#define DI __device__ __forceinline__
#define LAS __attribute__((address_space(3)))
typedef unsigned short bf16_t;
typedef short bf16x8 __attribute__((ext_vector_type(8)));
typedef short s16x4 __attribute__((ext_vector_type(4)));
typedef float f32x4 __attribute__((ext_vector_type(4)));
typedef unsigned u32x4 __attribute__((ext_vector_type(4)));
typedef unsigned u32x2 __attribute__((ext_vector_type(2)));

constexpr int DM = 1024, MP = 16384, MS = 512, MT = MP + MS;
constexpr int NPC = 256, NCH = 264;
constexpr float EPS = 1e-6f, LOG2E = 1.4426950408889634f;
constexpr int NWIN_T = 37;
constexpr int NTHREADS = 512;
constexpr int LDS_BYTES = 147456;

constexpr size_t MiB = 1u << 20;
constexpr size_t SLOT = 33 * MiB;
constexpr size_t WS_MSH = 65536;
constexpr size_t WS_SQ1 = 1 * MiB, WS_SQ2 = 5 * MiB / 2, WS_RA = 4 * MiB, WS_DC = 6 * MiB, WS_WSM = 7 * MiB, WSM_LAYER = 17 * MiB / 2;
constexpr size_t WS_WIN = 24 * MiB, WS_PB = 43 * MiB, WS_XB = 60 * MiB, WS_OV = 93 * MiB, WS_AX = WS_OV + 5 * SLOT, WS_END = WS_AX + 6 * MiB;
constexpr size_t O_Y = 0, O_SP = 17301504, O_KP = 18350080, O_VP = 22544384, O_SS = 26738688, O_KS = 28835840, O_VS = 37224448;


typedef const __attribute__((address_space(4))) unsigned char* kargp_t;
DI kargp_t kbase() { kargp_t k = (kargp_t)__builtin_amdgcn_kernarg_segment_ptr(); asm volatile("" : "+s"(k)); return k; }
DI const float* kin(int i) { return *(const float* const __attribute__((address_space(4)))*)(kbase() + 8 * i); }
DI float* kout() { return *(float* const __attribute__((address_space(4)))*)(kbase() + 168); }
DI unsigned char* kws() { return *(unsigned char* const __attribute__((address_space(4)))*)(kbase() + 176); }
DI int kph_lo() { return *(const __attribute__((address_space(4))) int*)(kbase() + 184); }
DI int kph_hi() { return *(const __attribute__((address_space(4))) int*)(kbase() + 188); }
DI int otid() { int t = threadIdx.x; asm volatile("" : "+v"(t)); return t; }
DI float bflo(unsigned w) { return __uint_as_float(w << 16); }
DI float bfhi(unsigned w) { return __uint_as_float(w & 0xffff0000u); }
DI float bf2f(bf16_t b) { return __uint_as_float(((unsigned)b) << 16); }
typedef float f32x2_t __attribute__((ext_vector_type(2))); typedef __bf16 bf16x2_t __attribute__((ext_vector_type(2)));
DI unsigned pk2(float lo, float hi) { f32x2_t v = {lo, hi}; bf16x2_t r = __builtin_convertvector(v, bf16x2_t); return __builtin_bit_cast(unsigned, r); }
DI float sigm(float x) { return __builtin_amdgcn_rcpf(1.f + __expf(-x)); }
DI float silu(float x) { return x * sigm(x); }
DI float row_rstd(const float* sq, int row) {
    const f32x4* p = (const f32x4*)(sq + (size_t)row * 16); const f32x4 a = p[0], b = p[1], c = p[2], d = p[3];
    const float s = (((a.x + a.y) + (a.z + a.w)) + ((b.x + b.y) + (b.z + b.w))) + (((c.x + c.y) + (c.z + c.w)) + ((d.x + d.y) + (d.z + d.w)));
    return rsqrtf(s * (1.f / 1024.f) + EPS);
}
DI u32x4 pack8(const float* v) { u32x4 w; w.x = pk2(v[0], v[1]); w.y = pk2(v[2], v[3]); w.z = pk2(v[4], v[5]); w.w = pk2(v[6], v[7]); return w; }
DI void unpack8(u32x4 w, float* v) { v[0] = bflo(w.x); v[1] = bfhi(w.x); v[2] = bflo(w.y); v[3] = bfhi(w.y); v[4] = bflo(w.z); v[5] = bfhi(w.z); v[6] = bflo(w.w); v[7] = bfhi(w.w); }

enum { T_QA = 0, T_KA, T_VA, T_GA, T_RA, T_QB, T_KB, T_VB, T_GB, T_MGA, T_MGB };
struct EpiIn {
    static constexpr bool PERM = false, AFTER_DRAIN = false;
    int tile0, L; unsigned char* ws; float* out; const float *qg, *kg;
    template <int TYPE> DI void run(const pg8::f32x4 (&acc)[2][2][4][2], int pm, int tcol, int wr, int wc, int fr, int fq) const {
        constexpr size_t doff = TYPE == T_QA ? WS_OV + 2 * SLOT : TYPE == T_KA ? WS_OV + 2 * SLOT + (size_t)MT * 1024 : TYPE == T_VA ? WS_OV + SLOT : TYPE == T_GA ? WS_OV : TYPE == T_QB ? WS_OV + SLOT : TYPE == T_KB ? WS_OV + 2 * SLOT
                              : TYPE == T_VB ? WS_OV + 3 * SLOT : TYPE == T_GB ? WS_OV + 4 * SLOT : TYPE == T_MGA ? WS_OV + SLOT : WS_OV + 2 * SLOT;
        constexpr bool ANX = TYPE == T_QB || TYPE == T_KB || TYPE == T_VB || TYPE == T_GB || TYPE == T_MGA || TYPE == T_MGB;
        constexpr size_t aoff = WS_AX + (TYPE == T_QB ? 0 : TYPE == T_KB ? 1 : TYPE == T_VB ? 2 : TYPE == T_GB ? 3 : TYPE == T_MGA ? 4 : 5) * MiB;
        const bool srow = ANX && pm >= MP / 256;
        bf16_t* dst = (bf16_t*)(ws + (srow ? aoff : doff)); const int rsub = srow ? MP : 0; const float* sq = (const float*)(ws + WS_SQ2); float* RA = (float*)(ws + WS_RA);
        float* okp = out + (TYPE == T_KB ? O_KP : O_VP) + (size_t)L * 4 * 512 * 1024; float* oks = out + (TYPE == T_KB ? O_KS : O_VS) + (size_t)L * 8 * 512 * 1024;
        const int ld = (TYPE == T_QA || TYPE == T_KA) ? 512 : 1024;
        float gq[2][8];
        if (TYPE == T_QB || TYPE == T_KB) {
            const float* g = TYPE == T_QB ? qg : kg;
#pragma unroll
            for (int bj = 0; bj < 2; ++bj)
#pragma unroll
                for (int k = 0; k < 8; ++k) gq[bj][k] = g[32 * bj + 8 * fq + k] * (TYPE == T_QB ? 0.125f * LOG2E : 1.f);
        }
#pragma unroll
        for (int ai = 0; ai < 2; ++ai)
#pragma unroll
            for (int m = 0; m < 4; ++m) {
                const int row = pm * 256 + ai * 128 + wr * 64 + m * 16 + fr;
                const float rs = row_rstd(sq, row);
                float v[2][8];
#pragma unroll
                for (int bj = 0; bj < 2; ++bj)
#pragma unroll
                    for (int n = 0; n < 2; ++n)
#pragma unroll
                        for (int e = 0; e < 4; ++e) v[bj][4 * n + e] = acc[ai][bj][m][n][e] * rs;
                if (TYPE == T_RA) {
                    if (wc == 0 && fq < 2) { float* p = RA + (size_t)row * 16 + 8 * fq; *(f32x4*)p = (f32x4){v[0][0], v[0][1], v[0][2], v[0][3]}; *(f32x4*)(p + 4) = (f32x4){v[0][4], v[0][5], v[0][6], v[0][7]}; }
                    continue;
                }
                if (TYPE == T_QB || TYPE == T_KB) {
                    float ss = 0.f;
#pragma unroll
                    for (int bj = 0; bj < 2; ++bj)
#pragma unroll
                        for (int k = 0; k < 8; ++k) ss += v[bj][k] * v[bj][k];
                    ss += __shfl_xor(ss, 16); ss += __shfl_xor(ss, 32);
                    const float r = rsqrtf(ss * (1.f / 64.f) + EPS);
#pragma unroll
                    for (int bj = 0; bj < 2; ++bj)
#pragma unroll
                        for (int k = 0; k < 8; ++k) v[bj][k] *= r * gq[bj][k];
                }
                float* bo = nullptr;
                if (TYPE == T_KB || TYPE == T_VB) {
                    if (row < MP) { const int t = row & 4095; if (t >= 3584) bo = okp + ((size_t)(row >> 12) * 512 + (t - 3584)) * 1024; }
                    else { const int rr = row - MP; bo = oks + ((size_t)(rr >> 6) * 512 + 448 + (rr & 63)) * 1024; }
                }
#pragma unroll
                for (int bj = 0; bj < 2; ++bj) {
                    const int col = tcol * 256 + 64 * wc + 32 * bj + 8 * fq;
                    if (TYPE == T_QA) {
#pragma unroll
                        for (int k = 0; k < 8; ++k) v[bj][k] *= 0.08838834764831845f;
                    }
                    if (TYPE == T_GA || TYPE == T_GB) {
#pragma unroll
                        for (int k = 0; k < 8; ++k) v[bj][k] = silu(v[bj][k]);
                    }
                    if (TYPE == T_MGA || TYPE == T_MGB) {
#pragma unroll
                        for (int k = 0; k < 8; ++k) v[bj][k] = sigm(v[bj][k]);
                    }
                    if ((TYPE == T_KB || TYPE == T_VB) && bo) { *(f32x4*)(bo + col) = (f32x4){v[bj][0], v[bj][1], v[bj][2], v[bj][3]}; *(f32x4*)(bo + col + 4) = (f32x4){v[bj][4], v[bj][5], v[bj][6], v[bj][7]}; }
                    if (TYPE == T_VA) {
                        bf16_t* p = dst + ((size_t)((row >> 6) * 4 + tcol) * 256 + 64 * wc + 32 * bj + 8 * fq) * 64 + (row & 63);
#pragma unroll
                        for (int k = 0; k < 8; k += 2) { const unsigned w = pk2(v[bj][k], v[bj][k + 1]); p[k * 64] = (bf16_t)w; p[(k + 1) * 64] = (bf16_t)(w >> 16); }
                    } else if (TYPE == T_VB) {
                        bf16_t* p = dst + ((size_t)(((row - rsub) >> 6) * 16 + tcol * 4 + wc) * 64 + 32 * bj + 8 * fq) * 64 + (row & 63);
#pragma unroll
                        for (int k = 0; k < 8; k += 2) { const unsigned w = pk2(v[bj][k], v[bj][k + 1]); p[k * 64] = (bf16_t)w; p[(k + 1) * 64] = (bf16_t)(w >> 16); }
                    } else
                    *(u32x4*)(dst + (size_t)(row - rsub) * ld + col) = pack8(v[bj]);
                }
                asm volatile("" ::: "memory");
            }
    }
    DI void operator()(const pg8::f32x4 (&acc)[2][2][4][2], const pg8::Unit& u, int wr, int wc, int fr, int fq) const {
        asm volatile("" : "+v"(fr), "+v"(fq));
        const int gt = tile0 + u.pn;
        if (gt < 2) run<T_QA>(acc, u.pm, gt, wr, wc, fr, fq);
        else if (gt < 4) run<T_KA>(acc, u.pm, gt - 2, wr, wc, fr, fq);
        else if (gt < 8) run<T_VA>(acc, u.pm, gt - 4, wr, wc, fr, fq);
        else if (gt < 12) run<T_GA>(acc, u.pm, gt - 8, wr, wc, fr, fq);
        else if (gt == 12) run<T_RA>(acc, u.pm, 0, wr, wc, fr, fq);
        else if (gt < 17) run<T_QB>(acc, u.pm, gt - 13, wr, wc, fr, fq);
        else if (gt < 21) run<T_KB>(acc, u.pm, gt - 17, wr, wc, fr, fq);
        else if (gt < 25) run<T_VB>(acc, u.pm, gt - 21, wr, wc, fr, fq);
        else if (gt < 29) run<T_GB>(acc, u.pm, gt - 25, wr, wc, fr, fq);
        else if (gt < 33) run<T_MGA>(acc, u.pm, gt - 29, wr, wc, fr, fq);
        else run<T_MGB>(acc, u.pm, gt - 33, wr, wc, fr, fq);
    }
};
#define EPI_ROWS_BEGIN _Pragma("unroll") for (int ai = 0; ai < 2; ++ai) _Pragma("unroll") for (int m = 0; m < 4; ++m) { asm volatile("" ::: "memory"); const int row = u.pm * 256 + ai * 128 + wr * 64 + m * 16 + fr;
#define EPI_COLS_BEGIN _Pragma("unroll") for (int bj = 0; bj < 2; ++bj) { const int col = u.pn * 256 + 64 * wc + 32 * bj + 8 * fq; float v[8]; \
    _Pragma("unroll") for (int n = 0; n < 2; ++n) _Pragma("unroll") for (int e = 0; e < 4; ++e) v[4 * n + e] = acc[ai][bj][m][n][e];
struct EpiYA {
    static constexpr bool PERM = false, AFTER_DRAIN = false; bf16_t* G; int dry; bf16_t* Gs;
    DI void operator()(const pg8::f32x4 (&acc)[2][2][4][2], const pg8::Unit& u, int wr, int wc, int fr, int fq) const {
        asm volatile("" : "+v"(fr), "+v"(fq));
        EPI_ROWS_BEGIN EPI_COLS_BEGIN
            bf16_t* p = G + (size_t)row * 1024 + col; float g[8]; unpack8(*(const u32x4*)p, g);
#pragma unroll
            for (int k = 0; k < 8; ++k) v[k] *= g[k];
            if (!dry) *(u32x4*)p = pack8(v);
        } }
    }
    DI void mini(int row, int col, f32x4 s) const {
        bf16_t* p = Gs + (size_t)(row - MP) * 1024 + col; const u32x2 g = *(const u32x2*)p;
        u32x2 w; w.x = pk2(s.x * bflo(g.x), s.y * bfhi(g.x)); w.y = pk2(s.z * bflo(g.y), s.w * bfhi(g.y)); if (!dry) *(u32x2*)p = w;
    }
};
struct EpiYB {
    static constexpr bool PERM = false, AFTER_DRAIN = false; const bf16_t* YA; bf16_t* G; int dry; const bf16_t* YAs; bf16_t* Gs;
    DI void operator()(const pg8::f32x4 (&acc)[2][2][4][2], const pg8::Unit& u, int wr, int wc, int fr, int fq) const {
        asm volatile("" : "+v"(fr), "+v"(fq));
        EPI_ROWS_BEGIN EPI_COLS_BEGIN
            bf16_t* p = G + (size_t)row * 1024 + col; float g[8], ya[8]; unpack8(*(const u32x4*)p, g); unpack8(*(const u32x4*)(YA + (size_t)row * 1024 + col), ya);
#pragma unroll
            for (int k = 0; k < 8; ++k) v[k] = ya[k] + v[k] * g[k];
            if (!dry) *(u32x4*)p = pack8(v);
        } }
    }
    DI void mini(int row, int col, f32x4 s) const {
        bf16_t* p = Gs + (size_t)(row - MP) * 1024 + col; const u32x2 g = *(const u32x2*)p, y = *(const u32x2*)(YAs + (size_t)(row - MP) * 1024 + col);
        u32x2 w; w.x = pk2(bflo(y.x) + s.x * bflo(g.x), bfhi(y.x) + s.y * bfhi(g.x)); w.y = pk2(bflo(y.y) + s.z * bflo(g.y), bfhi(y.y) + s.w * bfhi(g.y)); if (!dry) *(u32x2*)p = w;
    }
};
struct EpiOut {
    static constexpr bool PERM = false, AFTER_DRAIN = false; const float* xp; const float* xs; float* out; bf16_t* xb; float* sq; int dry;
    DI void operator()(const pg8::f32x4 (&acc)[2][2][4][2], const pg8::Unit& u, int wr, int wc, int fr, int fq) const {
        asm volatile("" : "+v"(fr), "+v"(fq));
        EPI_ROWS_BEGIN
            const float* base = row < MP ? xp + (size_t)row * 1024 : xs + (size_t)(row - MP) * 1024; float ss = 0.f;
            EPI_COLS_BEGIN
                const f32x4 b0 = *(const f32x4*)(base + col), b1 = *(const f32x4*)(base + col + 4);
                v[0] += b0.x; v[1] += b0.y; v[2] += b0.z; v[3] += b0.w; v[4] += b1.x; v[5] += b1.y; v[6] += b1.z; v[7] += b1.w;
#pragma unroll
                for (int k = 0; k < 8; ++k) ss += v[k] * v[k];
                if (!dry) { float* o = out + (size_t)row * 1024 + col; *(f32x4*)o = (f32x4){v[0], v[1], v[2], v[3]}; *(f32x4*)(o + 4) = (f32x4){v[4], v[5], v[6], v[7]};
                *(u32x4*)(xb + (size_t)row * 1024 + col) = pack8(v); }
            }
            ss += __shfl_xor(ss, 16); ss += __shfl_xor(ss, 32);
            if (fq == 0 && !dry) sq[(size_t)row * 16 + 4 * u.pn + wc] = ss;
        }
    }
    DI void mini(int row, int col, f32x4 s) const {
        const float* base = row < MP ? xp + (size_t)row * 1024 : xs + (size_t)(row - MP) * 1024; const f32x4 b0 = *(const f32x4*)(base + col);
        const f32x4 x = s + b0; float ss = (x.x * x.x + x.y * x.y) + (x.z * x.z + x.w * x.w);
        ss += __shfl_xor(ss, 1); ss += __shfl_xor(ss, 2); ss += __shfl_xor(ss, 4); ss += __shfl_xor(ss, 8);
        if (!dry) { *(f32x4*)(out + (size_t)row * 1024 + col) = x; u32x2 w; w.x = pk2(x.x, x.y); w.y = pk2(x.z, x.w); *(u32x2*)(xb + (size_t)row * 1024 + col) = w;
            if ((col & 63) == 0) sq[(size_t)row * 16 + (col >> 6)] = ss; }
    }
};
struct EpiP {
    static constexpr bool PERM = false, AFTER_DRAIN = false; float* PT; int dry;
    DI void operator()(const pg8::f32x4 (&acc)[2][2][4][2], const pg8::Unit& u, int wr, int wc, int fr, int fq) const {
        asm volatile("" : "+v"(fr), "+v"(fq));
        EPI_ROWS_BEGIN EPI_COLS_BEGIN
            if (!dry) { float* o = PT + (size_t)row * 1024 + col; *(f32x4*)o = (f32x4){v[0], v[1], v[2], v[3]}; *(f32x4*)(o + 4) = (f32x4){v[4], v[5], v[6], v[7]}; }
        } }
    }
    DI void mini(int row, int col, f32x4 s) const { if (!dry) *(f32x4*)(PT + (size_t)row * 1024 + col) = s; }
};
struct EpiGate {
    static constexpr bool PERM = false, AFTER_DRAIN = false; const float* sq1; const float* PT; float* out; bf16_t* xb; float* sq2; int dry;
    DI void operator()(const pg8::f32x4 (&acc)[2][2][4][2], const pg8::Unit& u, int wr, int wc, int fr, int fq) const {
        asm volatile("" : "+v"(fr), "+v"(fq));
        EPI_ROWS_BEGIN
            const float rs = row_rstd(sq1, row); float ss = 0.f;
            EPI_COLS_BEGIN
                float* o = out + (size_t)row * 1024 + col; const float* pt = PT + (size_t)row * 1024 + col;
                const f32x4 b0 = *(const f32x4*)o, b1 = *(const f32x4*)(o + 4), p0 = *(const f32x4*)pt, p1 = *(const f32x4*)(pt + 4);
                const float xb_[8] = {b0.x, b0.y, b0.z, b0.w, b1.x, b1.y, b1.z, b1.w}, pp[8] = {p0.x, p0.y, p0.z, p0.w, p1.x, p1.y, p1.z, p1.w};
#pragma unroll
                for (int k = 0; k < 8; ++k) { v[k] = xb_[k] + sigm(v[k] * rs) * pp[k]; ss += v[k] * v[k]; }
                if (!dry) { *(f32x4*)o = (f32x4){v[0], v[1], v[2], v[3]}; *(f32x4*)(o + 4) = (f32x4){v[4], v[5], v[6], v[7]};
                *(u32x4*)(xb + (size_t)row * 1024 + col) = pack8(v); }
            }
            ss += __shfl_xor(ss, 16); ss += __shfl_xor(ss, 32);
            if (fq == 0 && !dry) sq2[(size_t)row * 16 + 4 * u.pn + wc] = ss;
        }
    }
    DI void mini(int row, int col, f32x4 s) const {
        const float rs = row_rstd(sq1, row); float* o = out + (size_t)row * 1024 + col; const f32x4 b0 = *(const f32x4*)o, p0 = *(const f32x4*)(PT + (size_t)row * 1024 + col);
        f32x4 x; x.x = b0.x + sigm(s.x * rs) * p0.x; x.y = b0.y + sigm(s.y * rs) * p0.y; x.z = b0.z + sigm(s.z * rs) * p0.z; x.w = b0.w + sigm(s.w * rs) * p0.w;
        float ss = (x.x * x.x + x.y * x.y) + (x.z * x.z + x.w * x.w);
        ss += __shfl_xor(ss, 1); ss += __shfl_xor(ss, 2); ss += __shfl_xor(ss, 4); ss += __shfl_xor(ss, 8);
        if (!dry) { *(f32x4*)o = x; u32x2 w; w.x = pk2(x.x, x.y); w.y = pk2(x.z, x.w); *(u32x2*)(xb + (size_t)row * 1024 + col) = w;
            if ((col & 63) == 0) sq2[(size_t)row * 16 + (col >> 6)] = ss; }
    }
};

struct OrderG {
    pg8::StaticOrder S; int G, c;
    DI void init(int G_, int c_) { S.init(MP, 13 * 256, G_, c_); G = G_; c = c_; }
    DI bool next(int i, pg8::Unit& u) const { if (S.next(i, u)) return true; const long s = (long)i * G + c - 64 * 13; if (s >= 2 * NWIN_T) return false; u.pm = 64 + (int)(s / NWIN_T); u.pn = (int)(s % NWIN_T); return true; }
    DI void a_ready(const pg8::Unit&) const {}
    DI void done(const pg8::Unit&) const {}
};
struct OrderM {
    pg8::StaticOrder S;
    DI void init(int G_, int c_) { S.init(MP, 1024, G_, c_); }
    DI bool next(int i, pg8::Unit& u) const { pg8::Unit v; if (!S.next(i >> 1, v)) return false; u.pm = v.pm; u.pn = 4 * (i & 1) + v.pn; return true; }
    DI void a_ready(const pg8::Unit&) const {}
    DI void done(const pg8::Unit&) const {}
};
template <class Epi> DI void run_gemm_m(LAS unsigned char* lds, const bf16_t* A, const bf16_t* Bt, const Epi& E) {
    int K = 1024; asm volatile("" : "+s"(K));
    pg8::Gemm g{A, Bt, MP, 8 * 256, K}; OrderM S; S.init((int)gridDim.x, (int)blockIdx.x);
    pg8::gemm_phase<Epi, OrderM, true, true>(lds, g, S, E);
}
template <class Epi> DI void run_gemm_g(LAS unsigned char* lds, const bf16_t* A, const bf16_t* Bt, const Epi& E) {
    int K = 1024; asm volatile("" : "+s"(K));
    pg8::Gemm g{A, Bt, MT, NWIN_T * 256, K}; OrderG S; S.init((int)gridDim.x, (int)blockIdx.x);
    pg8::gemm_phase<Epi, OrderG, true, true>(lds, g, S, E);
}
template <class Epi> DI void run_gemm(LAS unsigned char* lds, const bf16_t* A, const bf16_t* Bt, int M, int N, int K, const Epi& E) {
    asm volatile("" : "+s"(K), "+s"(N));
    pg8::Gemm g{A, Bt, M, N, K}; pg8::StaticOrder S; S.init(M, N, (int)gridDim.x, (int)blockIdx.x);
    pg8::gemm_phase<Epi, pg8::StaticOrder, true, true>(lds, g, S, E);
}

template <int K, class Epi> DI void mini_gemm(LAS unsigned char* lds, const bf16_t* A, const bf16_t* Wt, const Epi& E) {
    const int tid = otid(), lane = tid & 63, wave = __builtin_amdgcn_readfirstlane(tid >> 6), r = lane & 15, q = lane >> 4;
    constexpr int KW = K / 8;
    for (int mt = blockIdx.x; mt < 256; mt += gridDim.x) {
        const int row0 = 32 * (mt >> 4), cb = mt & 15, tile = cb >> 2, wcp = cb & 3, k0 = wave * KW;
        f32x4 acc[4][2];
#pragma unroll
        for (int ct = 0; ct < 4; ++ct) { acc[ct][0] = (f32x4){0.f, 0.f, 0.f, 0.f}; acc[ct][1] = (f32x4){0.f, 0.f, 0.f, 0.f}; }
#pragma unroll
        for (int ks = 0; ks < KW / 32; ++ks) {
            bf16x8 af[2], wf[4];
#pragma unroll
            for (int rt = 0; rt < 2; ++rt) af[rt] = *(const bf16x8*)(A + (size_t)(row0 + 16 * rt + r) * K + k0 + 32 * ks + 8 * q);
#pragma unroll
            for (int ct = 0; ct < 4; ++ct) { const int x = 16 * ct + r, p = 128 * (x >> 5) + 32 * wcp + 16 * ((x >> 2) & 1) + 4 * ((x >> 3) & 3) + (x & 3);
                wf[ct] = *(const bf16x8*)(Wt + (size_t)(tile * 256 + p) * K + k0 + 32 * ks + 8 * q); }
#pragma unroll
            for (int ct = 0; ct < 4; ++ct)
#pragma unroll
                for (int rt = 0; rt < 2; ++rt) acc[ct][rt] = __builtin_amdgcn_mfma_f32_16x16x32_bf16(wf[ct], af[rt], acc[ct][rt], 0, 0, 0);
        }
        LAS float* part = (LAS float*)lds + wave * (32 * 68);
#pragma unroll
        for (int ct = 0; ct < 4; ++ct)
#pragma unroll
            for (int rt = 0; rt < 2; ++rt) *(LAS f32x4*)(part + (16 * rt + r) * 68 + 16 * ct + 4 * q) = acc[ct][rt];
        __syncthreads();
        { const int row = tid >> 4, c4 = (tid & 15) * 4; f32x4 s = (f32x4){0.f, 0.f, 0.f, 0.f};
#pragma unroll
          for (int w = 0; w < 8; ++w) s += *(const LAS f32x4*)((const LAS float*)lds + w * (32 * 68) + row * 68 + c4);
          E.mini(MP + row0 + row, 64 * cb + c4, s); }
        __syncthreads();
    }
}

struct Args { const float* in[21]; float* out; unsigned char* ws; int ph_lo, ph_hi; };
static_assert(sizeof(Args) == 192, "Args layout (kin/kout/kws offsets)");
enum { I_XP = 0, I_XS, I_STATE, I_CK, I_CV, I_PP, I_PS, I_NORMG, I_WIN, I_WGU, I_BG, I_GLAG, I_QG, I_KG, I_RELB, I_WA, I_WB, I_WO, I_PLEG, I_WPG, I_WPLE };

DI void transpose_item(const float* W, int ldw, int srccol0, int nvalid, const float* gain, bf16_t* WT, int K, int rowbase, int k0, LAS float* scr, int lane) {
    f32x4 wv[8];
#pragma unroll
    for (int i = 0; i < 8; ++i) { const int idx = lane + 64 * i, kk = idx >> 3, c4 = (idx & 7) * 4;
        wv[i] = (f32x4){0.f, 0.f, 0.f, 0.f}; if (c4 < nvalid) wv[i] = __builtin_nontemporal_load((const f32x4*)(W + (size_t)(k0 + kk) * ldw + srccol0 + c4)); }
#pragma unroll
    for (int i = 0; i < 8; ++i) { const int idx = lane + 64 * i, kk = idx >> 3, c4 = (idx & 7) * 4; const float gk = gain ? gain[k0 + kk] : 1.f;
        scr[kk * 33 + c4] = wv[i].x * gk; scr[kk * 33 + c4 + 1] = wv[i].y * gk; scr[kk * 33 + c4 + 2] = wv[i].z * gk; scr[kk * 33 + c4 + 3] = wv[i].w * gk; }
    asm volatile("s_waitcnt lgkmcnt(0)" ::: "memory");
    const int c8 = lane & 7;
#pragma unroll
    for (int j = 0; j < 4; ++j) { const int n = (lane >> 3) + 8 * j; const LAS float* s = scr + (8 * c8) * 33 + n;
        u32x4 o; o.x = pk2(s[0 * 33], s[1 * 33]); o.y = pk2(s[2 * 33], s[3 * 33]); o.z = pk2(s[4 * 33], s[5 * 33]); o.w = pk2(s[6 * 33], s[7 * 33]);
        const int prow = 16 * ((n >> 2) & 1) + 4 * (n >> 3) + (n & 3);
        *(u32x4*)(WT + (size_t)(rowbase + prow) * K + k0 + 8 * c8) = o; }
    asm volatile("s_waitcnt lgkmcnt(0)" ::: "memory");
}
DI int win_src(int t, int& nvalid) {
    nvalid = 256;
    if (t < 2) return t * 256; if (t < 4) return 512 + (t - 2) * 256; if (t < 8) return 1024 + (t - 4) * 256; if (t < 12) return 2064 + (t - 8) * 256;
    if (t == 12) { nvalid = 16; return 2048; }
    if (t < 17) return 3088 + (t - 13) * 256; if (t < 21) return 4112 + (t - 17) * 256; if (t < 25) return 5136 + (t - 21) * 256; if (t < 29) return 6160 + (t - 25) * 256;
    if (t < 33) return 7184 + (t - 29) * 256; return 8208 + (t - 33) * 256;
}
DI void transpose_generic(const float* W, int ldw, int K, int ntile, bool is_win, const float* gain, bf16_t* WT, int item, LAS float* scr, int lane) {
    const int nkb = K / 64; const int kb = item % nkb, nb = (item / nkb) & 7, t = item / (nkb * 8);
    int nvalid = 256, src = t * 256; if (is_win) src = win_src(t, nvalid);
    int nv = nvalid - 32 * nb; nv = nv < 0 ? 0 : (nv > 32 ? 32 : nv);
    transpose_item(W, ldw, src + 32 * nb, nv, gain, WT, K, t * 256 + 128 * (nb & 1) + 32 * (nb >> 1), kb * 64, scr, lane);
}
constexpr int WIN_ITEMS = NWIN_T * 8 * 16, SQ_ITEMS = 4 * 8 * 16, PLE_ITEMS = 4 * 8 * 4;
constexpr int N_IN = 9232;
DI void prep_win(const Args& a, int L, int gw, int ngw, LAS float* scr, int lane) {
    bf16_t* WT = (bf16_t*)(kws() + WS_WIN);
    for (int it = gw; it < WIN_ITEMS; it += ngw) transpose_generic(kin(I_WIN) + (size_t)L * 1024 * N_IN, N_IN, 1024, NWIN_T, true, kin(I_NORMG) + L * 1024, WT, it, scr, lane);
}
DI bf16_t* wsm(const Args& a, int L, int which) { return (bf16_t*)(kws() + WS_WSM + (size_t)L * WSM_LAYER + (size_t)which * 2 * MiB); }
DI void prep_small(const Args& a, int gw, int ngw, LAS float* scr, int lane) {
    constexpr int PER_L = 4 * SQ_ITEMS + PLE_ITEMS;
    for (int it = gw; it < 2 * PER_L; it += ngw) {
        const int L = it / PER_L; int r = it % PER_L;
        if (r < SQ_ITEMS) { transpose_generic(kin(I_WA) + (size_t)L * 1048576, 1024, 1024, 4, false, nullptr, wsm(a, L, 0), r, scr, lane); continue; } r -= SQ_ITEMS;
        if (r < SQ_ITEMS) { transpose_generic(kin(I_WB) + (size_t)L * 1048576, 1024, 1024, 4, false, nullptr, wsm(a, L, 1), r, scr, lane); continue; } r -= SQ_ITEMS;
        if (r < SQ_ITEMS) { transpose_generic(kin(I_WO) + (size_t)L * 1048576, 1024, 1024, 4, false, nullptr, wsm(a, L, 2), r, scr, lane); continue; } r -= SQ_ITEMS;
        if (r < SQ_ITEMS) { transpose_generic(kin(I_WPG) + (size_t)L * 1048576, 1024, 1024, 4, false, kin(I_PLEG) + L * 1024, wsm(a, L, 3), r, scr, lane); continue; } r -= SQ_ITEMS;
        transpose_generic(kin(I_WPLE) + (size_t)L * 262144, 1024, 256, 4, false, nullptr, wsm(a, L, 4), r, scr, lane);
    }
}
DI float wave_sum(float v) {
#pragma unroll
    for (int o = 1; o < 64; o <<= 1) v += __shfl_xor(v, o);
    return v;
}
DI void prep_shift(int gw, int lane) {
    if (gw < 32) { const int L = gw >> 4, h = gw & 15;
        float mq = fabsf(kin(I_QG)[L * 64 + lane]), mk = fabsf(kin(I_KG)[L * 64 + lane]), mb = 0.f;
        for (int i = lane; i < 257; i += 64) mb = fmaxf(mb, fabsf(kin(I_RELB)[((size_t)L * 16 + h) * 257 + i]));
#pragma unroll
        for (int o = 1; o < 64; o <<= 1) { mq = fmaxf(mq, __shfl_xor(mq, o)); mk = fmaxf(mk, __shfl_xor(mk, o)); mb = fmaxf(mb, __shfl_xor(mb, o)); }
        if (lane == 0) ((float*)(kws() + WS_MSH))[gw] = (8.f * mq * mk + mb) * LOG2E; }
}
DI void prep_rows(const Args& a, int gw, int ngw, int lane) {
    bf16_t* XB = (bf16_t*)(kws() + WS_XB); float* SQ2 = (float*)(kws() + WS_SQ2);
    const float* xp = kin(I_XP); const float* xs = kin(I_XS);
    for (int row0 = gw; row0 < MT; row0 += 4 * ngw) {
        f32x4 v[4][4];
#pragma unroll
        for (int u = 0; u < 4; ++u) { const int row = row0 + u * ngw; if (row < MT) { const float* x = row < MP ? xp + (size_t)row * 1024 : xs + (size_t)(row - MP) * 1024;
#pragma unroll
            for (int j = 0; j < 4; ++j) v[u][j] = __builtin_nontemporal_load((const f32x4*)x + lane + 64 * j); } }
#pragma unroll
        for (int u = 0; u < 4; ++u) { const int row = row0 + u * ngw; if (row < MT) { float s = 0.f;
#pragma unroll
            for (int j = 0; j < 4; ++j) s += (v[u][j].x * v[u][j].x + v[u][j].y * v[u][j].y) + (v[u][j].z * v[u][j].z + v[u][j].w * v[u][j].w);
            s = wave_sum(s);
            if (lane < 16) SQ2[(size_t)row * 16 + lane] = lane == 0 ? s : 0.f;
#pragma unroll
            for (int j = 0; j < 4; ++j) { u32x2 w; w.x = pk2(v[u][j].x, v[u][j].y); w.y = pk2(v[u][j].z, v[u][j].w); ((u32x2*)(XB + (size_t)row * 1024))[lane + 64 * j] = w; } } }
    }
}
DI void prep_misc(const Args& a, int gtid, int ngt) {
    bf16_t* PB = (bf16_t*)(kws() + WS_PB);
    const float* pp = kin(I_PP); const float* ps = kin(I_PS);
    for (int i0 = gtid; i0 < 2 * MT * 32; i0 += 4 * ngt) {
        f32x4 p0[4], p1[4];
#pragma unroll
        for (int k = 0; k < 4; ++k) { const int i = i0 + k * ngt; if (i < 2 * MT * 32) { const int c8 = i & 31, row = (i >> 5) % MT, L = (i >> 5) / MT;
            const float* src = row < MP ? pp + ((size_t)L * MP + row) * 256 + c8 * 8 : ps + ((size_t)L * MS + (row - MP)) * 256 + c8 * 8; p0[k] = __builtin_nontemporal_load((const f32x4*)src); p1[k] = __builtin_nontemporal_load((const f32x4*)(src + 4)); } }
#pragma unroll
        for (int k = 0; k < 4; ++k) { const int i = i0 + k * ngt; if (i < 2 * MT * 32) { const int c8 = i & 31, row = (i >> 5) % MT, L = (i >> 5) / MT;
            u32x4 w; w.x = pk2(p0[k].x, p0[k].y); w.y = pk2(p0[k].z, p0[k].w); w.z = pk2(p1[k].x, p1[k].y); w.w = pk2(p1[k].z, p1[k].w);
            *(u32x4*)(PB + ((size_t)L * MT + row) * 256 + c8 * 8) = w; } }
    }
    constexpr int PER = 448 * 1024 / 4;
    const float* ck = kin(I_CK); const float* cv = kin(I_CV); float* out = kout();
    for (int i0 = gtid; i0 < 32 * PER; i0 += 8 * ngt) {
        f32x4 v[8];
#pragma unroll
        for (int k = 0; k < 8; ++k) { const int i = i0 + k * ngt; if (i < 32 * PER) { const int lb = i / PER, r = i % PER, kv = lb >> 4, l_b = lb & 15;
            v[k] = __builtin_nontemporal_load((const f32x4*)((kv ? cv : ck) + (size_t)l_b * 512 * 1024 + 64 * 1024) + r); } }
#pragma unroll
        for (int k = 0; k < 8; ++k) { const int i = i0 + k * ngt; if (i < 32 * PER) { const int lb = i / PER, r = i % PER, kv = lb >> 4, l_b = lb & 15;
            __builtin_nontemporal_store(v[k], (f32x4*)(out + (kv ? O_VS : O_KS) + (size_t)l_b * 512 * 1024) + r); } }
    }
}

DI void gla_prep(const Args& a, int L, int c, int h, LAS float* totp, LAS float* ra_s, float (&b)[16], float& blast) {
    const int tid = otid(), d = tid & 127, jq = __builtin_amdgcn_readfirstlane(tid >> 7);
    if (tid < 256) *(LAS f32x4*)(ra_s + tid * 4) = *(const f32x4*)((const float*)(kws() + WS_RA) + (size_t)c * 64 * 16 + tid * 4);
    const float* wg = kin(I_WGU) + (size_t)L * 16 * 512 + h * 128 + d; float w[16];
#pragma unroll
    for (int r = 0; r < 16; ++r) w[r] = wg[r * 512];
    const float bg = kin(I_BG)[L * 512 + h * 128 + d];
    __syncthreads();
    float run = 0.f;
#pragma unroll
    for (int jj = 0; jj < 16; ++jj) {
        const LAS f32x4* rp = (const LAS f32x4*)(ra_s + (16 * jq + jj) * 16); const f32x4 r0 = rp[0], r1 = rp[1], r2 = rp[2], r3 = rp[3];
        float r = bg;
        r += r0.x * w[0]; r += r0.y * w[1]; r += r0.z * w[2]; r += r0.w * w[3]; r += r1.x * w[4]; r += r1.y * w[5]; r += r1.z * w[6]; r += r1.w * w[7];
        r += r2.x * w[8]; r += r2.y * w[9]; r += r2.z * w[10]; r += r2.w * w[11]; r += r3.x * w[12]; r += r3.y * w[13]; r += r3.z * w[14]; r += r3.w * w[15];
        const float lg = (fminf(r, 0.f) - __logf(1.f + __expf(-fabsf(r)))) * (1.f / 16.f);
        run += lg; b[jj] = run;
    }
    totp[jq * 128 + d] = run;
    __syncthreads();
    const float t0 = totp[d], t1 = totp[128 + d], t2 = totp[256 + d], t3 = totp[384 + d];
    const float off = jq == 0 ? 0.f : jq == 1 ? t0 : jq == 2 ? t0 + t1 : t0 + t1 + t2;
    blast = (t0 + t1) + (t2 + t3);
#pragma unroll
    for (int jj = 0; jj < 16; ++jj) b[jj] += off;
    if (jq == 0) totp[512 + d] = blast;
}
DI bf16x8 lds16(const LAS unsigned char* p) { return *(const LAS bf16x8*)p; }
DI s16x4 lds8(const LAS unsigned char* p) { return *(const LAS s16x4*)p; }
DI void vt_load(const bf16_t* VT, u32x4 (&vr)[4]) {
    const int tid = otid();
#pragma unroll
    for (int k = 0; k < 4; ++k) vr[k] = *(const u32x4*)(VT + (size_t)(tid + 512 * k) * 8);
}
DI void vt_store(const u32x4 (&vr)[4], LAS unsigned char* vt) {
    const int tid = otid();
#pragma unroll
    for (int k = 0; k < 4; ++k) { const int i = tid + 512 * k; *(LAS u32x4*)(vt + ((i >> 3) * 72 + (i & 7) * 8) * 2) = vr[k]; }
}
constexpr int GA_KT = 0, GA_VT = 18432, GA_TOT = 55296;
DI void gla_a_phase(const Args& a, int L, LAS unsigned char* lds, int item_lo, int item_hi, int first_wg) {
    const int tid = otid(), lane = tid & 63, wave = __builtin_amdgcn_readfirstlane(tid >> 6), r = lane & 15, q = lane >> 4;
    const bf16_t* KA = (const bf16_t*)(kws() + WS_OV + 2 * SLOT) + (size_t)MT * 512; const bf16_t* VA = (const bf16_t*)(kws() + WS_OV + 1 * SLOT);
    bf16_t* ST = (bf16_t*)(kws() + WS_OV + 3 * SLOT); float* DC = (float*)(kws() + WS_DC);
    LAS float* totp = (LAS float*)(lds + GA_TOT);
    int wg0_ = (int)blockIdx.x - first_wg; if (wg0_ < 0) wg0_ += (int)gridDim.x;
    for (int item = item_lo + wg0_; item < item_hi; item += gridDim.x) {
        const int c = item >> 2, h = item & 3;
        const int d = tid & 127, jq = tid >> 7;
        bf16_t kraw[16]; u32x4 vr[4];
#pragma unroll
        for (int jj = 0; jj < 16; ++jj) kraw[jj] = KA[((size_t)c * 64 + 16 * jq + jj) * 512 + h * 128 + d];
        vt_load(VA + (size_t)(c * 4 + h) * 16384, vr);
        float b[16], blast; gla_prep(a, L, c, h, totp, (LAS float*)(lds + GA_VT), b, blast);
        { float kd[16];
#pragma unroll
          for (int jj = 0; jj < 16; ++jj) kd[jj] = bf2f(kraw[jj]) * __expf(blast - b[jj]);
          LAS u32x4* o = (LAS u32x4*)(lds + GA_KT + (d * 72 + 16 * jq) * 2); o[0] = pack8(kd); o[1] = pack8(kd + 8); }
        if (jq == 0) DC[(size_t)item * 128 + d] = __expf(blast);
        vt_store(vr, lds + GA_VT);
        __syncthreads();
        f32x4 acc[8][2];
#pragma unroll
        for (int dt = 0; dt < 8; ++dt) { acc[dt][0] = (f32x4){0.f, 0.f, 0.f, 0.f}; acc[dt][1] = (f32x4){0.f, 0.f, 0.f, 0.f}; }
#pragma unroll
        for (int s = 0; s < 2; ++s) {
            bf16x8 bv[2];
#pragma unroll
            for (int vt = 0; vt < 2; ++vt) bv[vt] = lds16(lds + GA_VT + ((32 * wave + 16 * vt + r) * 72 + 32 * s + 8 * q) * 2);
#pragma unroll
            for (int dt = 0; dt < 8; ++dt) { const bf16x8 ak = lds16(lds + GA_KT + ((16 * dt + r) * 72 + 32 * s + 8 * q) * 2);
#pragma unroll
                for (int vt = 0; vt < 2; ++vt) acc[dt][vt] = __builtin_amdgcn_mfma_f32_16x16x32_bf16(ak, bv[vt], acc[dt][vt], 0, 0, 0); }
        }
        if (c < NPC) {
#pragma unroll
            for (int vt = 0; vt < 2; ++vt)
#pragma unroll
                for (int dt = 0; dt < 8; ++dt) { u32x2 w; w.x = pk2(acc[dt][vt][0], acc[dt][vt][1]); w.y = pk2(acc[dt][vt][2], acc[dt][vt][3]);
                    *(u32x2*)(ST + (size_t)item * 32768 + (32 * wave + 16 * vt + r) * 128 + 16 * dt + 4 * q) = w; }
        } else {
            const int bb = c - NPC; const size_t so = (((size_t)L * 8 + bb) * 4 + h) * 32768;
            const float* s0 = kin(I_STATE) + so; float* s1 = kout() + O_SS + so;
#pragma unroll
            for (int dt = 0; dt < 8; ++dt)
#pragma unroll
                for (int e = 0; e < 4; ++e) { const int dd = 16 * dt + 4 * q + e; const float dc = __expf(totp[512 + dd]);
#pragma unroll
                    for (int vt = 0; vt < 2; ++vt) { const int v = 32 * wave + 16 * vt + r; s1[dd * 256 + v] = dc * s0[dd * 256 + v] + acc[dt][vt][e]; } }
        }
        __syncthreads();
    }
}
template <int NG> DI void gla_scan_gts(int L, int dry, const int (&gts)[NG], bf16_t* ST, const float* DC) {
    int e4[NG], bb[NG], h[NG], d[NG]; float run[NG][4];
#pragma unroll
    for (int g = 0; g < NG; ++g) { const int bh = gts[g] >> 13; e4[g] = gts[g] & 8191; bb[g] = bh >> 2; h[g] = bh & 3; d[g] = (4 * e4[g]) & 127; run[g][0] = run[g][1] = run[g][2] = run[g][3] = 0.f; }
    for (int n0 = 0; n0 < 64; n0 += 8) {
        u32x2 cur[NG][8]; f32x4 dc[NG][8];
#pragma unroll
        for (int g = 0; g < NG; ++g)
#pragma unroll
            for (int k = 0; k < 8; ++k) { const size_t it = (size_t)(bb[g] * 64 + n0 + k) * 4 + h[g]; cur[g][k] = *(const u32x2*)(ST + it * 32768 + 4 * e4[g]); dc[g][k] = *(const f32x4*)(DC + it * 128 + d[g]); }
#pragma unroll
        for (int g = 0; g < NG; ++g)
#pragma unroll
            for (int k = 0; k < 8; ++k) { const size_t it = (size_t)(bb[g] * 64 + n0 + k) * 4 + h[g];
                u32x2 w; w.x = pk2(run[g][0], run[g][1]); w.y = pk2(run[g][2], run[g][3]); if (!dry || run[g][0] == 1.2345e30f) *(u32x2*)(ST + it * 32768 + 4 * e4[g]) = w;
                run[g][0] = dc[g][k].x * run[g][0] + bflo(cur[g][k].x); run[g][1] = dc[g][k].y * run[g][1] + bfhi(cur[g][k].x); run[g][2] = dc[g][k].z * run[g][2] + bflo(cur[g][k].y); run[g][3] = dc[g][k].w * run[g][3] + bfhi(cur[g][k].y); }
    }
#pragma unroll
    for (int g = 0; g < NG; ++g) { float* o = kout() + O_SP + (((size_t)L * 4 + bb[g]) * 4 + h[g]) * 32768; const int v = (4 * e4[g]) >> 7;
#pragma unroll
        for (int e = 0; e < 4; ++e) if (!dry || run[g][e] == 1.2345e30f) o[(d[g] + e) * 256 + v] = run[g][e]; }
}
DI void gla_scan_phase(const Args& a, int L, int dry) {
    bf16_t* ST = (bf16_t*)(kws() + WS_OV + 3 * SLOT); const float* DC = (const float*)(kws() + WS_DC);
    const int w = (int)blockIdx.x, G = (int)gridDim.x, tid = otid();
    if (G == 256) {
        if (w >= 128) { const int gts[2] = {(w - 128) * NTHREADS + tid, 65536 + (w - 128) * NTHREADS + tid}; gla_scan_gts<2>(L, dry, gts, ST, DC); }
    } else {
        for (int gt = w * NTHREADS + tid; gt < 16 * 8192; gt += G * NTHREADS) { const int gts[1] = {gt}; gla_scan_gts<1>(L, dry, gts, ST, DC); }
    }
}
constexpr int GC_QS = 0, GC_KS = 17408, GC_VT = 34816, GC_SS = 71680, GC_TOT = 141312, GC_RED = 143872;
DI void gla_c_phase(const Args& a, int L, LAS unsigned char* lds, int dry, int item_lo, int item_hi, int first_wg) {
    const int tid = otid(), lane = tid & 63, wave = __builtin_amdgcn_readfirstlane(tid >> 6), r = lane & 15, q = lane >> 4, it = wave & 3, vh = wave >> 2;
    const bf16_t* QA = (const bf16_t*)(kws() + WS_OV + 2 * SLOT); const bf16_t* KA = QA + (size_t)MT * 512; const bf16_t* VA = (const bf16_t*)(kws() + WS_OV + 1 * SLOT);
    bf16_t* SGA = (bf16_t*)(kws() + WS_OV); const bf16_t* ST = (const bf16_t*)(kws() + WS_OV + 3 * SLOT);
    LAS float* totp = (LAS float*)(lds + GC_TOT); LAS float* red = (LAS float*)(lds + GC_RED);
    const float* gg = kin(I_GLAG) + L * 256;
    int wg0_ = (int)blockIdx.x - first_wg; if (wg0_ < 0) wg0_ += (int)gridDim.x;
    for (int item = item_lo + wg0_; item < item_hi; item += gridDim.x) {
        const int c = item >> 2, h = item & 3;
        const int d = tid & 127, jq = tid >> 7;
        bf16_t qraw[16], kraw[16]; u32x4 vr[4], sr[8];
#pragma unroll
        for (int jj = 0; jj < 16; ++jj) { const size_t g = ((size_t)c * 64 + 16 * jq + jj) * 512 + h * 128 + d; qraw[jj] = QA[g]; kraw[jj] = KA[g]; }
        vt_load(VA + (size_t)(c * 4 + h) * 16384, vr);
        if (c < NPC) { const bf16_t* s = ST + (size_t)item * 32768;
#pragma unroll
            for (int k = 0; k < 8; ++k) sr[k] = *(const u32x4*)(s + (size_t)(tid + 512 * k) * 8); }
        float b[16], blast; gla_prep(a, L, c, h, totp, (LAS float*)(lds + GC_SS), b, blast);
#pragma unroll
        for (int jj = 0; jj < 16; ++jj) { const int j = 16 * jq + jj; const float eb = __expf(b[jj]);
            ((LAS bf16_t*)(lds + GC_QS))[j * 136 + d] = (bf16_t)pk2(bf2f(qraw[jj]) * eb, 0.f);
            ((LAS bf16_t*)(lds + GC_KS))[j * 136 + d] = (bf16_t)pk2(bf2f(kraw[jj]) * __builtin_amdgcn_rcpf(eb), 0.f); }
        vt_store(vr, lds + GC_VT);
        if (c < NPC) {
#pragma unroll
            for (int k = 0; k < 8; ++k) { const int i = tid + 512 * k, v = i >> 4, c8 = i & 15; *(LAS u32x4*)(lds + GC_SS + (v * 136 + c8 * 8) * 2) = sr[k]; }
        } else {
            const float* s0 = kin(I_STATE) + ((((size_t)L * 8 + (c - NPC)) * 4 + h) * 32768);
            for (int i = tid; i < 8192; i += NTHREADS) { const int dd = i & 127, v4 = i >> 7; const f32x4 s = *(const f32x4*)(s0 + dd * 256 + v4 * 4); LAS bf16_t* o = (LAS bf16_t*)(lds + GC_SS) + (v4 * 4) * 136 + dd;
                o[0] = (bf16_t)pk2(s.x, 0.f); o[136] = (bf16_t)pk2(s.y, 0.f); o[272] = (bf16_t)pk2(s.z, 0.f); o[408] = (bf16_t)pk2(s.w, 0.f); }
        }
        __syncthreads();
        bf16_t* orow = SGA + ((size_t)c * 64 + 16 * it + r) * 1024 + h * 256;
        u32x2 gate[8];
#pragma unroll
        for (int vt = 0; vt < 8; ++vt) gate[vt] = *(const u32x2*)(orow + 128 * vh + 16 * vt + 4 * q);
        bf16x8 bq[4];
#pragma unroll
        for (int ks = 0; ks < 4; ++ks) bq[ks] = lds16(lds + GC_QS + ((16 * it + r) * 136 + 32 * ks + 8 * q) * 2);
        f32x4 at[4];
#pragma unroll
        for (int jt = 0; jt < 4; ++jt) { at[jt] = (f32x4){0.f, 0.f, 0.f, 0.f};
            if (jt <= it) {
#pragma unroll
                for (int ks = 0; ks < 4; ++ks) at[jt] = __builtin_amdgcn_mfma_f32_16x16x32_bf16(lds16(lds + GC_KS + ((16 * jt + r) * 136 + 32 * ks + 8 * q) * 2), bq[ks], at[jt], 0, 0, 0);
                if (jt == it) {
#pragma unroll
                    for (int e = 0; e < 4; ++e) if (4 * q + e > r) at[jt][e] = 0.f;
                } } }
        bf16x8 bp[2];
#pragma unroll
        for (int s = 0; s < 2; ++s) { u32x4 w; w.x = pk2(at[2 * s][0], at[2 * s][1]); w.y = pk2(at[2 * s][2], at[2 * s][3]); w.z = pk2(at[2 * s + 1][0], at[2 * s + 1][1]); w.w = pk2(at[2 * s + 1][2], at[2 * s + 1][3]); bp[s] = __builtin_bit_cast(bf16x8, w); }
        f32x4 o[8];
#pragma unroll
        for (int vt = 0; vt < 8; ++vt) { o[vt] = (f32x4){0.f, 0.f, 0.f, 0.f}; const int v = 128 * vh + 16 * vt + r;
#pragma unroll
            for (int s = 0; s < 2; ++s) if (2 * s <= it) { const s16x4 lo = lds8(lds + GC_VT + (v * 72 + 32 * s + 4 * q) * 2), hi = lds8(lds + GC_VT + (v * 72 + 32 * s + 16 + 4 * q) * 2);
                const bf16x8 av = __builtin_shufflevector(lo, hi, 0, 1, 2, 3, 4, 5, 6, 7); o[vt] = __builtin_amdgcn_mfma_f32_16x16x32_bf16(av, bp[s], o[vt], 0, 0, 0); }
#pragma unroll
            for (int ks = 0; ks < 4; ++ks) o[vt] = __builtin_amdgcn_mfma_f32_16x16x32_bf16(lds16(lds + GC_SS + (v * 136 + 32 * ks + 8 * q) * 2), bq[ks], o[vt], 0, 0, 0); }
        float ss = 0.f;
#pragma unroll
        for (int vt = 0; vt < 8; ++vt) ss += (o[vt][0] * o[vt][0] + o[vt][1] * o[vt][1]) + (o[vt][2] * o[vt][2] + o[vt][3] * o[vt][3]);
        ss += __shfl_xor(ss, 16); ss += __shfl_xor(ss, 32);
        if (q == 0) red[vh * 64 + 16 * it + r] = ss;
        __syncthreads();
        const float rstd = rsqrtf((red[16 * it + r] + red[64 + 16 * it + r]) * (1.f / 256.f) + EPS);
#pragma unroll
        for (int vt = 0; vt < 8; ++vt) { const int v = 128 * vh + 16 * vt + 4 * q; const u32x2 g = gate[vt]; const f32x4 gn = *(const f32x4*)(gg + v);
            u32x2 w; w.x = pk2(o[vt][0] * rstd * gn.x * bflo(g.x), o[vt][1] * rstd * gn.y * bfhi(g.x)); w.y = pk2(o[vt][2] * rstd * gn.z * bflo(g.y), o[vt][3] * rstd * gn.w * bfhi(g.y));
            if (!dry || rstd == 1.2345e30f) *(u32x2*)(orow + v) = w; }
        __syncthreads();
    }
}

constexpr int AT_KS = 0, AT_VT = 36864, AT_BIAS = 73728, AT_BUF = 18432;
template <bool SAMPLE> DI void attn_load_k(int L, const bf16_t* KB, const float* ck, int bb, int n, int t, int hh, int sj, int sdq, u32x4& w0, u32x4& w1) {
    if (SAMPLE && t < 8) { const float* s = ck + (((size_t)L * 8 + bb) * 512 + t * 64 + sj) * 1024 + hh * 64 + 16 * sdq;
        const f32x4 f0 = *(const f32x4*)s, f1 = *(const f32x4*)(s + 4), f2 = *(const f32x4*)(s + 8), f3 = *(const f32x4*)(s + 12);
        w0.x = pk2(f0.x, f0.y); w0.y = pk2(f0.z, f0.w); w0.z = pk2(f1.x, f1.y); w0.w = pk2(f1.z, f1.w); w1.x = pk2(f2.x, f2.y); w1.y = pk2(f2.z, f2.w); w1.z = pk2(f3.x, f3.y); w1.w = pk2(f3.z, f3.w);
    } else { const size_t krow = SAMPLE ? (size_t)bb * 64 + sj : (size_t)bb * 4096 + (n - 8 + t) * 64 + sj; const bf16_t* s = KB + krow * 1024 + hh * 64 + 16 * sdq; w0 = *(const u32x4*)s; w1 = *(const u32x4*)(s + 8); }
}
template <bool SAMPLE> DI void attn_load_v(int L, const bf16_t* VBT, const float* cv, int bb, int n, int t, int hh, int tid, u32x4& w0, u32x4& w1) {
    if (SAMPLE && t < 8) { const int sj2 = tid & 63, dq2 = (tid >> 6) & 3; const float* s = cv + (((size_t)L * 8 + bb) * 512 + t * 64 + sj2) * 1024 + hh * 64 + 16 * dq2;
        const f32x4 f0 = *(const f32x4*)s, f1 = *(const f32x4*)(s + 4), f2 = *(const f32x4*)(s + 8), f3 = *(const f32x4*)(s + 12);
        w0.x = pk2(f0.x, f0.y); w0.y = pk2(f0.z, f0.w); w0.z = pk2(f1.x, f1.y); w0.w = pk2(f1.z, f1.w); w1.x = pk2(f2.x, f2.y); w1.y = pk2(f2.z, f2.w); w1.z = pk2(f3.x, f3.y); w1.w = pk2(f3.z, f3.w);
    } else { const int cc = SAMPLE ? bb : bb * 64 + (n - 8 + t); const bf16_t* s = VBT + ((size_t)cc * 16 + hh) * 4096 + (size_t)(tid & 255) * 8; w0 = *(const u32x4*)s; w1 = *(const u32x4*)(s + 2048); }
}
template <bool SAMPLE> DI void attn_item(const Args& a, int L, LAS unsigned char* lds, int dry, int item, bool stage_bias) {
    const int tid = otid(), lane = tid & 63, wave = __builtin_amdgcn_readfirstlane(tid >> 6), r = lane & 15, q = lane >> 4, g = wave >> 2, it = wave & 3;
    const bf16_t* QB = (const bf16_t*)(kws() + (SAMPLE ? WS_AX : WS_OV + 1 * SLOT)); const bf16_t* KB = (const bf16_t*)(kws() + (SAMPLE ? WS_AX + 1 * MiB : WS_OV + 2 * SLOT));
    const bf16_t* VB = (const bf16_t*)(kws() + (SAMPLE ? WS_AX + 2 * MiB : WS_OV + 3 * SLOT)); const bf16_t* GBs = (const bf16_t*)(kws() + (SAMPLE ? WS_AX + 3 * MiB : WS_OV + 4 * SLOT));
    bf16_t* SGB = (bf16_t*)(kws() + WS_OV + 4 * SLOT);
    const float* ck = kin(I_CK); const float* cv = kin(I_CV);
    LAS float* bias_s = (LAS float*)(lds + AT_BIAS);
    const int sg = tid >> 8, sj = (tid >> 2) & 63, sdq = tid & 3;
    const int c = item >> 3, hp = item & 7, h = 2 * hp + g;
    const int bb = SAMPLE ? c - NPC : c >> 6, n = SAMPLE ? 8 : c & 63, t0 = n >= 8 ? 0 : 8 - n;
    if (stage_bias) { const float* msh = (const float*)(kws() + WS_MSH) + L * 16 + 2 * hp;
    for (int i = tid; i < 2 * 257; i += NTHREADS) { const int g2 = i / 257, idx = i % 257; bias_s[g2 * 260 + idx] = kin(I_RELB)[((size_t)L * 16 + 2 * hp + g2) * 257 + idx] * LOG2E - msh[g2]; } }
    const size_t qrow = (size_t)c * 64 + 16 * it + r, qrl = SAMPLE ? qrow - MP : qrow;
    bf16x8 qf[2];
#pragma unroll
    for (int ks = 0; ks < 2; ++ks) qf[ks] = *(const bf16x8*)(QB + qrl * 1024 + h * 64 + 32 * ks + 8 * q);
    const int qi = 16 * it + r;
    bf16_t* orow = SGB + qrow * 1024 + h * 64;
    float l_run = 0.f;
    f32x4 o[4];
#pragma unroll
    for (int dt = 0; dt < 4; ++dt) o[dt] = (f32x4){0.f, 0.f, 0.f, 0.f};
    u32x4 k0, k1, v0, v1;
#define ATT_LOADT(T_) do { attn_load_k<SAMPLE>(L, KB, ck, bb, n, (T_), 2 * hp + sg, sj, sdq, k0, k1); attn_load_v<SAMPLE>(L, VB, cv, bb, n, (T_), 2 * hp + sg, tid, v0, v1); } while (0)
#define ATT_WRITE(T_, BUF_) do { const int bo_ = (BUF_) * AT_BUF; \
        LAS u32x4* ok = (LAS u32x4*)(lds + AT_KS + bo_ + ((sg * 64 + sj) * 72 + 16 * sdq) * 2); ok[0] = k0; ok[1] = k1; \
        if (SAMPLE && (T_) < 8) { const int sj2 = tid & 63, dq2 = (tid >> 6) & 3; LAS bf16_t* ov = (LAS bf16_t*)(lds + AT_VT + bo_) + (sg * 64 + 16 * dq2) * 72 + sj2; \
            ov[0] = (bf16_t)v0.x; ov[72] = (bf16_t)(v0.x >> 16); ov[144] = (bf16_t)v0.y; ov[216] = (bf16_t)(v0.y >> 16); ov[288] = (bf16_t)v0.z; ov[360] = (bf16_t)(v0.z >> 16); ov[432] = (bf16_t)v0.w; ov[504] = (bf16_t)(v0.w >> 16); \
            ov[576] = (bf16_t)v1.x; ov[648] = (bf16_t)(v1.x >> 16); ov[720] = (bf16_t)v1.y; ov[792] = (bf16_t)(v1.y >> 16); ov[864] = (bf16_t)v1.z; ov[936] = (bf16_t)(v1.z >> 16); ov[1008] = (bf16_t)v1.w; ov[1080] = (bf16_t)(v1.w >> 16); \
        } else { const int p0 = tid & 255, p1 = p0 + 256; \
            *(LAS u32x4*)(lds + AT_VT + bo_ + ((sg * 64 + (p0 >> 3)) * 72 + (p0 & 7) * 8) * 2) = v0; *(LAS u32x4*)(lds + AT_VT + bo_ + ((sg * 64 + (p1 >> 3)) * 72 + (p1 & 7) * 8) * 2) = v1; } } while (0)
    ATT_LOADT(t0);
    ATT_WRITE(t0, 0);
    if (t0 + 1 < 9) ATT_LOADT(t0 + 1);
    __syncthreads();
#pragma unroll 1
    for (int t = t0; t < 9; ++t) {
        const int cb = (t - t0) & 1;
        if (t + 1 < 9) { ATT_WRITE(t + 1, cb ^ 1); if (t + 2 < 9) ATT_LOADT(t + 2); }
        const LAS unsigned char* kb_ = lds + AT_KS + cb * AT_BUF; const LAS unsigned char* vb_ = lds + AT_VT + cb * AT_BUF;
        f32x4 sc[4];
#pragma unroll
        for (int jt = 0; jt < 4; ++jt) { f32x4 acc = (f32x4){0.f, 0.f, 0.f, 0.f};
#pragma unroll
            for (int ks = 0; ks < 2; ++ks) acc = __builtin_amdgcn_mfma_f32_16x16x32_bf16(lds16(kb_ + ((g * 64 + 16 * jt + r) * 72 + 32 * ks + 8 * q) * 2), qf[ks], acc, 0, 0, 0);
            sc[jt] = acc; }
        if (t >= 6) {
#pragma unroll
            for (int jt = 0; jt < 4; ++jt)
#pragma unroll
                for (int e = 0; e < 4; ++e) { int rel = 512 + qi - (64 * t + 16 * jt + 4 * q + e); rel = rel > 128 ? 128 : rel; rel = rel < -128 ? -128 : rel; sc[jt][e] += bias_s[g * 260 + rel + 128]; }
        } else { const float bfar = bias_s[g * 260 + 256];
#pragma unroll
            for (int jt = 0; jt < 4; ++jt) sc[jt] = sc[jt] + bfar;
        }
        float ps = 0.f;
#pragma unroll
        for (int jt = 0; jt < 4; ++jt)
#pragma unroll
            for (int e = 0; e < 4; ++e) { const float p = __builtin_amdgcn_exp2f(sc[jt][e]); sc[jt][e] = p; ps += p; }
        l_run += ps;
#pragma unroll
        for (int s = 0; s < 2; ++s) {
            u32x4 w; w.x = pk2(sc[2 * s][0], sc[2 * s][1]); w.y = pk2(sc[2 * s][2], sc[2 * s][3]); w.z = pk2(sc[2 * s + 1][0], sc[2 * s + 1][1]); w.w = pk2(sc[2 * s + 1][2], sc[2 * s + 1][3]);
            const bf16x8 bp = __builtin_bit_cast(bf16x8, w);
#pragma unroll
            for (int dt = 0; dt < 4; ++dt) { const LAS unsigned char* vp = vb_ + ((g * 64 + 16 * dt + r) * 72 + 32 * s + 4 * q) * 2;
                const s16x4 lo = lds8(vp), hi = lds8(vp + 32); const bf16x8 av = __builtin_shufflevector(lo, hi, 0, 1, 2, 3, 4, 5, 6, 7);
                o[dt] = __builtin_amdgcn_mfma_f32_16x16x32_bf16(av, bp, o[dt], 0, 0, 0); }
        }
        __syncthreads();
    }
#undef ATT_LOADT
#undef ATT_WRITE
    l_run += __shfl_xor(l_run, 16); l_run += __shfl_xor(l_run, 32);
    const float inv = __builtin_amdgcn_rcpf(l_run);
#pragma unroll
    for (int dt = 0; dt < 4; ++dt) { const int dd = 16 * dt + 4 * q; const u32x2 gv = *(const u32x2*)(GBs + qrl * 1024 + h * 64 + dd);
        u32x2 w; w.x = pk2(o[dt][0] * inv * bflo(gv.x), o[dt][1] * inv * bfhi(gv.x)); w.y = pk2(o[dt][2] * inv * bflo(gv.y), o[dt][3] * inv * bfhi(gv.y));
        if (!dry || inv == 1.2345e30f) *(u32x2*)(orow + dd) = w; }
}
DI void attn_phase(const Args& a, int L, LAS unsigned char* lds, int dry, int item_lo, int item_hi, int first_wg) {
    int wg0_ = (int)blockIdx.x - first_wg; if (wg0_ < 0) wg0_ += (int)gridDim.x;
    int prev_hp = -1;
    for (int item = item_lo + wg0_; item < item_hi; item += gridDim.x) { const bool sb = (item & 7) != prev_hp; prev_hp = item & 7;
        if ((item >> 3) >= NPC) attn_item<true>(a, L, lds, dry, item, sb); else attn_item<false>(a, L, lds, dry, item, sb); }
}

#define XB_TMO      128
#define XB_XCNT(j)  (256  + 64 * (j))
#define XB_XSUB(j)  (1280 + 64 * (j))
#define XB_XGEN(j)  (2304 + 64 * (j))
#define XB_TOP      3328
#define XB_TOPGEN   3392
#define XCD_BAR_WORDS 3456
#define XB_SPIN_CAP (1u << 18)

__device__ __forceinline__ unsigned xb_ld(unsigned* p)              { return __hip_atomic_load(p, __ATOMIC_RELAXED, __HIP_MEMORY_SCOPE_AGENT); }
__device__ __forceinline__ unsigned xb_add(unsigned* p, unsigned v) { return __hip_atomic_fetch_add(p, v, __ATOMIC_RELAXED, __HIP_MEMORY_SCOPE_AGENT); }
__device__ __forceinline__ unsigned xb_xcc_id() { return (unsigned)__builtin_amdgcn_s_getreg((3 << 11) | 20) & 0xFu; }
#define XB_SPIN(cond, bar) do { unsigned _sp = 0; while (cond) { __builtin_amdgcn_s_sleep(1); \
    if ((++_sp & 255u) == 0u) { if (xb_ld(&(bar)[XB_TMO])) break; if (_sp > XB_SPIN_CAP) { atomicAdd(&(bar)[XB_TMO], 1u); break; } } } } while (0)

struct XcdBarrier {
    unsigned* bar; unsigned x;
    volatile LAS unsigned* st;
};

__device__ __forceinline__ XcdBarrier xcd_barrier_post(unsigned* bar, volatile LAS unsigned* st) {
    XcdBarrier b; b.bar = bar; b.x = xb_xcc_id(); b.st = st;
    if (threadIdx.x == 0) (void)xb_add(&bar[XB_XCNT(b.x)], 1u);
    return b;
}
__device__ __forceinline__ void xcd_barrier_complete(unsigned* bar, unsigned x, unsigned& nloc, unsigned& nx) {
    const unsigned G = gridDim.x * gridDim.y * gridDim.z;
    unsigned sum, cnt, mine, sp = 0u;
    for (;;) {
        sum = 0u; cnt = 0u; mine = 0u;
#pragma unroll
        for (unsigned j = 0; j < 16; ++j) { const unsigned c = xb_ld(&bar[XB_XCNT(j)]); sum += c; cnt += (c > 0u) ? 1u : 0u; mine = (j == x) ? c : mine; }
        if (sum == G) break;
        __builtin_amdgcn_s_sleep(1);
        if ((++sp & 255u) == 0u) { if (xb_ld(&bar[XB_TMO])) break; if (sp > XB_SPIN_CAP) { atomicAdd(&bar[XB_TMO], 1u); break; } }
    }
    nloc = mine > 0u ? mine : 1u; nx = cnt > 0u ? cnt : 1u;
}

__device__ __forceinline__ void xcd_barrier(const XcdBarrier& b) {
    asm volatile("s_waitcnt vmcnt(0)" ::: "memory");
    __syncthreads();
    if (threadIdx.x == 0) {
        unsigned* bar = b.bar;
        __builtin_amdgcn_s_waitcnt(0);
        unsigned nloc = b.st[0], nx = b.st[1];
        if (nloc == 0u) { xcd_barrier_complete(bar, b.x, nloc, nx); b.st[0] = nloc; b.st[1] = nx; }
        const unsigned old = xb_add(&bar[XB_XSUB(b.x)], 1u);
        const unsigned gen = old / nloc;
        if (old + 1u == (gen + 1u) * nloc) {
            __builtin_amdgcn_fence(__ATOMIC_RELEASE, "agent");
            asm volatile("s_waitcnt vmcnt(0)" ::: "memory");
            const unsigned og = xb_add(&bar[XB_TOP], 1u);
            const unsigned tg = og / nx;
            if (og + 1u == (tg + 1u) * nx) xb_add(&bar[XB_TOPGEN], 1u);
            else XB_SPIN(xb_ld(&bar[XB_TOPGEN]) == tg, bar);
            __builtin_amdgcn_fence(__ATOMIC_ACQUIRE, "agent");
            xb_add(&bar[XB_XGEN(b.x)], 1u);
            asm volatile("s_waitcnt vmcnt(0)" ::: "memory");
        } else {
            XB_SPIN(xb_ld(&bar[XB_XGEN(b.x)]) == gen, bar);
            __builtin_amdgcn_fence(__ATOMIC_ACQUIRE, "agent");
            asm volatile("s_waitcnt vmcnt(0)" ::: "memory");
        }
    }
    __syncthreads();
}

#ifndef PROBE_REP
#define PROBE_REP 0
#endif
#ifndef EN_CH
#define EN_CH 31
#endif
#ifndef EN_PREP
#define EN_PREP 1
#endif
#ifndef EN_GIN
#define EN_GIN 1
#endif
#ifndef EN_GLAA
#define EN_GLAA 1
#endif
#ifndef EN_SCAN
#define EN_SCAN 1
#endif
#ifndef EN_GLAC
#define EN_GLAC 1
#endif
#ifndef EN_ATTN
#define EN_ATTN 1
#endif
#ifndef EN_CHAIN
#define EN_CHAIN 1
#endif
constexpr int PH_PER_LAYER = 10, N_PHASES = 1 + 2 * PH_PER_LAYER;
constexpr int MISC_OFF = LDS_BYTES - 64;
#define REPS(k) (((PROBE_REP >> (k)) & 1) ? 2 : 1)
__global__ void __launch_bounds__(NTHREADS, 2) fwd_kernel(Args a) {
    extern __shared__ __attribute__((aligned(16))) unsigned char lds_raw[];
    LAS unsigned char* lds = (LAS unsigned char*)lds_raw;
    const int tid = otid(), lane = tid & 63, wave = __builtin_amdgcn_readfirstlane(tid >> 6);
    const int gw = blockIdx.x * 8 + wave, ngw = gridDim.x * 8, gtid = blockIdx.x * NTHREADS + tid, ngt = gridDim.x * NTHREADS;
    LAS float* scr = (LAS float*)(lds + wave * 16384);
    const int lo = kph_lo(), hi = kph_hi();
    volatile LAS unsigned* MISC = (volatile LAS unsigned*)(lds + MISC_OFF);
    if (tid < 16) MISC[tid] = 0u;
    __syncthreads();
    XcdBarrier bar; bar.bar = (unsigned*)kws(); bar.x = 0; bar.st = nullptr;
    if (hi - lo > 1) bar = xcd_barrier_post((unsigned*)kws(), MISC);
#define IN_PH(k) (lo <= (k) && (k) < hi)
#define SEAM(k) do { if (IN_PH(k) && IN_PH((k) + 1)) { XcdBarrier b2_ = bar; asm volatile("" : "+s"(b2_.bar));     \
        xcd_barrier(b2_); if ((PROBE_REP >> 11) & 1) xcd_barrier(b2_); } } while (0)
    if (lo < 0) { __threadfence(); cg::this_grid().sync(); }
    if (EN_PREP && IN_PH(0)) for (int rep = 0; rep < REPS(10); ++rep) { prep_small(a, gw, ngw, scr, lane); prep_win(a, 0, gw, ngw, scr, lane); prep_rows(a, gw, ngw, lane); prep_shift(gw, lane); prep_misc(a, gtid, ngt); __syncthreads(); }
    SEAM(0);
    for (int L = 0; L < 2; ++L) {
        const int pb = 1 + L * PH_PER_LAYER;
        unsigned char* ws = kws();
        bf16_t* XB = (bf16_t*)(ws + WS_XB); float* SQ1 = (float*)(ws + WS_SQ1); float* SQ2 = (float*)(ws + WS_SQ2);
        bf16_t* S0 = (bf16_t*)(ws + WS_OV); bf16_t* S1 = (bf16_t*)(ws + WS_OV + SLOT); bf16_t* S2 = (bf16_t*)(ws + WS_OV + 2 * SLOT); bf16_t* S3 = (bf16_t*)(ws + WS_OV + 3 * SLOT); bf16_t* S4 = (bf16_t*)(ws + WS_OV + 4 * SLOT);
        const bf16_t* WIN = (const bf16_t*)(ws + WS_WIN);
        EpiIn ein; ein.L = L; ein.ws = ws; ein.out = kout(); ein.qg = kin(I_QG) + L * 64; ein.kg = kin(I_KG) + L * 64;
        if (EN_GIN && IN_PH(pb + 0)) for (int rep = 0; rep < REPS(0); ++rep) { ein.tile0 = 0; run_gemm_g(lds, XB, WIN, ein); }
        SEAM(pb + 0);
        if (EN_GLAA && IN_PH(pb + 1)) for (int rep = 0; rep < REPS(1); ++rep) gla_a_phase(a, L, lds, 0, NPC * 4, 0);
        SEAM(pb + 1);
        if (EN_SCAN && IN_PH(pb + 2)) for (int rep = 0; rep < REPS(2); ++rep) {
            gla_a_phase(a, L, lds, NPC * 4, NCH * 4, 0); gla_c_phase(a, L, lds, rep + 1 < REPS(2), NPC * 4, NCH * 4, 32);
            attn_phase(a, L, lds, rep + 1 < REPS(2), NPC * 8, NCH * 8, 64);
            gla_scan_phase(a, L, rep + 1 < REPS(2)); }
        SEAM(pb + 2);
        if (EN_GLAC && IN_PH(pb + 3)) for (int rep = 0; rep < REPS(3); ++rep) gla_c_phase(a, L, lds, rep + 1 < REPS(3), 0, NPC * 4, 0);
        SEAM(pb + 3);
        if (EN_GIN && IN_PH(pb + 4)) for (int rep = 0; rep < REPS(4); ++rep) { ein.tile0 = 13; run_gemm(lds, XB, WIN + (size_t)13 * 256 * 1024, MP, 16 * 256, 1024, ein); }
        SEAM(pb + 4);
        if (EN_ATTN && IN_PH(pb + 5)) for (int rep = 0; rep < REPS(5); ++rep) attn_phase(a, L, lds, rep + 1 < REPS(5), 0, NPC * 8, 0);
        SEAM(pb + 5);
        if (EN_GIN && IN_PH(pb + 6)) for (int rep = 0; rep < REPS(6); ++rep) { ein.tile0 = 29; run_gemm_m(lds, XB, WIN + (size_t)29 * 256 * 1024, ein); }
        if (!(IN_PH(pb + 6) && IN_PH(pb + 7))) SEAM(pb + 6);
        if (EN_CHAIN && IN_PH(pb + 7)) for (int rep = 0; rep < REPS(7); ++rep) { const int dry = rep + 1 < REPS(7);
            if (EN_CH & 1) { bf16_t* AXA = (bf16_t*)(ws + WS_AX + 4 * MiB); EpiYA ea{S1, dry, AXA}; run_gemm(lds, S0, wsm(a, L, 0), MP, 1024, 1024, ea); mini_gemm<1024>(lds, S0 + (size_t)MP * 1024, wsm(a, L, 0), ea); }
            if (EN_CH & 2) { bf16_t* AXA = (bf16_t*)(ws + WS_AX + 4 * MiB); bf16_t* AXB = (bf16_t*)(ws + WS_AX + 5 * MiB); EpiYB eb{S1, S2, dry, AXA, AXB}; run_gemm(lds, S4, wsm(a, L, 1), MP, 1024, 1024, eb); mini_gemm<1024>(lds, S4 + (size_t)MP * 1024, wsm(a, L, 1), eb); }
        }
        SEAM(pb + 7);
        if (EN_CHAIN && IN_PH(pb + 8)) {
            if (L == 0) { prep_win(a, 1, gw, ngw, scr, lane); __syncthreads(); }
            for (int rep = 0; rep < REPS(8); ++rep) {
            EpiOut eo; eo.xp = L == 0 ? kin(I_XP) : kout(); eo.xs = L == 0 ? kin(I_XS) : kout() + (size_t)MP * 1024; eo.out = kout(); eo.xb = S3; eo.sq = SQ1; eo.dry = rep + 1 < REPS(8);
            if (EN_CH & 4) { run_gemm(lds, S2, wsm(a, L, 2), MP, 1024, 1024, eo); mini_gemm<1024>(lds, (const bf16_t*)(ws + WS_AX + 5 * MiB), wsm(a, L, 2), eo); } }
        }
        SEAM(pb + 8);
        if (EN_CHAIN && IN_PH(pb + 9)) for (int rep = 0; rep < REPS(9); ++rep) { const int dry = rep + 1 < REPS(9);
            if (EN_CH & 8) { EpiP ep{(float*)S0, dry}; run_gemm(lds, (const bf16_t*)(ws + WS_PB) + (size_t)L * MT * 256, wsm(a, L, 4), MP, 1024, 256, ep); mini_gemm<256>(lds, (const bf16_t*)(ws + WS_PB) + ((size_t)L * MT + MP) * 256, wsm(a, L, 4), ep); }
            EpiGate eg; eg.sq1 = SQ1; eg.PT = (const float*)S0; eg.out = kout(); eg.xb = XB; eg.sq2 = SQ2; eg.dry = dry;
            if (EN_CH & 16) { run_gemm(lds, S3, wsm(a, L, 3), MP, 1024, 1024, eg); mini_gemm<1024>(lds, S3 + (size_t)MP * 1024, wsm(a, L, 3), eg); }
        }
        SEAM(pb + 9);
    }
}

#ifndef MK_ONE_LAUNCH
#define MK_ONE_LAUNCH 1
#endif
extern "C" void kernel_launch(void* const* d_in, const int* in_sizes, int n_in, void* d_out, int out_size, void* d_ws, size_t ws_size, hipStream_t stream) {
    static int grid = 0;
    if (grid == 0) {
        if (n_in != 21 || ws_size < WS_END) { fprintf(stderr, "kernel_launch: unexpected n_in %d or ws_size %zu (< %zu)\n", n_in, ws_size, (size_t)WS_END); grid = -1; return; }
        int dev = 0, cus = 0, per_cu = 0;
        (void)hipGetDevice(&dev); (void)hipDeviceGetAttribute(&cus, hipDeviceAttributeMultiprocessorCount, dev);
        (void)hipFuncSetAttribute((const void*)fwd_kernel, hipFuncAttributeMaxDynamicSharedMemorySize, LDS_BYTES);
        (void)hipOccupancyMaxActiveBlocksPerMultiprocessor(&per_cu, (const void*)fwd_kernel, NTHREADS, LDS_BYTES);
        (void)hipGetLastError();
        if (per_cu < 1) { fprintf(stderr, "kernel_launch: occupancy query says %d blocks/CU\n", per_cu); per_cu = 1; }
        grid = cus;
    }
    if (grid < 0) return;
    Args a{};
    for (int i = 0; i < 21; ++i) a.in[i] = (const float*)d_in[i];
    a.out = (float*)d_out; a.ws = (unsigned char*)d_ws;
#if MK_ONE_LAUNCH
    (void)hipMemsetAsync(d_ws, 0, 16384, stream);
    a.ph_lo = 0; a.ph_hi = N_PHASES;
    void* args[] = {&a};
    hipError_t e = hipLaunchCooperativeKernel((const void*)fwd_kernel, dim3(grid), dim3(NTHREADS), args, LDS_BYTES, stream);
    if (e != hipSuccess) fprintf(stderr, "cooperative launch failed: %s (grid %d)\n", hipGetErrorString(e), grid);
#else
    for (int p = 0; p < N_PHASES; ++p) { a.ph_lo = p; a.ph_hi = p + 1; hipLaunchKernelGGL(fwd_kernel, dim3(grid), dim3(NTHREADS), LDS_BYTES, stream, a); }
#endif
}
```

```cpp
#include <hip/hip_runtime.h>
#include <hip/hip_cooperative_groups.h>
#include <cstdio>
#include <cstdint>
namespace cg = cooperative_groups;
namespace pg8 {
#define PG8_LAS __attribute__((address_space(3)))
typedef unsigned short bf16_t;
typedef short bf16x8 __attribute__((ext_vector_type(8)));
typedef float f32x4 __attribute__((ext_vector_type(4)));
typedef unsigned u32x4 __attribute__((ext_vector_type(4)));
constexpr int BM = 256, BK = 64, HALF = 128, HTB = HALF * BK * 2  , STAGE_BYTES = 8 * HTB, NXCD = 8, WGM = 8;

__host__ __device__ __forceinline__ int lds_byte(int r, int c) { const int st = (r >> 4) * 2 + (c >> 5), rr = r & 15, cc = c & 31, ob = rr * 64 + cc * 2; return st * 1024 + (ob ^ (((ob >> 9) & 1) << 5)); }
__host__ __device__ __forceinline__ void stage_rc(int b, int& R, int& C) { const int st = b / 1024, sb = b % 1024, swz = sb ^ (((sb >> 9) & 1) << 5); R = (st >> 1) * 16 + swz / 64; C = (st & 1) * 32 + (swz % 64) / 2; }
__host__ __device__ __forceinline__ int perm32(int rho) { const int n = rho >> 4, i = rho & 15; return 8 * (i >> 2) + 4 * n + (i & 3); }

struct Unit { int pm, pn; };
struct Gemm { const bf16_t* A; const bf16_t* Bt; int M, N, K; };

struct StaticOrder {
    int nM, nN, nwg, G, c;
    __host__ __device__ void init(int M, int N, int G_, int c_) { nM = M / BM; nN = N / BM; nwg = nM * nN; G = G_; c = c_; }
    __host__ __device__ bool next(int i, Unit& u) const {
        const long L = (long)i * G + c; if (L >= nwg) return false;
        int wgid = (int)L; { const int q = nwg / NXCD, r = nwg % NXCD, xcd = wgid % NXCD, off = wgid / NXCD; wgid = (xcd < r ? xcd * (q + 1) : r * (q + 1) + (xcd - r) * q) + off; }
        const int nig = WGM * nN, gid = wgid / nig, fm = gid * WGM, gsz = (nM - fm) < WGM ? (nM - fm) : WGM;
        u.pm = fm + ((wgid % nig) % gsz); u.pn = (wgid % nig) / gsz; return true;
    }
    __device__ __forceinline__ void a_ready(const Unit&) const {}
    __device__ __forceinline__ void done(const Unit&) const {}
};
__device__ __forceinline__ unsigned cvt_pk_bf16(float lo, float hi) { unsigned r; asm volatile("v_cvt_pk_bf16_f32 %0, %1, %2" : "=v"(r) : "v"(lo), "v"(hi)); return r; }
template <class Epi, class Sched, bool ALIGN_EPI = false, bool SP2 = false>
__device__ __forceinline__ void gemm_phase(PG8_LAS unsigned char* lds, const Gemm g, const Sched& S, const Epi& E) {
    int tid_ = threadIdx.x; asm volatile("" : "+v"(tid_));
    const int tid = tid_, wid = __builtin_amdgcn_readfirstlane(tid >> 6), lane = tid & 63, wr = wid >> 2, wc = wid & 3, fr = lane & 15, fq = lane >> 4;
    const int K = g.K, nt = K / BK;
    unsigned voffA[2], voffB[2];
#pragma unroll
    for (int i = 0; i < 2; ++i) { int R, C; stage_rc(tid * 16 + i * 8192, R, C); const int Rb = Epi::PERM ? ((R & ~31) + perm32(R & 31)) : R;
        voffA[i] = (unsigned)(R * K + C) * 2u; voffB[i] = (unsigned)(Rb * K + C) * 2u; }
    const size_t kstep = (size_t)(BK * 2);
    const size_t hstep = (size_t)HALF * K * 2;
    const size_t tstep = 2 * hstep;
    const unsigned ldsw = (unsigned)wid * 1024u;
    const int aoff = lds_byte(wr * 64 + fr, fq * 8), boff = lds_byte(wc * 32 + fr, fq * 8);
#define PG8_SA(b, h) (((b) * 2 + (h)) * HTB)
#define PG8_SB(b, h) ((4 + (b) * 2 + (h)) * HTB)
#define PG8_STAGE(bufoff, gbase, voff) do { _Pragma("unroll") for (int _i = 0; _i < 2; ++_i) \
        __builtin_amdgcn_global_load_lds((const unsigned*)((const char*)(gbase) + (voff)[_i]), (PG8_LAS unsigned*)(lds + (bufoff) + ldsw + _i * 8192), 16, 0, 0); } while (0)
#define PG8_LDA(dst, b, h) do { _Pragma("unroll") for (int m = 0; m < 4; ++m) _Pragma("unroll") for (int k = 0; k < 2; ++k) dst[m][k] = *(const PG8_LAS bf16x8*)(lds + PG8_SA(b, h) + aoff + m * 2048 + k * 1024); } while (0)
#define PG8_LDB(dst, b, h) do { _Pragma("unroll") for (int n = 0; n < 2; ++n) _Pragma("unroll") for (int k = 0; k < 2; ++k) dst[n][k] = *(const PG8_LAS bf16x8*)(lds + PG8_SB(b, h) + boff + n * 2048 + k * 1024); } while (0)
#define PG8_MMA(ai, bj, At, Bt) do { __builtin_amdgcn_s_setprio(1); _Pragma("unroll") for (int m = 0; m < 4; ++m) _Pragma("unroll") for (int n = 0; n < 2; ++n) _Pragma("unroll") for (int k = 0; k < 2; ++k) \
        acc[ai][bj][m][n] = __builtin_amdgcn_mfma_f32_16x16x32_bf16(Bt[n][k], At[m][k], acc[ai][bj][m][n], 0, 0, 0); __builtin_amdgcn_s_setprio(0); } while (0)
#define PG8_WAIT_V(n) asm volatile("s_waitcnt vmcnt(" #n ")" ::: "memory")
#define PG8_WAIT_L(n) asm volatile("s_waitcnt lgkmcnt(" #n ")" ::: "memory")
#define PG8_BAR __builtin_amdgcn_s_barrier()
#define PG8_SCHED __builtin_amdgcn_sched_barrier(0)
    Unit cur, nxt; int ui = 0;
    if (!S.next(0, cur)) return;
    f32x4 acc[2][2][4][2];
#pragma unroll
    for (int a = 0; a < 2; ++a)
#pragma unroll
        for (int b = 0; b < 2; ++b)
#pragma unroll
            for (int m = 0; m < 4; ++m)
#pragma unroll
                for (int n = 0; n < 2; ++n) acc[a][b][m][n] = (f32x4){0.f, 0.f, 0.f, 0.f};
    bf16x8 At[4][2], B0[2][2], B1[2][2];
    const char* cA = (const char*)g.A + (size_t)cur.pm * tstep; const char* cB = (const char*)g.Bt + (size_t)cur.pn * tstep;
    S.a_ready(cur);
    if constexpr (SP2) {
        PG8_STAGE(PG8_SB(0, 0), cB, voffB); PG8_STAGE(PG8_SB(0, 1), cB + hstep, voffB); PG8_STAGE(PG8_SA(0, 0), cA, voffA); PG8_STAGE(PG8_SA(0, 1), cA + hstep, voffA);
        if (wr == 1) PG8_BAR;
        PG8_WAIT_V(2); PG8_BAR;
        PG8_STAGE(PG8_SB(1, 0), cB + kstep, voffB); PG8_STAGE(PG8_SA(1, 0), cA + kstep, voffA); PG8_STAGE(PG8_SB(1, 1), cB + hstep + kstep, voffB);
        PG8_WAIT_V(6); PG8_BAR;
    } else {
        PG8_STAGE(PG8_SB(0, 0), cB, voffB); PG8_STAGE(PG8_SA(0, 0), cA, voffA); PG8_STAGE(PG8_SB(0, 1), cB + hstep, voffB); PG8_STAGE(PG8_SA(0, 1), cA + hstep, voffA);
        if (wr == 1) PG8_BAR;
        PG8_WAIT_V(4); PG8_BAR;
        PG8_STAGE(PG8_SB(1, 0), cB + kstep, voffB); PG8_STAGE(PG8_SA(1, 0), cA + kstep, voffA); PG8_STAGE(PG8_SB(1, 1), cB + hstep + kstep, voffB);
        PG8_WAIT_V(6); PG8_BAR;
    }
    for (;;) {
        const bool has_next = S.next(ui + 1, nxt);
        const char* nA = has_next ? (const char*)g.A + (size_t)nxt.pm * tstep : cA; const char* nB = has_next ? (const char*)g.Bt + (size_t)nxt.pn * tstep : cB;
        for (int t = 0; t < nt; t += 2) {
            const bool last = (t == nt - 2);
            const char* a1 = cA + (size_t)(t + 1) * kstep;
            const char* a2 = last ? nA : cA + (size_t)(t + 2) * kstep; const char* b2 = last ? nB : cB + (size_t)(t + 2) * kstep;
            const char* a3 = a2 + kstep; const char* b3 = b2 + kstep;
            if (last && has_next) S.a_ready(nxt);
            if constexpr (SP2) {
            PG8_LDB(B0, 0, 0); PG8_LDB(B1, 0, 1); PG8_SCHED; PG8_LDA(At, 0, 0); PG8_STAGE(PG8_SA(1, 1), a1 + hstep, voffA);
            PG8_WAIT_V(8); PG8_WAIT_L(0); PG8_BAR; PG8_MMA(0, 0, At, B0); PG8_MMA(0, 1, At, B1); PG8_BAR; PG8_SCHED;
            PG8_LDA(At, 0, 1); PG8_STAGE(PG8_SB(0, 0), b2, voffB); PG8_STAGE(PG8_SB(0, 1), b2 + hstep, voffB); PG8_STAGE(PG8_SA(0, 0), a2, voffA);
            PG8_WAIT_V(8); PG8_WAIT_L(0); PG8_BAR; PG8_MMA(1, 0, At, B0); PG8_MMA(1, 1, At, B1); PG8_BAR; PG8_SCHED;
            PG8_LDB(B0, 1, 0); PG8_LDB(B1, 1, 1); PG8_SCHED; PG8_LDA(At, 1, 0); PG8_STAGE(PG8_SA(0, 1), a2 + hstep, voffA);
            PG8_WAIT_V(8); PG8_WAIT_L(0); PG8_BAR; PG8_MMA(0, 0, At, B0); PG8_MMA(0, 1, At, B1); PG8_BAR; PG8_SCHED;
            PG8_LDA(At, 1, 1); PG8_STAGE(PG8_SB(1, 0), b3, voffB); PG8_STAGE(PG8_SB(1, 1), b3 + hstep, voffB); PG8_STAGE(PG8_SA(1, 0), a3, voffA);
            PG8_WAIT_V(8); PG8_WAIT_L(0); PG8_BAR; PG8_MMA(1, 0, At, B0); PG8_MMA(1, 1, At, B1); PG8_BAR; PG8_SCHED;
            } else {
            PG8_LDB(B0, 0, 0); PG8_SCHED; PG8_LDA(At, 0, 0); PG8_STAGE(PG8_SA(1, 1), a1 + hstep, voffA);
            PG8_WAIT_L(8); PG8_BAR; PG8_WAIT_L(0); PG8_MMA(0, 0, At, B0); PG8_BAR; PG8_SCHED;
            PG8_LDB(B1, 0, 1); PG8_STAGE(PG8_SB(0, 0), b2, voffB);
            PG8_BAR; PG8_WAIT_L(0); PG8_MMA(0, 1, At, B1); PG8_BAR;
            PG8_LDA(At, 0, 1); PG8_STAGE(PG8_SA(0, 0), a2, voffA);
            PG8_BAR; PG8_WAIT_L(0); PG8_MMA(1, 0, At, B0); PG8_BAR; PG8_SCHED;
            PG8_STAGE(PG8_SB(0, 1), b2 + hstep, voffB);
            PG8_WAIT_V(6); PG8_BAR; PG8_MMA(1, 1, At, B1); PG8_BAR;
            PG8_LDB(B0, 1, 0); PG8_SCHED; PG8_LDA(At, 1, 0); PG8_STAGE(PG8_SA(0, 1), a2 + hstep, voffA);
            PG8_WAIT_L(8); PG8_BAR; PG8_WAIT_L(0); PG8_MMA(0, 0, At, B0); PG8_BAR; PG8_SCHED;
            PG8_LDB(B1, 1, 1); PG8_STAGE(PG8_SB(1, 0), b3, voffB);
            PG8_BAR; PG8_WAIT_L(0); PG8_MMA(0, 1, At, B1); PG8_BAR;
            PG8_LDA(At, 1, 1); PG8_STAGE(PG8_SA(1, 0), a3, voffA);
            PG8_BAR; PG8_WAIT_L(0); PG8_MMA(1, 0, At, B0); PG8_BAR; PG8_SCHED;
            PG8_STAGE(PG8_SB(1, 1), b3 + hstep, voffB);
            PG8_WAIT_V(6); PG8_BAR; PG8_MMA(1, 1, At, B1); PG8_BAR;
            }
        }
        if constexpr (ALIGN_EPI) { if (wr == 0) PG8_BAR; }
        if constexpr (!Epi::AFTER_DRAIN) { E(acc, cur, wr, wc, fr, fq); S.done(cur); }
        if (!has_next) break;
#pragma unroll
        for (int a = 0; a < 2; ++a)
#pragma unroll
            for (int b = 0; b < 2; ++b)
#pragma unroll
                for (int m = 0; m < 4; ++m)
#pragma unroll
                    for (int n = 0; n < 2; ++n) acc[a][b][m][n] = (f32x4){0.f, 0.f, 0.f, 0.f};
        cur = nxt; cA = nA; cB = nB; ++ui;
        if constexpr (ALIGN_EPI) { if (wr == 1) PG8_BAR; }
    }
    PG8_WAIT_V(0);
    if constexpr (!ALIGN_EPI) { if (wr == 0) PG8_BAR; }
    PG8_BAR;
    if constexpr (Epi::AFTER_DRAIN) { E.fused(acc, cur, wr, wc, fr, fq, lds, wid, lane); S.done(cur); }
#undef PG8_SA
#undef PG8_SB
#undef PG8_STAGE
#undef PG8_LDA
#undef PG8_LDB
#undef PG8_MMA
#undef PG8_WAIT_V
#undef PG8_WAIT_L
#undef PG8_BAR
#undef PG8_SCHED
}
}

#define DI __device__ __forceinline__
#define LAS __attribute__((address_space(3)))
typedef unsigned short bf16_t;
typedef short bf16x8 __attribute__((ext_vector_type(8)));
typedef short s16x4 __attribute__((ext_vector_type(4)));
typedef float f32x4 __attribute__((ext_vector_type(4)));
typedef unsigned u32x4 __attribute__((ext_vector_type(4)));
typedef unsigned u32x2 __attribute__((ext_vector_type(2)));

constexpr int DM = 1024, MP = 16384, MS = 512, MT = MP + MS;
constexpr int NPC = 256, NCH = 264;
constexpr float EPS = 1e-6f, LOG2E = 1.4426950408889634f;
constexpr int NWIN_T = 37;
constexpr int NTHREADS = 512;
constexpr int LDS_BYTES = 147456;

constexpr size_t MiB = 1u << 20;
constexpr size_t SLOT = 33 * MiB;
constexpr size_t WS_MSH = 65536;
constexpr size_t WS_SQ1 = 1 * MiB, WS_SQ2 = 5 * MiB / 2, WS_RA = 4 * MiB, WS_DC = 6 * MiB, WS_WSM = 7 * MiB, WSM_LAYER = 17 * MiB / 2;
constexpr size_t WS_WIN = 24 * MiB, WS_PB = 43 * MiB, WS_XB = 60 * MiB, WS_OV = 93 * MiB, WS_AX = WS_OV + 5 * SLOT, WS_END = WS_AX + 6 * MiB;
constexpr size_t O_Y = 0, O_SP = 17301504, O_KP = 18350080, O_VP = 22544384, O_SS = 26738688, O_KS = 28835840, O_VS = 37224448;


typedef const __attribute__((address_space(4))) unsigned char* kargp_t;
DI kargp_t kbase() { kargp_t k = (kargp_t)__builtin_amdgcn_kernarg_segment_ptr(); asm volatile("" : "+s"(k)); return k; }
DI const float* kin(int i) { return *(const float* const __attribute__((address_space(4)))*)(kbase() + 8 * i); }
DI float* kout() { return *(float* const __attribute__((address_space(4)))*)(kbase() + 168); }
DI unsigned char* kws() { return *(unsigned char* const __attribute__((address_space(4)))*)(kbase() + 176); }
DI int kph_lo() { return *(const __attribute__((address_space(4))) int*)(kbase() + 184); }
DI int kph_hi() { return *(const __attribute__((address_space(4))) int*)(kbase() + 188); }
DI int otid() { int t = threadIdx.x; asm volatile("" : "+v"(t)); return t; }
DI float bflo(unsigned w) { return __uint_as_float(w << 16); }
DI float bfhi(unsigned w) { return __uint_as_float(w & 0xffff0000u); }
DI float bf2f(bf16_t b) { return __uint_as_float(((unsigned)b) << 16); }
typedef float f32x2_t __attribute__((ext_vector_type(2))); typedef __bf16 bf16x2_t __attribute__((ext_vector_type(2)));
DI unsigned pk2(float lo, float hi) { f32x2_t v = {lo, hi}; bf16x2_t r = __builtin_convertvector(v, bf16x2_t); return __builtin_bit_cast(unsigned, r); }
DI float sigm(float x) { return __builtin_amdgcn_rcpf(1.f + __expf(-x)); }
DI float silu(float x) { return x * sigm(x); }
DI float row_rstd(const float* sq, int row) {
    const f32x4* p = (const f32x4*)(sq + (size_t)row * 16); const f32x4 a = p[0], b = p[1], c = p[2], d = p[3];
    const float s = (((a.x + a.y) + (a.z + a.w)) + ((b.x + b.y) + (b.z + b.w))) + (((c.x + c.y) + (c.z + c.w)) + ((d.x + d.y) + (d.z + d.w)));
    return rsqrtf(s * (1.f / 1024.f) + EPS);
}
DI u32x4 pack8(const float* v) { u32x4 w; w.x = pk2(v[0], v[1]); w.y = pk2(v[2], v[3]); w.z = pk2(v[4], v[5]); w.w = pk2(v[6], v[7]); return w; }
DI void unpack8(u32x4 w, float* v) { v[0] = bflo(w.x); v[1] = bfhi(w.x); v[2] = bflo(w.y); v[3] = bfhi(w.y); v[4] = bflo(w.z); v[5] = bfhi(w.z); v[6] = bflo(w.w); v[7] = bfhi(w.w); }

DI void store_vt_pair(bf16_t* p, const float* v8, int fr) {
    const unsigned w0 = pk2(v8[0], v8[1]), w1 = pk2(v8[2], v8[3]), w2 = pk2(v8[4], v8[5]), w3 = pk2(v8[6], v8[7]);
    const bool odd = fr & 1;
    const unsigned r0 = __shfl_xor(odd ? w0 : w2, 1), r1 = __shfl_xor(odd ? w1 : w3, 1);
    const unsigned m0 = odd ? w2 : w0, m1 = odd ? w3 : w1;
    const unsigned te0 = odd ? r0 : m0, to0 = odd ? m0 : r0, te1 = odd ? r1 : m1, to1 = odd ? m1 : r1;
    unsigned* q = (unsigned*)(p - (odd ? 1 : 0) + (odd ? 4 : 0) * 64);
    q[0] = (te0 & 0xffffu) | (to0 << 16); q[32] = (te0 >> 16) | (to0 & 0xffff0000u); q[64] = (te1 & 0xffffu) | (to1 << 16); q[96] = (te1 >> 16) | (to1 & 0xffff0000u);
}
enum { T_QA = 0, T_KA, T_VA, T_GA, T_RA, T_QB, T_KB, T_VB, T_GB, T_MGA, T_MGB };
struct EpiIn {
    static constexpr bool PERM = false, AFTER_DRAIN = false;
    int tile0, L; unsigned char* ws; float* out; const float *qg, *kg;
    template <int TYPE> DI void run(const pg8::f32x4 (&acc)[2][2][4][2], int pm, int tcol, int wr, int wc, int fr, int fq) const {
        constexpr size_t doff = TYPE == T_QA ? WS_OV + 2 * SLOT : TYPE == T_KA ? WS_OV + 2 * SLOT + (size_t)MT * 1024 : TYPE == T_VA ? WS_OV + SLOT : TYPE == T_GA ? WS_OV : TYPE == T_QB ? WS_OV + SLOT : TYPE == T_KB ? WS_OV + 2 * SLOT
                              : TYPE == T_VB ? WS_OV + 3 * SLOT : TYPE == T_GB ? WS_OV + 4 * SLOT : TYPE == T_MGA ? WS_OV + SLOT : WS_OV + 2 * SLOT;
        constexpr bool ANX = TYPE == T_QB || TYPE == T_KB || TYPE == T_VB || TYPE == T_GB || TYPE == T_MGA || TYPE == T_MGB;
        constexpr size_t aoff = WS_AX + (TYPE == T_QB ? 0 : TYPE == T_KB ? 1 : TYPE == T_VB ? 2 : TYPE == T_GB ? 3 : TYPE == T_MGA ? 4 : 5) * MiB;
        const bool srow = ANX && pm >= MP / 256;
        bf16_t* dst = (bf16_t*)(ws + (srow ? aoff : doff)); const int rsub = srow ? MP : 0; const float* sq = (const float*)(ws + WS_SQ2); float* RA = (float*)(ws + WS_RA);
        float* okp = out + (TYPE == T_KB ? O_KP : O_VP) + (size_t)L * 4 * 512 * 1024; float* oks = out + (TYPE == T_KB ? O_KS : O_VS) + (size_t)L * 8 * 512 * 1024;
        const int ld = (TYPE == T_QA || TYPE == T_KA) ? 512 : 1024;
        float gq[2][8];
        if (TYPE == T_QB || TYPE == T_KB) {
            const float* g = TYPE == T_QB ? qg : kg;
#pragma unroll
            for (int bj = 0; bj < 2; ++bj)
#pragma unroll
                for (int k = 0; k < 8; ++k) gq[bj][k] = g[32 * bj + 8 * fq + k] * (TYPE == T_QB ? 0.125f * LOG2E : 1.f);
        }
#pragma unroll
        for (int ai = 0; ai < 2; ++ai)
#pragma unroll
            for (int m = 0; m < 4; ++m) {
                const int row = pm * 256 + ai * 128 + wr * 64 + m * 16 + fr;
                const float rs = row_rstd(sq, row);
                float v[2][8];
#pragma unroll
                for (int bj = 0; bj < 2; ++bj)
#pragma unroll
                    for (int n = 0; n < 2; ++n)
#pragma unroll
                        for (int e = 0; e < 4; ++e) v[bj][4 * n + e] = acc[ai][bj][m][n][e] * rs;
                if (TYPE == T_RA) {
                    if (wc == 0 && fq < 2) { float* p = RA + (size_t)row * 16 + 8 * fq; *(f32x4*)p = (f32x4){v[0][0], v[0][1], v[0][2], v[0][3]}; *(f32x4*)(p + 4) = (f32x4){v[0][4], v[0][5], v[0][6], v[0][7]}; }
                    continue;
                }
                if (TYPE == T_QB || TYPE == T_KB) {
                    float ss = 0.f;
#pragma unroll
                    for (int bj = 0; bj < 2; ++bj)
#pragma unroll
                        for (int k = 0; k < 8; ++k) ss += v[bj][k] * v[bj][k];
                    ss += __shfl_xor(ss, 16); ss += __shfl_xor(ss, 32);
                    const float r = rsqrtf(ss * (1.f / 64.f) + EPS);
#pragma unroll
                    for (int bj = 0; bj < 2; ++bj)
#pragma unroll
                        for (int k = 0; k < 8; ++k) v[bj][k] *= r * gq[bj][k];
                }
                float* bo = nullptr;
                if (TYPE == T_KB || TYPE == T_VB) {
                    if (row < MP) { const int t = row & 4095; if (t >= 3584) bo = okp + ((size_t)(row >> 12) * 512 + (t - 3584)) * 1024; }
                    else { const int rr = row - MP; bo = oks + ((size_t)(rr >> 6) * 512 + 448 + (rr & 63)) * 1024; }
                }
#pragma unroll
                for (int bj = 0; bj < 2; ++bj) {
                    const int col = tcol * 256 + 64 * wc + 32 * bj + 8 * fq;
                    if (TYPE == T_QA) {
#pragma unroll
                        for (int k = 0; k < 8; ++k) v[bj][k] *= 0.08838834764831845f;
                    }
                    if (TYPE == T_GA || TYPE == T_GB) {
#pragma unroll
                        for (int k = 0; k < 8; ++k) v[bj][k] = silu(v[bj][k]);
                    }
                    if (TYPE == T_MGA || TYPE == T_MGB) {
#pragma unroll
                        for (int k = 0; k < 8; ++k) v[bj][k] = sigm(v[bj][k]);
                    }
                    if ((TYPE == T_KB || TYPE == T_VB) && bo) { *(f32x4*)(bo + col) = (f32x4){v[bj][0], v[bj][1], v[bj][2], v[bj][3]}; *(f32x4*)(bo + col + 4) = (f32x4){v[bj][4], v[bj][5], v[bj][6], v[bj][7]}; }
                    if (TYPE == T_VA) {
                        bf16_t* p = dst + ((size_t)((row >> 6) * 4 + tcol) * 256 + 64 * wc + 32 * bj + 8 * fq) * 64 + (row & 63);
                        store_vt_pair(p, v[bj], fr);
                    } else if (TYPE == T_VB) {
                        bf16_t* p = dst + ((size_t)(((row - rsub) >> 6) * 16 + tcol * 4 + wc) * 64 + 32 * bj + 8 * fq) * 64 + (row & 63);
                        store_vt_pair(p, v[bj], fr);
                    } else
                    *(u32x4*)(dst + (size_t)(row - rsub) * ld + col) = pack8(v[bj]);
                }
                asm volatile("" ::: "memory");
            }
    }
    DI void operator()(const pg8::f32x4 (&acc)[2][2][4][2], const pg8::Unit& u, int wr, int wc, int fr, int fq) const {
        asm volatile("" : "+v"(fr), "+v"(fq));
        const int gt = tile0 + u.pn;
        if (gt < 2) run<T_QA>(acc, u.pm, gt, wr, wc, fr, fq);
        else if (gt < 4) run<T_KA>(acc, u.pm, gt - 2, wr, wc, fr, fq);
        else if (gt < 8) run<T_VA>(acc, u.pm, gt - 4, wr, wc, fr, fq);
        else if (gt < 12) run<T_GA>(acc, u.pm, gt - 8, wr, wc, fr, fq);
        else if (gt == 12) run<T_RA>(acc, u.pm, 0, wr, wc, fr, fq);
        else if (gt < 17) run<T_QB>(acc, u.pm, gt - 13, wr, wc, fr, fq);
        else if (gt < 21) run<T_KB>(acc, u.pm, gt - 17, wr, wc, fr, fq);
        else if (gt < 25) run<T_VB>(acc, u.pm, gt - 21, wr, wc, fr, fq);
        else if (gt < 29) run<T_GB>(acc, u.pm, gt - 25, wr, wc, fr, fq);
        else if (gt < 33) run<T_MGA>(acc, u.pm, gt - 29, wr, wc, fr, fq);
        else run<T_MGB>(acc, u.pm, gt - 33, wr, wc, fr, fq);
    }
};
#define EPI_ROWS_BEGIN _Pragma("unroll") for (int ai = 0; ai < 2; ++ai) _Pragma("unroll") for (int m = 0; m < 4; ++m) { asm volatile("" ::: "memory"); const int row = u.pm * 256 + ai * 128 + wr * 64 + m * 16 + fr;
#define EPI_COLS_BEGIN _Pragma("unroll") for (int bj = 0; bj < 2; ++bj) { const int col = u.pn * 256 + 64 * wc + 32 * bj + 8 * fq; float v[8]; \
    _Pragma("unroll") for (int n = 0; n < 2; ++n) _Pragma("unroll") for (int e = 0; e < 4; ++e) v[4 * n + e] = acc[ai][bj][m][n][e];
struct EpiYA {
    static constexpr bool PERM = false, AFTER_DRAIN = false; bf16_t* G; int dry; bf16_t* Gs;
    DI void operator()(const pg8::f32x4 (&acc)[2][2][4][2], const pg8::Unit& u, int wr, int wc, int fr, int fq) const {
        asm volatile("" : "+v"(fr), "+v"(fq));
        EPI_ROWS_BEGIN EPI_COLS_BEGIN
            bf16_t* p = G + (size_t)row * 1024 + col; float g[8]; unpack8(*(const u32x4*)p, g);
#pragma unroll
            for (int k = 0; k < 8; ++k) v[k] *= g[k];
            if (!dry) *(u32x4*)p = pack8(v);
        } }
    }
    DI void mini(int row, int col, f32x4 s) const {
        bf16_t* p = Gs + (size_t)(row - MP) * 1024 + col; const u32x2 g = *(const u32x2*)p;
        u32x2 w; w.x = pk2(s.x * bflo(g.x), s.y * bfhi(g.x)); w.y = pk2(s.z * bflo(g.y), s.w * bfhi(g.y)); if (!dry) *(u32x2*)p = w;
    }
};
struct EpiYB {
    static constexpr bool PERM = false, AFTER_DRAIN = false; const bf16_t* YA; bf16_t* G; int dry; const bf16_t* YAs; bf16_t* Gs;
    DI void operator()(const pg8::f32x4 (&acc)[2][2][4][2], const pg8::Unit& u, int wr, int wc, int fr, int fq) const {
        asm volatile("" : "+v"(fr), "+v"(fq));
        EPI_ROWS_BEGIN EPI_COLS_BEGIN
            bf16_t* p = G + (size_t)row * 1024 + col; float g[8], ya[8]; unpack8(*(const u32x4*)p, g); unpack8(*(const u32x4*)(YA + (size_t)row * 1024 + col), ya);
#pragma unroll
            for (int k = 0; k < 8; ++k) v[k] = ya[k] + v[k] * g[k];
            if (!dry) *(u32x4*)p = pack8(v);
        } }
    }
    DI void mini(int row, int col, f32x4 s) const {
        bf16_t* p = Gs + (size_t)(row - MP) * 1024 + col; const u32x2 g = *(const u32x2*)p, y = *(const u32x2*)(YAs + (size_t)(row - MP) * 1024 + col);
        u32x2 w; w.x = pk2(bflo(y.x) + s.x * bflo(g.x), bfhi(y.x) + s.y * bfhi(g.x)); w.y = pk2(bflo(y.y) + s.z * bflo(g.y), bfhi(y.y) + s.w * bfhi(g.y)); if (!dry) *(u32x2*)p = w;
    }
};
struct EpiOut {
    static constexpr bool PERM = false, AFTER_DRAIN = false; const float* xp; const float* xs; float* out; bf16_t* xb; float* sq; int dry;
    DI void operator()(const pg8::f32x4 (&acc)[2][2][4][2], const pg8::Unit& u, int wr, int wc, int fr, int fq) const {
        asm volatile("" : "+v"(fr), "+v"(fq));
        EPI_ROWS_BEGIN
            const float* base = row < MP ? xp + (size_t)row * 1024 : xs + (size_t)(row - MP) * 1024; float ss = 0.f;
            EPI_COLS_BEGIN
                const f32x4 b0 = *(const f32x4*)(base + col), b1 = *(const f32x4*)(base + col + 4);
                v[0] += b0.x; v[1] += b0.y; v[2] += b0.z; v[3] += b0.w; v[4] += b1.x; v[5] += b1.y; v[6] += b1.z; v[7] += b1.w;
#pragma unroll
                for (int k = 0; k < 8; ++k) ss += v[k] * v[k];
                if (!dry) { float* o = out + (size_t)row * 1024 + col; *(f32x4*)o = (f32x4){v[0], v[1], v[2], v[3]}; *(f32x4*)(o + 4) = (f32x4){v[4], v[5], v[6], v[7]};
                *(u32x4*)(xb + (size_t)row * 1024 + col) = pack8(v); }
            }
            ss += __shfl_xor(ss, 16); ss += __shfl_xor(ss, 32);
            if (fq == 0 && !dry) sq[(size_t)row * 16 + 4 * u.pn + wc] = ss;
        }
    }
    DI void mini(int row, int col, f32x4 s) const {
        const float* base = row < MP ? xp + (size_t)row * 1024 : xs + (size_t)(row - MP) * 1024; const f32x4 b0 = *(const f32x4*)(base + col);
        const f32x4 x = s + b0; float ss = (x.x * x.x + x.y * x.y) + (x.z * x.z + x.w * x.w);
        ss += __shfl_xor(ss, 1); ss += __shfl_xor(ss, 2); ss += __shfl_xor(ss, 4); ss += __shfl_xor(ss, 8);
        if (!dry) { *(f32x4*)(out + (size_t)row * 1024 + col) = x; u32x2 w; w.x = pk2(x.x, x.y); w.y = pk2(x.z, x.w); *(u32x2*)(xb + (size_t)row * 1024 + col) = w;
            if ((col & 63) == 0) sq[(size_t)row * 16 + (col >> 6)] = ss; }
    }
};
struct EpiP {
    static constexpr bool PERM = false, AFTER_DRAIN = false; float* PT; int dry;
    DI void operator()(const pg8::f32x4 (&acc)[2][2][4][2], const pg8::Unit& u, int wr, int wc, int fr, int fq) const {
        asm volatile("" : "+v"(fr), "+v"(fq));
        EPI_ROWS_BEGIN EPI_COLS_BEGIN
            if (!dry) { float* o = PT + (size_t)row * 1024 + col; *(f32x4*)o = (f32x4){v[0], v[1], v[2], v[3]}; *(f32x4*)(o + 4) = (f32x4){v[4], v[5], v[6], v[7]}; }
        } }
    }
    DI void mini(int row, int col, f32x4 s) const { if (!dry) *(f32x4*)(PT + (size_t)row * 1024 + col) = s; }
};
struct EpiGate {
    static constexpr bool PERM = false, AFTER_DRAIN = false; const float* sq1; const float* PT; float* out; bf16_t* xb; float* sq2; int dry;
    DI void operator()(const pg8::f32x4 (&acc)[2][2][4][2], const pg8::Unit& u, int wr, int wc, int fr, int fq) const {
        asm volatile("" : "+v"(fr), "+v"(fq));
        EPI_ROWS_BEGIN
            const float rs = row_rstd(sq1, row); float ss = 0.f;
            EPI_COLS_BEGIN
                float* o = out + (size_t)row * 1024 + col; const float* pt = PT + (size_t)row * 1024 + col;
                const f32x4 b0 = *(const f32x4*)o, b1 = *(const f32x4*)(o + 4), p0 = *(const f32x4*)pt, p1 = *(const f32x4*)(pt + 4);
                const float xb_[8] = {b0.x, b0.y, b0.z, b0.w, b1.x, b1.y, b1.z, b1.w}, pp[8] = {p0.x, p0.y, p0.z, p0.w, p1.x, p1.y, p1.z, p1.w};
#pragma unroll
                for (int k = 0; k < 8; ++k) { v[k] = xb_[k] + sigm(v[k] * rs) * pp[k]; ss += v[k] * v[k]; }
                if (!dry) { *(f32x4*)o = (f32x4){v[0], v[1], v[2], v[3]}; *(f32x4*)(o + 4) = (f32x4){v[4], v[5], v[6], v[7]};
                *(u32x4*)(xb + (size_t)row * 1024 + col) = pack8(v); }
            }
            ss += __shfl_xor(ss, 16); ss += __shfl_xor(ss, 32);
            if (fq == 0 && !dry) sq2[(size_t)row * 16 + 4 * u.pn + wc] = ss;
        }
    }
    DI void mini(int row, int col, f32x4 s) const {
        const float rs = row_rstd(sq1, row); float* o = out + (size_t)row * 1024 + col; const f32x4 b0 = *(const f32x4*)o, p0 = *(const f32x4*)(PT + (size_t)row * 1024 + col);
        f32x4 x; x.x = b0.x + sigm(s.x * rs) * p0.x; x.y = b0.y + sigm(s.y * rs) * p0.y; x.z = b0.z + sigm(s.z * rs) * p0.z; x.w = b0.w + sigm(s.w * rs) * p0.w;
        float ss = (x.x * x.x + x.y * x.y) + (x.z * x.z + x.w * x.w);
        ss += __shfl_xor(ss, 1); ss += __shfl_xor(ss, 2); ss += __shfl_xor(ss, 4); ss += __shfl_xor(ss, 8);
        if (!dry) { *(f32x4*)o = x; u32x2 w; w.x = pk2(x.x, x.y); w.y = pk2(x.z, x.w); *(u32x2*)(xb + (size_t)row * 1024 + col) = w;
            if ((col & 63) == 0) sq2[(size_t)row * 16 + (col >> 6)] = ss; }
    }
};

struct OrderG {
    pg8::StaticOrder S; int G, c;
    DI void init(int G_, int c_) { S.init(MP, 13 * 256, G_, c_); G = G_; c = c_; }
    DI bool next(int i, pg8::Unit& u) const { if (S.next(i, u)) return true; const long s = (long)i * G + c - 64 * 13; if (s >= 2 * NWIN_T) return false; u.pm = 64 + (int)(s / NWIN_T); u.pn = (int)(s % NWIN_T); return true; }
    DI void a_ready(const pg8::Unit&) const {}
    DI void done(const pg8::Unit&) const {}
};
struct OrderM {
    pg8::StaticOrder S;
    DI void init(int G_, int c_) { S.init(MP, 1024, G_, c_); }
    DI bool next(int i, pg8::Unit& u) const { pg8::Unit v; if (!S.next(i >> 1, v)) return false; u.pm = v.pm; u.pn = 4 * (i & 1) + v.pn; return true; }
    DI void a_ready(const pg8::Unit&) const {}
    DI void done(const pg8::Unit&) const {}
};
template <class Epi> DI void run_gemm_m(LAS unsigned char* lds, const bf16_t* A, const bf16_t* Bt, const Epi& E) {
    int K = 1024; asm volatile("" : "+s"(K));
    pg8::Gemm g{A, Bt, MP, 8 * 256, K}; OrderM S; S.init((int)gridDim.x, (int)blockIdx.x);
    pg8::gemm_phase<Epi, OrderM, true, true>(lds, g, S, E);
}
template <class Epi> DI void run_gemm_g(LAS unsigned char* lds, const bf16_t* A, const bf16_t* Bt, const Epi& E) {
    int K = 1024; asm volatile("" : "+s"(K));
    pg8::Gemm g{A, Bt, MT, NWIN_T * 256, K}; OrderG S; S.init((int)gridDim.x, (int)blockIdx.x);
    pg8::gemm_phase<Epi, OrderG, true, true>(lds, g, S, E);
}
template <class Epi> DI void run_gemm(LAS unsigned char* lds, const bf16_t* A, const bf16_t* Bt, int M, int N, int K, const Epi& E) {
    asm volatile("" : "+s"(K), "+s"(N));
    pg8::Gemm g{A, Bt, M, N, K}; pg8::StaticOrder S; S.init(M, N, (int)gridDim.x, (int)blockIdx.x);
    pg8::gemm_phase<Epi, pg8::StaticOrder, true, true>(lds, g, S, E);
}

template <int K, class Epi> DI void mini_gemm(LAS unsigned char* lds, const bf16_t* A, const bf16_t* Wt, const Epi& E) {
    const int tid = otid(), lane = tid & 63, wave = __builtin_amdgcn_readfirstlane(tid >> 6), r = lane & 15, q = lane >> 4;
    constexpr int KW = K / 8;
    for (int mt = blockIdx.x; mt < 256; mt += gridDim.x) {
        const int row0 = 32 * (mt >> 4), cb = mt & 15, tile = cb >> 2, wcp = cb & 3, k0 = wave * KW;
        f32x4 acc[4][2];
#pragma unroll
        for (int ct = 0; ct < 4; ++ct) { acc[ct][0] = (f32x4){0.f, 0.f, 0.f, 0.f}; acc[ct][1] = (f32x4){0.f, 0.f, 0.f, 0.f}; }
#pragma unroll
        for (int ks = 0; ks < KW / 32; ++ks) {
            bf16x8 af[2], wf[4];
#pragma unroll
            for (int rt = 0; rt < 2; ++rt) af[rt] = *(const bf16x8*)(A + (size_t)(row0 + 16 * rt + r) * K + k0 + 32 * ks + 8 * q);
#pragma unroll
            for (int ct = 0; ct < 4; ++ct) { const int x = 16 * ct + r, p = 128 * (x >> 5) + 32 * wcp + 16 * ((x >> 2) & 1) + 4 * ((x >> 3) & 3) + (x & 3);
                wf[ct] = *(const bf16x8*)(Wt + (size_t)(tile * 256 + p) * K + k0 + 32 * ks + 8 * q); }
#pragma unroll
            for (int ct = 0; ct < 4; ++ct)
#pragma unroll
                for (int rt = 0; rt < 2; ++rt) acc[ct][rt] = __builtin_amdgcn_mfma_f32_16x16x32_bf16(wf[ct], af[rt], acc[ct][rt], 0, 0, 0);
        }
        LAS float* part = (LAS float*)lds + wave * (32 * 68);
#pragma unroll
        for (int ct = 0; ct < 4; ++ct)
#pragma unroll
            for (int rt = 0; rt < 2; ++rt) *(LAS f32x4*)(part + (16 * rt + r) * 68 + 16 * ct + 4 * q) = acc[ct][rt];
        __syncthreads();
        { const int row = tid >> 4, c4 = (tid & 15) * 4; f32x4 s = (f32x4){0.f, 0.f, 0.f, 0.f};
#pragma unroll
          for (int w = 0; w < 8; ++w) s += *(const LAS f32x4*)((const LAS float*)lds + w * (32 * 68) + row * 68 + c4);
          E.mini(MP + row0 + row, 64 * cb + c4, s); }
        __syncthreads();
    }
}

struct Args { const float* in[21]; float* out; unsigned char* ws; int ph_lo, ph_hi; };
static_assert(sizeof(Args) == 192, "Args layout (kin/kout/kws offsets)");
enum { I_XP = 0, I_XS, I_STATE, I_CK, I_CV, I_PP, I_PS, I_NORMG, I_WIN, I_WGU, I_BG, I_GLAG, I_QG, I_KG, I_RELB, I_WA, I_WB, I_WO, I_PLEG, I_WPG, I_WPLE };

DI void transpose_item(const float* W, int ldw, int srccol0, int nvalid, const float* gain, bf16_t* WT, int K, int rowbase, int k0, LAS float* scr, int lane) {
    f32x4 wv[8];
#pragma unroll
    for (int i = 0; i < 8; ++i) { const int idx = lane + 64 * i, kk = idx >> 3, c4 = (idx & 7) * 4;
        wv[i] = (f32x4){0.f, 0.f, 0.f, 0.f}; if (c4 < nvalid) wv[i] = __builtin_nontemporal_load((const f32x4*)(W + (size_t)(k0 + kk) * ldw + srccol0 + c4)); }
#pragma unroll
    for (int i = 0; i < 8; ++i) { const int idx = lane + 64 * i, kk = idx >> 3, c4 = (idx & 7) * 4; const float gk = gain ? gain[k0 + kk] : 1.f;
        scr[kk * 33 + c4] = wv[i].x * gk; scr[kk * 33 + c4 + 1] = wv[i].y * gk; scr[kk * 33 + c4 + 2] = wv[i].z * gk; scr[kk * 33 + c4 + 3] = wv[i].w * gk; }
    asm volatile("s_waitcnt lgkmcnt(0)" ::: "memory");
    const int c8 = lane & 7;
#pragma unroll
    for (int j = 0; j < 4; ++j) { const int n = (lane >> 3) + 8 * j; const LAS float* s = scr + (8 * c8) * 33 + n;
        u32x4 o; o.x = pk2(s[0 * 33], s[1 * 33]); o.y = pk2(s[2 * 33], s[3 * 33]); o.z = pk2(s[4 * 33], s[5 * 33]); o.w = pk2(s[6 * 33], s[7 * 33]);
        const int prow = 16 * ((n >> 2) & 1) + 4 * (n >> 3) + (n & 3);
        *(u32x4*)(WT + (size_t)(rowbase + prow) * K + k0 + 8 * c8) = o; }
    asm volatile("s_waitcnt lgkmcnt(0)" ::: "memory");
}
DI int win_src(int t, int& nvalid) {
    nvalid = 256;
    if (t < 2) return t * 256; if (t < 4) return 512 + (t - 2) * 256; if (t < 8) return 1024 + (t - 4) * 256; if (t < 12) return 2064 + (t - 8) * 256;
    if (t == 12) { nvalid = 16; return 2048; }
    if (t < 17) return 3088 + (t - 13) * 256; if (t < 21) return 4112 + (t - 17) * 256; if (t < 25) return 5136 + (t - 21) * 256; if (t < 29) return 6160 + (t - 25) * 256;
    if (t < 33) return 7184 + (t - 29) * 256; return 8208 + (t - 33) * 256;
}
DI void transpose_generic(const float* W, int ldw, int K, int ntile, bool is_win, const float* gain, bf16_t* WT, int item, LAS float* scr, int lane) {
    const int nkb = K / 64; const int kb = item % nkb, nb = (item / nkb) & 7, t = item / (nkb * 8);
    int nvalid = 256, src = t * 256; if (is_win) src = win_src(t, nvalid);
    int nv = nvalid - 32 * nb; nv = nv < 0 ? 0 : (nv > 32 ? 32 : nv);
    transpose_item(W, ldw, src + 32 * nb, nv, gain, WT, K, t * 256 + 128 * (nb & 1) + 32 * (nb >> 1), kb * 64, scr, lane);
}
constexpr int WIN_ITEMS = NWIN_T * 8 * 16, SQ_ITEMS = 4 * 8 * 16, PLE_ITEMS = 4 * 8 * 4;
constexpr int N_IN = 9232;
DI void prep_win(const Args& a, int L, int gw, int ngw, LAS float* scr, int lane) {
    bf16_t* WT = (bf16_t*)(kws() + WS_WIN);
    for (int it = gw; it < WIN_ITEMS; it += ngw) transpose_generic(kin(I_WIN) + (size_t)L * 1024 * N_IN, N_IN, 1024, NWIN_T, true, kin(I_NORMG) + L * 1024, WT, it, scr, lane);
}
DI bf16_t* wsm(const Args& a, int L, int which) { return (bf16_t*)(kws() + WS_WSM + (size_t)L * WSM_LAYER + (size_t)which * 2 * MiB); }
DI void prep_small(const Args& a, int gw, int ngw, LAS float* scr, int lane) {
    constexpr int PER_L = 4 * SQ_ITEMS + PLE_ITEMS;
    for (int it = gw; it < 2 * PER_L; it += ngw) {
        const int L = it / PER_L; int r = it % PER_L;
        if (r < SQ_ITEMS) { transpose_generic(kin(I_WA) + (size_t)L * 1048576, 1024, 1024, 4, false, nullptr, wsm(a, L, 0), r, scr, lane); continue; } r -= SQ_ITEMS;
        if (r < SQ_ITEMS) { transpose_generic(kin(I_WB) + (size_t)L * 1048576, 1024, 1024, 4, false, nullptr, wsm(a, L, 1), r, scr, lane); continue; } r -= SQ_ITEMS;
        if (r < SQ_ITEMS) { transpose_generic(kin(I_WO) + (size_t)L * 1048576, 1024, 1024, 4, false, nullptr, wsm(a, L, 2), r, scr, lane); continue; } r -= SQ_ITEMS;
        if (r < SQ_ITEMS) { transpose_generic(kin(I_WPG) + (size_t)L * 1048576, 1024, 1024, 4, false, kin(I_PLEG) + L * 1024, wsm(a, L, 3), r, scr, lane); continue; } r -= SQ_ITEMS;
        transpose_generic(kin(I_WPLE) + (size_t)L * 262144, 1024, 256, 4, false, nullptr, wsm(a, L, 4), r, scr, lane);
    }
}
DI float wave_sum(float v) {
#pragma unroll
    for (int o = 1; o < 64; o <<= 1) v += __shfl_xor(v, o);
    return v;
}
DI void prep_shift(int gw, int lane) {
    if (gw < 32) { const int L = gw >> 4, h = gw & 15;
        float mq = fabsf(kin(I_QG)[L * 64 + lane]), mk = fabsf(kin(I_KG)[L * 64 + lane]), mb = 0.f;
        for (int i = lane; i < 257; i += 64) mb = fmaxf(mb, fabsf(kin(I_RELB)[((size_t)L * 16 + h) * 257 + i]));
#pragma unroll
        for (int o = 1; o < 64; o <<= 1) { mq = fmaxf(mq, __shfl_xor(mq, o)); mk = fmaxf(mk, __shfl_xor(mk, o)); mb = fmaxf(mb, __shfl_xor(mb, o)); }
        if (lane == 0) ((float*)(kws() + WS_MSH))[gw] = (8.f * mq * mk + mb) * LOG2E; }
}
DI void prep_rows(const Args& a, int gw, int ngw, int lane) {
    bf16_t* XB = (bf16_t*)(kws() + WS_XB); float* SQ2 = (float*)(kws() + WS_SQ2);
    const float* xp = kin(I_XP); const float* xs = kin(I_XS);
    for (int row0 = gw; row0 < MT; row0 += 4 * ngw) {
        f32x4 v[4][4];
#pragma unroll
        for (int u = 0; u < 4; ++u) { const int row = row0 + u * ngw; if (row < MT) { const float* x = row < MP ? xp + (size_t)row * 1024 : xs + (size_t)(row - MP) * 1024;
#pragma unroll
            for (int j = 0; j < 4; ++j) v[u][j] = __builtin_nontemporal_load((const f32x4*)x + lane + 64 * j); } }
#pragma unroll
        for (int u = 0; u < 4; ++u) { const int row = row0 + u * ngw; if (row < MT) { float s = 0.f;
#pragma unroll
            for (int j = 0; j < 4; ++j) s += (v[u][j].x * v[u][j].x + v[u][j].y * v[u][j].y) + (v[u][j].z * v[u][j].z + v[u][j].w * v[u][j].w);
            s = wave_sum(s);
            if (lane < 16) SQ2[(size_t)row * 16 + lane] = lane == 0 ? s : 0.f;
#pragma unroll
            for (int j = 0; j < 4; ++j) { u32x2 w; w.x = pk2(v[u][j].x, v[u][j].y); w.y = pk2(v[u][j].z, v[u][j].w); ((u32x2*)(XB + (size_t)row * 1024))[lane + 64 * j] = w; } } }
    }
}
DI void prep_misc(const Args& a, int gtid, int ngt) {
    bf16_t* PB = (bf16_t*)(kws() + WS_PB);
    const float* pp = kin(I_PP); const float* ps = kin(I_PS);
    for (int i0 = gtid; i0 < 2 * MT * 32; i0 += 4 * ngt) {
        f32x4 p0[4], p1[4];
#pragma unroll
        for (int k = 0; k < 4; ++k) { const int i = i0 + k * ngt; if (i < 2 * MT * 32) { const int c8 = i & 31, row = (i >> 5) % MT, L = (i >> 5) / MT;
            const float* src = row < MP ? pp + ((size_t)L * MP + row) * 256 + c8 * 8 : ps + ((size_t)L * MS + (row - MP)) * 256 + c8 * 8; p0[k] = __builtin_nontemporal_load((const f32x4*)src); p1[k] = __builtin_nontemporal_load((const f32x4*)(src + 4)); } }
#pragma unroll
        for (int k = 0; k < 4; ++k) { const int i = i0 + k * ngt; if (i < 2 * MT * 32) { const int c8 = i & 31, row = (i >> 5) % MT, L = (i >> 5) / MT;
            u32x4 w; w.x = pk2(p0[k].x, p0[k].y); w.y = pk2(p0[k].z, p0[k].w); w.z = pk2(p1[k].x, p1[k].y); w.w = pk2(p1[k].z, p1[k].w);
            *(u32x4*)(PB + ((size_t)L * MT + row) * 256 + c8 * 8) = w; } }
    }
    constexpr int PER = 448 * 1024 / 4;
    const float* ck = kin(I_CK); const float* cv = kin(I_CV); float* out = kout();
    for (int i0 = gtid; i0 < 32 * PER; i0 += 8 * ngt) {
        f32x4 v[8];
#pragma unroll
        for (int k = 0; k < 8; ++k) { const int i = i0 + k * ngt; if (i < 32 * PER) { const int lb = i / PER, r = i % PER, kv = lb >> 4, l_b = lb & 15;
            v[k] = __builtin_nontemporal_load((const f32x4*)((kv ? cv : ck) + (size_t)l_b * 512 * 1024 + 64 * 1024) + r); } }
#pragma unroll
        for (int k = 0; k < 8; ++k) { const int i = i0 + k * ngt; if (i < 32 * PER) { const int lb = i / PER, r = i % PER, kv = lb >> 4, l_b = lb & 15;
            __builtin_nontemporal_store(v[k], (f32x4*)(out + (kv ? O_VS : O_KS) + (size_t)l_b * 512 * 1024) + r); } }
    }
}

DI void gla_prep(const Args& a, int L, int c, int h, LAS float* totp, LAS float* ra_s, float (&b)[16], float& blast) {
    const int tid = otid(), d = tid & 127, jq = __builtin_amdgcn_readfirstlane(tid >> 7);
    if (tid < 256) *(LAS f32x4*)(ra_s + tid * 4) = *(const f32x4*)((const float*)(kws() + WS_RA) + (size_t)c * 64 * 16 + tid * 4);
    const float* wg = kin(I_WGU) + (size_t)L * 16 * 512 + h * 128 + d; float w[16];
#pragma unroll
    for (int r = 0; r < 16; ++r) w[r] = wg[r * 512];
    const float bg = kin(I_BG)[L * 512 + h * 128 + d];
    __syncthreads();
    float run = 0.f;
#pragma unroll
    for (int jj = 0; jj < 16; ++jj) {
        const LAS f32x4* rp = (const LAS f32x4*)(ra_s + (16 * jq + jj) * 16); const f32x4 r0 = rp[0], r1 = rp[1], r2 = rp[2], r3 = rp[3];
        float r = bg;
        r += r0.x * w[0]; r += r0.y * w[1]; r += r0.z * w[2]; r += r0.w * w[3]; r += r1.x * w[4]; r += r1.y * w[5]; r += r1.z * w[6]; r += r1.w * w[7];
        r += r2.x * w[8]; r += r2.y * w[9]; r += r2.z * w[10]; r += r2.w * w[11]; r += r3.x * w[12]; r += r3.y * w[13]; r += r3.z * w[14]; r += r3.w * w[15];
        const float lg = (fminf(r, 0.f) - __logf(1.f + __expf(-fabsf(r)))) * (1.f / 16.f);
        run += lg; b[jj] = run;
    }
    totp[jq * 128 + d] = run;
    __syncthreads();
    const float t0 = totp[d], t1 = totp[128 + d], t2 = totp[256 + d], t3 = totp[384 + d];
    const float off = jq == 0 ? 0.f : jq == 1 ? t0 : jq == 2 ? t0 + t1 : t0 + t1 + t2;
    blast = (t0 + t1) + (t2 + t3);
#pragma unroll
    for (int jj = 0; jj < 16; ++jj) b[jj] += off;
    if (jq == 0) totp[512 + d] = blast;
}
DI bf16x8 lds16(const LAS unsigned char* p) { return *(const LAS bf16x8*)p; }
DI s16x4 lds8(const LAS unsigned char* p) { return *(const LAS s16x4*)p; }
DI void vt_load(const bf16_t* VT, u32x4 (&vr)[4]) {
    const int tid = otid();
#pragma unroll
    for (int k = 0; k < 4; ++k) vr[k] = *(const u32x4*)(VT + (size_t)(tid + 512 * k) * 8);
}
DI void vt_store(const u32x4 (&vr)[4], LAS unsigned char* vt) {
    const int tid = otid();
#pragma unroll
    for (int k = 0; k < 4; ++k) { const int i = tid + 512 * k; *(LAS u32x4*)(vt + ((i >> 3) * 72 + (i & 7) * 8) * 2) = vr[k]; }
}
constexpr int GA_KT = 0, GA_VT = 18432, GA_TOT = 55296;
DI void gla_a_phase(const Args& a, int L, LAS unsigned char* lds, int item_lo, int item_hi, int first_wg) {
    const int tid = otid(), lane = tid & 63, wave = __builtin_amdgcn_readfirstlane(tid >> 6), r = lane & 15, q = lane >> 4;
    const bf16_t* KA = (const bf16_t*)(kws() + WS_OV + 2 * SLOT) + (size_t)MT * 512; const bf16_t* VA = (const bf16_t*)(kws() + WS_OV + 1 * SLOT);
    bf16_t* ST = (bf16_t*)(kws() + WS_OV + 3 * SLOT); float* DC = (float*)(kws() + WS_DC);
    LAS float* totp = (LAS float*)(lds + GA_TOT);
    int wg0_ = (int)blockIdx.x - first_wg; if (wg0_ < 0) wg0_ += (int)gridDim.x;
    for (int item = item_lo + wg0_; item < item_hi; item += gridDim.x) {
        const int c = item >> 2, h = item & 3;
        const int d = tid & 127, jq = tid >> 7;
        bf16_t kraw[16]; u32x4 vr[4];
#pragma unroll
        for (int jj = 0; jj < 16; ++jj) kraw[jj] = KA[((size_t)c * 64 + 16 * jq + jj) * 512 + h * 128 + d];
        vt_load(VA + (size_t)(c * 4 + h) * 16384, vr);
        float b[16], blast; gla_prep(a, L, c, h, totp, (LAS float*)(lds + GA_VT), b, blast);
        { float kd[16];
#pragma unroll
          for (int jj = 0; jj < 16; ++jj) kd[jj] = bf2f(kraw[jj]) * __expf(blast - b[jj]);
          LAS u32x4* o = (LAS u32x4*)(lds + GA_KT + (d * 72 + 16 * jq) * 2); o[0] = pack8(kd); o[1] = pack8(kd + 8); }
        if (jq == 0) DC[(size_t)item * 128 + d] = __expf(blast);
        vt_store(vr, lds + GA_VT);
        __syncthreads();
        f32x4 acc[8][2];
#pragma unroll
        for (int dt = 0; dt < 8; ++dt) { acc[dt][0] = (f32x4){0.f, 0.f, 0.f, 0.f}; acc[dt][1] = (f32x4){0.f, 0.f, 0.f, 0.f}; }
#pragma unroll
        for (int s = 0; s < 2; ++s) {
            bf16x8 bv[2];
#pragma unroll
            for (int vt = 0; vt < 2; ++vt) bv[vt] = lds16(lds + GA_VT + ((32 * wave + 16 * vt + r) * 72 + 32 * s + 8 * q) * 2);
#pragma unroll
            for (int dt = 0; dt < 8; ++dt) { const bf16x8 ak = lds16(lds + GA_KT + ((16 * dt + r) * 72 + 32 * s + 8 * q) * 2);
#pragma unroll
                for (int vt = 0; vt < 2; ++vt) acc[dt][vt] = __builtin_amdgcn_mfma_f32_16x16x32_bf16(ak, bv[vt], acc[dt][vt], 0, 0, 0); }
        }
        if (c < NPC) {
#pragma unroll
            for (int vt = 0; vt < 2; ++vt)
#pragma unroll
                for (int dt = 0; dt < 8; ++dt) { u32x2 w; w.x = pk2(acc[dt][vt][0], acc[dt][vt][1]); w.y = pk2(acc[dt][vt][2], acc[dt][vt][3]);
                    *(u32x2*)(ST + (size_t)item * 32768 + (32 * wave + 16 * vt + r) * 128 + 16 * dt + 4 * q) = w; }
        } else {
            const int bb = c - NPC; const size_t so = (((size_t)L * 8 + bb) * 4 + h) * 32768;
            const float* s0 = kin(I_STATE) + so; float* s1 = kout() + O_SS + so;
#pragma unroll
            for (int dt = 0; dt < 8; ++dt)
#pragma unroll
                for (int e = 0; e < 4; ++e) { const int dd = 16 * dt + 4 * q + e; const float dc = __expf(totp[512 + dd]);
#pragma unroll
                    for (int vt = 0; vt < 2; ++vt) { const int v = 32 * wave + 16 * vt + r; s1[dd * 256 + v] = dc * s0[dd * 256 + v] + acc[dt][vt][e]; } }
        }
        __syncthreads();
    }
}
template <int NG> DI void gla_scan_gts(int L, int dry, const int (&gts)[NG], bf16_t* ST, const float* DC) {
    int e4[NG], bb[NG], h[NG], d[NG]; float run[NG][4];
#pragma unroll
    for (int g = 0; g < NG; ++g) { const int bh = gts[g] >> 13; e4[g] = gts[g] & 8191; bb[g] = bh >> 2; h[g] = bh & 3; d[g] = (4 * e4[g]) & 127; run[g][0] = run[g][1] = run[g][2] = run[g][3] = 0.f; }
    for (int n0 = 0; n0 < 64; n0 += 8) {
        u32x2 cur[NG][8]; f32x4 dc[NG][8];
#pragma unroll
        for (int g = 0; g < NG; ++g)
#pragma unroll
            for (int k = 0; k < 8; ++k) { const size_t it = (size_t)(bb[g] * 64 + n0 + k) * 4 + h[g]; cur[g][k] = *(const u32x2*)(ST + it * 32768 + 4 * e4[g]); dc[g][k] = *(const f32x4*)(DC + it * 128 + d[g]); }
#pragma unroll
        for (int g = 0; g < NG; ++g)
#pragma unroll
            for (int k = 0; k < 8; ++k) { const size_t it = (size_t)(bb[g] * 64 + n0 + k) * 4 + h[g];
                u32x2 w; w.x = pk2(run[g][0], run[g][1]); w.y = pk2(run[g][2], run[g][3]); if (!dry || run[g][0] == 1.2345e30f) *(u32x2*)(ST + it * 32768 + 4 * e4[g]) = w;
                run[g][0] = dc[g][k].x * run[g][0] + bflo(cur[g][k].x); run[g][1] = dc[g][k].y * run[g][1] + bfhi(cur[g][k].x); run[g][2] = dc[g][k].z * run[g][2] + bflo(cur[g][k].y); run[g][3] = dc[g][k].w * run[g][3] + bfhi(cur[g][k].y); }
    }
#pragma unroll
    for (int g = 0; g < NG; ++g) { float* o = kout() + O_SP + (((size_t)L * 4 + bb[g]) * 4 + h[g]) * 32768; const int v = (4 * e4[g]) >> 7;
#pragma unroll
        for (int e = 0; e < 4; ++e) if (!dry || run[g][e] == 1.2345e30f) o[(d[g] + e) * 256 + v] = run[g][e]; }
}
DI void gla_scan_phase(const Args& a, int L, int dry) {
    bf16_t* ST = (bf16_t*)(kws() + WS_OV + 3 * SLOT); const float* DC = (const float*)(kws() + WS_DC);
    const int w = (int)blockIdx.x, G = (int)gridDim.x, tid = otid();
    if (G == 256) {
        if (w >= 128) { const int gts[2] = {(w - 128) * NTHREADS + tid, 65536 + (w - 128) * NTHREADS + tid}; gla_scan_gts<2>(L, dry, gts, ST, DC); }
    } else {
        for (int gt = w * NTHREADS + tid; gt < 16 * 8192; gt += G * NTHREADS) { const int gts[1] = {gt}; gla_scan_gts<1>(L, dry, gts, ST, DC); }
    }
}
constexpr int GC_QS = 0, GC_KS = 17408, GC_VT = 34816, GC_SS = 71680, GC_TOT = 141312, GC_RED = 143872;
DI void gla_c_phase(const Args& a, int L, LAS unsigned char* lds, int dry, int item_lo, int item_hi, int first_wg) {
    const int tid = otid(), lane = tid & 63, wave = __builtin_amdgcn_readfirstlane(tid >> 6), r = lane & 15, q = lane >> 4, it = wave & 3, vh = wave >> 2;
    const bf16_t* QA = (const bf16_t*)(kws() + WS_OV + 2 * SLOT); const bf16_t* KA = QA + (size_t)MT * 512; const bf16_t* VA = (const bf16_t*)(kws() + WS_OV + 1 * SLOT);
    bf16_t* SGA = (bf16_t*)(kws() + WS_OV); const bf16_t* ST = (const bf16_t*)(kws() + WS_OV + 3 * SLOT);
    LAS float* totp = (LAS float*)(lds + GC_TOT); LAS float* red = (LAS float*)(lds + GC_RED);
    const float* gg = kin(I_GLAG) + L * 256;
    int wg0_ = (int)blockIdx.x - first_wg; if (wg0_ < 0) wg0_ += (int)gridDim.x;
    for (int item = item_lo + wg0_; item < item_hi; item += gridDim.x) {
        const int c = item >> 2, h = item & 3;
        const int d = tid & 127, jq = tid >> 7;
        bf16_t qraw[16], kraw[16]; u32x4 vr[4], sr[8];
#pragma unroll
        for (int jj = 0; jj < 16; ++jj) { const size_t g = ((size_t)c * 64 + 16 * jq + jj) * 512 + h * 128 + d; qraw[jj] = QA[g]; kraw[jj] = KA[g]; }
        vt_load(VA + (size_t)(c * 4 + h) * 16384, vr);
        if (c < NPC) { const bf16_t* s = ST + (size_t)item * 32768;
#pragma unroll
            for (int k = 0; k < 8; ++k) sr[k] = *(const u32x4*)(s + (size_t)(tid + 512 * k) * 8); }
        float b[16], blast; gla_prep(a, L, c, h, totp, (LAS float*)(lds + GC_SS), b, blast);
#pragma unroll
        for (int jj = 0; jj < 16; ++jj) { const int j = 16 * jq + jj; const float eb = __expf(b[jj]);
            ((LAS bf16_t*)(lds + GC_QS))[j * 136 + d] = (bf16_t)pk2(bf2f(qraw[jj]) * eb, 0.f);
            ((LAS bf16_t*)(lds + GC_KS))[j * 136 + d] = (bf16_t)pk2(bf2f(kraw[jj]) * __builtin_amdgcn_rcpf(eb), 0.f); }
        vt_store(vr, lds + GC_VT);
        if (c < NPC) {
#pragma unroll
            for (int k = 0; k < 8; ++k) { const int i = tid + 512 * k, v = i >> 4, c8 = i & 15; *(LAS u32x4*)(lds + GC_SS + (v * 136 + c8 * 8) * 2) = sr[k]; }
        } else {
            const float* s0 = kin(I_STATE) + ((((size_t)L * 8 + (c - NPC)) * 4 + h) * 32768);
            for (int i = tid; i < 8192; i += NTHREADS) { const int dd = i & 127, v4 = i >> 7; const f32x4 s = *(const f32x4*)(s0 + dd * 256 + v4 * 4); LAS bf16_t* o = (LAS bf16_t*)(lds + GC_SS) + (v4 * 4) * 136 + dd;
                o[0] = (bf16_t)pk2(s.x, 0.f); o[136] = (bf16_t)pk2(s.y, 0.f); o[272] = (bf16_t)pk2(s.z, 0.f); o[408] = (bf16_t)pk2(s.w, 0.f); }
        }
        __syncthreads();
        bf16_t* orow = SGA + ((size_t)c * 64 + 16 * it + r) * 1024 + h * 256;
        u32x2 gate[8];
#pragma unroll
        for (int vt = 0; vt < 8; ++vt) gate[vt] = *(const u32x2*)(orow + 128 * vh + 16 * vt + 4 * q);
        bf16x8 bq[4];
#pragma unroll
        for (int ks = 0; ks < 4; ++ks) bq[ks] = lds16(lds + GC_QS + ((16 * it + r) * 136 + 32 * ks + 8 * q) * 2);
        f32x4 at[4];
#pragma unroll
        for (int jt = 0; jt < 4; ++jt) { at[jt] = (f32x4){0.f, 0.f, 0.f, 0.f};
            if (jt <= it) {
#pragma unroll
                for (int ks = 0; ks < 4; ++ks) at[jt] = __builtin_amdgcn_mfma_f32_16x16x32_bf16(lds16(lds + GC_KS + ((16 * jt + r) * 136 + 32 * ks + 8 * q) * 2), bq[ks], at[jt], 0, 0, 0);
                if (jt == it) {
#pragma unroll
                    for (int e = 0; e < 4; ++e) if (4 * q + e > r) at[jt][e] = 0.f;
                } } }
        bf16x8 bp[2];
#pragma unroll
        for (int s = 0; s < 2; ++s) { u32x4 w; w.x = pk2(at[2 * s][0], at[2 * s][1]); w.y = pk2(at[2 * s][2], at[2 * s][3]); w.z = pk2(at[2 * s + 1][0], at[2 * s + 1][1]); w.w = pk2(at[2 * s + 1][2], at[2 * s + 1][3]); bp[s] = __builtin_bit_cast(bf16x8, w); }
        f32x4 o[8];
#pragma unroll
        for (int vt = 0; vt < 8; ++vt) { o[vt] = (f32x4){0.f, 0.f, 0.f, 0.f}; const int v = 128 * vh + 16 * vt + r;
#pragma unroll
            for (int s = 0; s < 2; ++s) if (2 * s <= it) { const s16x4 lo = lds8(lds + GC_VT + (v * 72 + 32 * s + 4 * q) * 2), hi = lds8(lds + GC_VT + (v * 72 + 32 * s + 16 + 4 * q) * 2);
                const bf16x8 av = __builtin_shufflevector(lo, hi, 0, 1, 2, 3, 4, 5, 6, 7); o[vt] = __builtin_amdgcn_mfma_f32_16x16x32_bf16(av, bp[s], o[vt], 0, 0, 0); }
#pragma unroll
            for (int ks = 0; ks < 4; ++ks) o[vt] = __builtin_amdgcn_mfma_f32_16x16x32_bf16(lds16(lds + GC_SS + (v * 136 + 32 * ks + 8 * q) * 2), bq[ks], o[vt], 0, 0, 0); }
        float ss = 0.f;
#pragma unroll
        for (int vt = 0; vt < 8; ++vt) ss += (o[vt][0] * o[vt][0] + o[vt][1] * o[vt][1]) + (o[vt][2] * o[vt][2] + o[vt][3] * o[vt][3]);
        ss += __shfl_xor(ss, 16); ss += __shfl_xor(ss, 32);
        if (q == 0) red[vh * 64 + 16 * it + r] = ss;
        __syncthreads();
        const float rstd = rsqrtf((red[16 * it + r] + red[64 + 16 * it + r]) * (1.f / 256.f) + EPS);
#pragma unroll
        for (int vt = 0; vt < 8; ++vt) { const int v = 128 * vh + 16 * vt + 4 * q; const u32x2 g = gate[vt]; const f32x4 gn = *(const f32x4*)(gg + v);
            u32x2 w; w.x = pk2(o[vt][0] * rstd * gn.x * bflo(g.x), o[vt][1] * rstd * gn.y * bfhi(g.x)); w.y = pk2(o[vt][2] * rstd * gn.z * bflo(g.y), o[vt][3] * rstd * gn.w * bfhi(g.y));
            if (!dry || rstd == 1.2345e30f) *(u32x2*)(orow + v) = w; }
        __syncthreads();
    }
}

constexpr int AT_KS = 0, AT_VT = 36864, AT_BIAS = 73728, AT_BUF = 18432;
template <bool SAMPLE> DI void attn_load_k(int L, const bf16_t* KB, const float* ck, int bb, int n, int t, int hh, int sj, int sdq, u32x4& w0, u32x4& w1) {
    if (SAMPLE && t < 8) { const float* s = ck + (((size_t)L * 8 + bb) * 512 + t * 64 + sj) * 1024 + hh * 64 + 16 * sdq;
        const f32x4 f0 = *(const f32x4*)s, f1 = *(const f32x4*)(s + 4), f2 = *(const f32x4*)(s + 8), f3 = *(const f32x4*)(s + 12);
        w0.x = pk2(f0.x, f0.y); w0.y = pk2(f0.z, f0.w); w0.z = pk2(f1.x, f1.y); w0.w = pk2(f1.z, f1.w); w1.x = pk2(f2.x, f2.y); w1.y = pk2(f2.z, f2.w); w1.z = pk2(f3.x, f3.y); w1.w = pk2(f3.z, f3.w);
    } else { const size_t krow = SAMPLE ? (size_t)bb * 64 + sj : (size_t)bb * 4096 + (n - 8 + t) * 64 + sj; const bf16_t* s = KB + krow * 1024 + hh * 64 + 16 * sdq; w0 = *(const u32x4*)s; w1 = *(const u32x4*)(s + 8); }
}
template <bool SAMPLE> DI void attn_load_v(int L, const bf16_t* VBT, const float* cv, int bb, int n, int t, int hh, int tid, u32x4& w0, u32x4& w1) {
    if (SAMPLE && t < 8) { const int sj2 = tid & 63, dq2 = (tid >> 6) & 3; const float* s = cv + (((size_t)L * 8 + bb) * 512 + t * 64 + sj2) * 1024 + hh * 64 + 16 * dq2;
        const f32x4 f0 = *(const f32x4*)s, f1 = *(const f32x4*)(s + 4), f2 = *(const f32x4*)(s + 8), f3 = *(const f32x4*)(s + 12);
        w0.x = pk2(f0.x, f0.y); w0.y = pk2(f0.z, f0.w); w0.z = pk2(f1.x, f1.y); w0.w = pk2(f1.z, f1.w); w1.x = pk2(f2.x, f2.y); w1.y = pk2(f2.z, f2.w); w1.z = pk2(f3.x, f3.y); w1.w = pk2(f3.z, f3.w);
    } else { const int cc = SAMPLE ? bb : bb * 64 + (n - 8 + t); const bf16_t* s = VBT + ((size_t)cc * 16 + hh) * 4096 + (size_t)(tid & 255) * 8; w0 = *(const u32x4*)s; w1 = *(const u32x4*)(s + 2048); }
}
template <bool SAMPLE> DI void attn_item(const Args& a, int L, LAS unsigned char* lds, int dry, int item, bool stage_bias) {
    const int tid = otid(), lane = tid & 63, wave = __builtin_amdgcn_readfirstlane(tid >> 6), r = lane & 15, q = lane >> 4, g = wave >> 2, it = wave & 3;
    const bf16_t* QB = (const bf16_t*)(kws() + (SAMPLE ? WS_AX : WS_OV + 1 * SLOT)); const bf16_t* KB = (const bf16_t*)(kws() + (SAMPLE ? WS_AX + 1 * MiB : WS_OV + 2 * SLOT));
    const bf16_t* VB = (const bf16_t*)(kws() + (SAMPLE ? WS_AX + 2 * MiB : WS_OV + 3 * SLOT)); const bf16_t* GBs = (const bf16_t*)(kws() + (SAMPLE ? WS_AX + 3 * MiB : WS_OV + 4 * SLOT));
    bf16_t* SGB = (bf16_t*)(kws() + WS_OV + 4 * SLOT);
    const float* ck = kin(I_CK); const float* cv = kin(I_CV);
    LAS float* bias_s = (LAS float*)(lds + AT_BIAS);
    const int sg = tid >> 8, sj = (tid >> 2) & 63, sdq = tid & 3;
    const int c = item >> 3, hp = item & 7, h = 2 * hp + g;
    const int bb = SAMPLE ? c - NPC : c >> 6, n = SAMPLE ? 8 : c & 63, t0 = n >= 8 ? 0 : 8 - n;
    if (stage_bias) { const float* msh = (const float*)(kws() + WS_MSH) + L * 16 + 2 * hp;
    for (int i = tid; i < 2 * 257; i += NTHREADS) { const int g2 = i / 257, idx = i % 257; bias_s[g2 * 260 + idx] = kin(I_RELB)[((size_t)L * 16 + 2 * hp + g2) * 257 + idx] * LOG2E - msh[g2]; } }
    const size_t qrow = (size_t)c * 64 + 16 * it + r, qrl = SAMPLE ? qrow - MP : qrow;
    bf16x8 qf[2];
#pragma unroll
    for (int ks = 0; ks < 2; ++ks) qf[ks] = *(const bf16x8*)(QB + qrl * 1024 + h * 64 + 32 * ks + 8 * q);
    const int qi = 16 * it + r;
    bf16_t* orow = SGB + qrow * 1024 + h * 64;
    float l_run = 0.f;
    f32x4 o[4];
#pragma unroll
    for (int dt = 0; dt < 4; ++dt) o[dt] = (f32x4){0.f, 0.f, 0.f, 0.f};
    u32x4 k0, k1, v0, v1;
#define ATT_LOADT(T_) do { attn_load_k<SAMPLE>(L, KB, ck, bb, n, (T_), 2 * hp + sg, sj, sdq, k0, k1); attn_load_v<SAMPLE>(L, VB, cv, bb, n, (T_), 2 * hp + sg, tid, v0, v1); } while (0)
#define ATT_WRITE(T_, BUF_) do { const int bo_ = (BUF_) * AT_BUF; \
        LAS u32x4* ok = (LAS u32x4*)(lds + AT_KS + bo_ + ((sg * 64 + sj) * 72 + 16 * sdq) * 2); ok[0] = k0; ok[1] = k1; \
        if (SAMPLE && (T_) < 8) { const int sj2 = tid & 63, dq2 = (tid >> 6) & 3; LAS bf16_t* ov = (LAS bf16_t*)(lds + AT_VT + bo_) + (sg * 64 + 16 * dq2) * 72 + sj2; \
            ov[0] = (bf16_t)v0.x; ov[72] = (bf16_t)(v0.x >> 16); ov[144] = (bf16_t)v0.y; ov[216] = (bf16_t)(v0.y >> 16); ov[288] = (bf16_t)v0.z; ov[360] = (bf16_t)(v0.z >> 16); ov[432] = (bf16_t)v0.w; ov[504] = (bf16_t)(v0.w >> 16); \
            ov[576] = (bf16_t)v1.x; ov[648] = (bf16_t)(v1.x >> 16); ov[720] = (bf16_t)v1.y; ov[792] = (bf16_t)(v1.y >> 16); ov[864] = (bf16_t)v1.z; ov[936] = (bf16_t)(v1.z >> 16); ov[1008] = (bf16_t)v1.w; ov[1080] = (bf16_t)(v1.w >> 16); \
        } else { const int p0 = tid & 255, p1 = p0 + 256; \
            *(LAS u32x4*)(lds + AT_VT + bo_ + ((sg * 64 + (p0 >> 3)) * 72 + (p0 & 7) * 8) * 2) = v0; *(LAS u32x4*)(lds + AT_VT + bo_ + ((sg * 64 + (p1 >> 3)) * 72 + (p1 & 7) * 8) * 2) = v1; } } while (0)
    ATT_LOADT(t0);
    ATT_WRITE(t0, 0);
    if (t0 + 1 < 9) ATT_LOADT(t0 + 1);
    __syncthreads();
#pragma unroll 1
    for (int t = t0; t < 9; ++t) {
        const int cb = (t - t0) & 1;
        if (t + 1 < 9) { ATT_WRITE(t + 1, cb ^ 1); if (t + 2 < 9) ATT_LOADT(t + 2); }
        const LAS unsigned char* kb_ = lds + AT_KS + cb * AT_BUF; const LAS unsigned char* vb_ = lds + AT_VT + cb * AT_BUF;
        f32x4 sc[4];
#pragma unroll
        for (int jt = 0; jt < 4; ++jt) { f32x4 acc = (f32x4){0.f, 0.f, 0.f, 0.f};
#pragma unroll
            for (int ks = 0; ks < 2; ++ks) acc = __builtin_amdgcn_mfma_f32_16x16x32_bf16(lds16(kb_ + ((g * 64 + 16 * jt + r) * 72 + 32 * ks + 8 * q) * 2), qf[ks], acc, 0, 0, 0);
            sc[jt] = acc; }
        if (t >= 6) {
#pragma unroll
            for (int jt = 0; jt < 4; ++jt)
#pragma unroll
                for (int e = 0; e < 4; ++e) { int rel = 512 + qi - (64 * t + 16 * jt + 4 * q + e); rel = rel > 128 ? 128 : rel; rel = rel < -128 ? -128 : rel; sc[jt][e] += bias_s[g * 260 + rel + 128]; }
        } else { const float bfar = bias_s[g * 260 + 256];
#pragma unroll
            for (int jt = 0; jt < 4; ++jt) sc[jt] = sc[jt] + bfar;
        }
        float ps = 0.f;
#pragma unroll
        for (int jt = 0; jt < 4; ++jt)
#pragma unroll
            for (int e = 0; e < 4; ++e) { const float p = __builtin_amdgcn_exp2f(sc[jt][e]); sc[jt][e] = p; ps += p; }
        l_run += ps;
#pragma unroll
        for (int s = 0; s < 2; ++s) {
            u32x4 w; w.x = pk2(sc[2 * s][0], sc[2 * s][1]); w.y = pk2(sc[2 * s][2], sc[2 * s][3]); w.z = pk2(sc[2 * s + 1][0], sc[2 * s + 1][1]); w.w = pk2(sc[2 * s + 1][2], sc[2 * s + 1][3]);
            const bf16x8 bp = __builtin_bit_cast(bf16x8, w);
#pragma unroll
            for (int dt = 0; dt < 4; ++dt) { const LAS unsigned char* vp = vb_ + ((g * 64 + 16 * dt + r) * 72 + 32 * s + 4 * q) * 2;
                const s16x4 lo = lds8(vp), hi = lds8(vp + 32); const bf16x8 av = __builtin_shufflevector(lo, hi, 0, 1, 2, 3, 4, 5, 6, 7);
                o[dt] = __builtin_amdgcn_mfma_f32_16x16x32_bf16(av, bp, o[dt], 0, 0, 0); }
        }
        __syncthreads();
    }
#undef ATT_LOADT
#undef ATT_WRITE
    l_run += __shfl_xor(l_run, 16); l_run += __shfl_xor(l_run, 32);
    const float inv = __builtin_amdgcn_rcpf(l_run);
#pragma unroll
    for (int dt = 0; dt < 4; ++dt) { const int dd = 16 * dt + 4 * q; const u32x2 gv = *(const u32x2*)(GBs + qrl * 1024 + h * 64 + dd);
        u32x2 w; w.x = pk2(o[dt][0] * inv * bflo(gv.x), o[dt][1] * inv * bfhi(gv.x)); w.y = pk2(o[dt][2] * inv * bflo(gv.y), o[dt][3] * inv * bfhi(gv.y));
        if (!dry || inv == 1.2345e30f) *(u32x2*)(orow + dd) = w; }
}
DI void attn_phase(const Args& a, int L, LAS unsigned char* lds, int dry, int item_lo, int item_hi, int first_wg) {
    int wg0_ = (int)blockIdx.x - first_wg; if (wg0_ < 0) wg0_ += (int)gridDim.x;
    int prev_hp = -1;
    for (int item = item_lo + wg0_; item < item_hi; item += gridDim.x) { const bool sb = (item & 7) != prev_hp; prev_hp = item & 7;
        if ((item >> 3) >= NPC) attn_item<true>(a, L, lds, dry, item, sb); else attn_item<false>(a, L, lds, dry, item, sb); }
}

#define XB_TMO      128
#define XB_XCNT(j)  (256  + 64 * (j))
#define XB_XSUB(j)  (1280 + 64 * (j))
#define XB_XGEN(j)  (2304 + 64 * (j))
#define XB_TOP      3328
#define XB_TOPGEN   3392
#define XCD_BAR_WORDS 3456
#define XB_SPIN_CAP (1u << 18)

__device__ __forceinline__ unsigned xb_ld(unsigned* p)              { return __hip_atomic_load(p, __ATOMIC_RELAXED, __HIP_MEMORY_SCOPE_AGENT); }
__device__ __forceinline__ unsigned xb_add(unsigned* p, unsigned v) { return __hip_atomic_fetch_add(p, v, __ATOMIC_RELAXED, __HIP_MEMORY_SCOPE_AGENT); }
__device__ __forceinline__ unsigned xb_xcc_id() { return (unsigned)__builtin_amdgcn_s_getreg((3 << 11) | 20) & 0xFu; }
#define XB_SPIN(cond, bar) do { unsigned _sp = 0; while (cond) { __builtin_amdgcn_s_sleep(1); \
    if ((++_sp & 255u) == 0u) { if (xb_ld(&(bar)[XB_TMO])) break; if (_sp > XB_SPIN_CAP) { atomicAdd(&(bar)[XB_TMO], 1u); break; } } } } while (0)

struct XcdBarrier {
    unsigned* bar; unsigned x;
    volatile LAS unsigned* st;
};

__device__ __forceinline__ XcdBarrier xcd_barrier_post(unsigned* bar, volatile LAS unsigned* st) {
    XcdBarrier b; b.bar = bar; b.x = xb_xcc_id(); b.st = st;
    if (threadIdx.x == 0) (void)xb_add(&bar[XB_XCNT(b.x)], 1u);
    return b;
}
__device__ __forceinline__ void xcd_barrier_complete(unsigned* bar, unsigned x, unsigned& nloc, unsigned& nx) {
    const unsigned G = gridDim.x * gridDim.y * gridDim.z;
    unsigned sum, cnt, mine, sp = 0u;
    for (;;) {
        sum = 0u; cnt = 0u; mine = 0u;
#pragma unroll
        for (unsigned j = 0; j < 16; ++j) { const unsigned c = xb_ld(&bar[XB_XCNT(j)]); sum += c; cnt += (c > 0u) ? 1u : 0u; mine = (j == x) ? c : mine; }
        if (sum == G) break;
        __builtin_amdgcn_s_sleep(1);
        if ((++sp & 255u) == 0u) { if (xb_ld(&bar[XB_TMO])) break; if (sp > XB_SPIN_CAP) { atomicAdd(&bar[XB_TMO], 1u); break; } }
    }
    nloc = mine > 0u ? mine : 1u; nx = cnt > 0u ? cnt : 1u;
}

__device__ __forceinline__ void xcd_barrier(const XcdBarrier& b) {
    asm volatile("s_waitcnt vmcnt(0)" ::: "memory");
    __syncthreads();
    if (threadIdx.x == 0) {
        unsigned* bar = b.bar;
        __builtin_amdgcn_s_waitcnt(0);
        unsigned nloc = b.st[0], nx = b.st[1];
        if (nloc == 0u) { xcd_barrier_complete(bar, b.x, nloc, nx); b.st[0] = nloc; b.st[1] = nx; }
        const unsigned old = xb_add(&bar[XB_XSUB(b.x)], 1u);
        const unsigned gen = old / nloc;
        if (old + 1u == (gen + 1u) * nloc) {
            __builtin_amdgcn_fence(__ATOMIC_RELEASE, "agent");
            asm volatile("s_waitcnt vmcnt(0)" ::: "memory");
            const unsigned og = xb_add(&bar[XB_TOP], 1u);
            const unsigned tg = og / nx;
            if (og + 1u == (tg + 1u) * nx) xb_add(&bar[XB_TOPGEN], 1u);
            else XB_SPIN(xb_ld(&bar[XB_TOPGEN]) == tg, bar);
            __builtin_amdgcn_fence(__ATOMIC_ACQUIRE, "agent");
            xb_add(&bar[XB_XGEN(b.x)], 1u);
            asm volatile("s_waitcnt vmcnt(0)" ::: "memory");
        } else {
            XB_SPIN(xb_ld(&bar[XB_XGEN(b.x)]) == gen, bar);
            __builtin_amdgcn_fence(__ATOMIC_ACQUIRE, "agent");
            asm volatile("s_waitcnt vmcnt(0)" ::: "memory");
        }
    }
    __syncthreads();
}

#ifndef PROBE_REP
#define PROBE_REP 0
#endif
#ifndef EN_CH
#define EN_CH 31
#endif
#ifndef EN_PREP
#define EN_PREP 1
#endif
#ifndef EN_GIN
#define EN_GIN 1
#endif
#ifndef EN_GLAA
#define EN_GLAA 1
#endif
#ifndef EN_SCAN
#define EN_SCAN 1
#endif
#ifndef EN_GLAC
#define EN_GLAC 1
#endif
#ifndef EN_ATTN
#define EN_ATTN 1
#endif
#ifndef EN_CHAIN
#define EN_CHAIN 1
#endif
constexpr int PH_PER_LAYER = 10, N_PHASES = 1 + 2 * PH_PER_LAYER;
constexpr int MISC_OFF = LDS_BYTES - 64;
#define REPS(k) (((PROBE_REP >> (k)) & 1) ? 2 : 1)
__global__ void __launch_bounds__(NTHREADS, 2) fwd_kernel(Args a) {
    extern __shared__ __attribute__((aligned(16))) unsigned char lds_raw[];
    LAS unsigned char* lds = (LAS unsigned char*)lds_raw;
    const int tid = otid(), lane = tid & 63, wave = __builtin_amdgcn_readfirstlane(tid >> 6);
    const int gw = blockIdx.x * 8 + wave, ngw = gridDim.x * 8, gtid = blockIdx.x * NTHREADS + tid, ngt = gridDim.x * NTHREADS;
    LAS float* scr = (LAS float*)(lds + wave * 16384);
    const int lo = kph_lo(), hi = kph_hi();
    volatile LAS unsigned* MISC = (volatile LAS unsigned*)(lds + MISC_OFF);
    if (tid < 16) MISC[tid] = 0u;
    __syncthreads();
    XcdBarrier bar; bar.bar = (unsigned*)kws(); bar.x = 0; bar.st = nullptr;
    if (hi - lo > 1) bar = xcd_barrier_post((unsigned*)kws(), MISC);
#define IN_PH(k) (lo <= (k) && (k) < hi)
#define SEAM(k) do { if (IN_PH(k) && IN_PH((k) + 1)) { XcdBarrier b2_ = bar; asm volatile("" : "+s"(b2_.bar));     \
        xcd_barrier(b2_); if ((PROBE_REP >> 11) & 1) xcd_barrier(b2_); } } while (0)
    if (lo < 0) { __threadfence(); cg::this_grid().sync(); }
    if (EN_PREP && IN_PH(0)) for (int rep = 0; rep < REPS(10); ++rep) { prep_small(a, gw, ngw, scr, lane); prep_win(a, 0, gw, ngw, scr, lane); prep_rows(a, gw, ngw, lane); prep_shift(gw, lane); prep_misc(a, gtid, ngt); __syncthreads(); }
    SEAM(0);
    for (int L = 0; L < 2; ++L) {
        const int pb = 1 + L * PH_PER_LAYER;
        unsigned char* ws = kws();
        bf16_t* XB = (bf16_t*)(ws + WS_XB); float* SQ1 = (float*)(ws + WS_SQ1); float* SQ2 = (float*)(ws + WS_SQ2);
        bf16_t* S0 = (bf16_t*)(ws + WS_OV); bf16_t* S1 = (bf16_t*)(ws + WS_OV + SLOT); bf16_t* S2 = (bf16_t*)(ws + WS_OV + 2 * SLOT); bf16_t* S3 = (bf16_t*)(ws + WS_OV + 3 * SLOT); bf16_t* S4 = (bf16_t*)(ws + WS_OV + 4 * SLOT);
        const bf16_t* WIN = (const bf16_t*)(ws + WS_WIN);
        EpiIn ein; ein.L = L; ein.ws = ws; ein.out = kout(); ein.qg = kin(I_QG) + L * 64; ein.kg = kin(I_KG) + L * 64;
        if (EN_GIN && IN_PH(pb + 0)) for (int rep = 0; rep < REPS(0); ++rep) { ein.tile0 = 0; run_gemm_g(lds, XB, WIN, ein); }
        SEAM(pb + 0);
        if (EN_GLAA && IN_PH(pb + 1)) for (int rep = 0; rep < REPS(1); ++rep) gla_a_phase(a, L, lds, 0, NPC * 4, 0);
        SEAM(pb + 1);
        if (EN_SCAN && IN_PH(pb + 2)) for (int rep = 0; rep < REPS(2); ++rep) {
            gla_a_phase(a, L, lds, NPC * 4, NCH * 4, 0); gla_c_phase(a, L, lds, rep + 1 < REPS(2), NPC * 4, NCH * 4, 32);
            attn_phase(a, L, lds, rep + 1 < REPS(2), NPC * 8, NCH * 8, 64);
            gla_scan_phase(a, L, rep + 1 < REPS(2)); }
        SEAM(pb + 2);
        if (EN_GLAC && IN_PH(pb + 3)) for (int rep = 0; rep < REPS(3); ++rep) gla_c_phase(a, L, lds, rep + 1 < REPS(3), 0, NPC * 4, 0);
        SEAM(pb + 3);
        if (EN_GIN && IN_PH(pb + 4)) for (int rep = 0; rep < REPS(4); ++rep) { ein.tile0 = 13; run_gemm(lds, XB, WIN + (size_t)13 * 256 * 1024, MP, 16 * 256, 1024, ein); }
        SEAM(pb + 4);
        if (EN_ATTN && IN_PH(pb + 5)) for (int rep = 0; rep < REPS(5); ++rep) attn_phase(a, L, lds, rep + 1 < REPS(5), 0, NPC * 8, 0);
        SEAM(pb + 5);
        if (EN_GIN && IN_PH(pb + 6)) for (int rep = 0; rep < REPS(6); ++rep) { ein.tile0 = 29; run_gemm_m(lds, XB, WIN + (size_t)29 * 256 * 1024, ein); }
        if (!(IN_PH(pb + 6) && IN_PH(pb + 7))) SEAM(pb + 6);
        if (EN_CHAIN && IN_PH(pb + 7)) for (int rep = 0; rep < REPS(7); ++rep) { const int dry = rep + 1 < REPS(7);
            if (EN_CH & 1) { bf16_t* AXA = (bf16_t*)(ws + WS_AX + 4 * MiB); EpiYA ea{S1, dry, AXA}; run_gemm(lds, S0, wsm(a, L, 0), MP, 1024, 1024, ea); mini_gemm<1024>(lds, S0 + (size_t)MP * 1024, wsm(a, L, 0), ea); }
            if (EN_CH & 2) { bf16_t* AXA = (bf16_t*)(ws + WS_AX + 4 * MiB); bf16_t* AXB = (bf16_t*)(ws + WS_AX + 5 * MiB); EpiYB eb{S1, S2, dry, AXA, AXB}; run_gemm(lds, S4, wsm(a, L, 1), MP, 1024, 1024, eb); mini_gemm<1024>(lds, S4 + (size_t)MP * 1024, wsm(a, L, 1), eb); }
        }
        SEAM(pb + 7);
        if (EN_CHAIN && IN_PH(pb + 8)) {
            if (L == 0) { prep_win(a, 1, gw, ngw, scr, lane); __syncthreads(); }
            for (int rep = 0; rep < REPS(8); ++rep) {
            EpiOut eo; eo.xp = L == 0 ? kin(I_XP) : kout(); eo.xs = L == 0 ? kin(I_XS) : kout() + (size_t)MP * 1024; eo.out = kout(); eo.xb = S3; eo.sq = SQ1; eo.dry = rep + 1 < REPS(8);
            if (EN_CH & 4) { run_gemm(lds, S2, wsm(a, L, 2), MP, 1024, 1024, eo); mini_gemm<1024>(lds, (const bf16_t*)(ws + WS_AX + 5 * MiB), wsm(a, L, 2), eo); } }
        }
        SEAM(pb + 8);
        if (EN_CHAIN && IN_PH(pb + 9)) for (int rep = 0; rep < REPS(9); ++rep) { const int dry = rep + 1 < REPS(9);
            if (EN_CH & 8) { EpiP ep{(float*)S0, dry}; run_gemm(lds, (const bf16_t*)(ws + WS_PB) + (size_t)L * MT * 256, wsm(a, L, 4), MP, 1024, 256, ep); mini_gemm<256>(lds, (const bf16_t*)(ws + WS_PB) + ((size_t)L * MT + MP) * 256, wsm(a, L, 4), ep); }
            EpiGate eg; eg.sq1 = SQ1; eg.PT = (const float*)S0; eg.out = kout(); eg.xb = XB; eg.sq2 = SQ2; eg.dry = dry;
            if (EN_CH & 16) { run_gemm(lds, S3, wsm(a, L, 3), MP, 1024, 1024, eg); mini_gemm<1024>(lds, S3 + (size_t)MP * 1024, wsm(a, L, 3), eg); }
        }
        SEAM(pb + 9);
    }
}

#ifndef MK_ONE_LAUNCH
#define MK_ONE_LAUNCH 1
#endif
extern "C" void kernel_launch(void* const* d_in, const int* in_sizes, int n_in, void* d_out, int out_size, void* d_ws, size_t ws_size, hipStream_t stream) {
    static int grid = 0;
    if (grid == 0) {
        if (n_in != 21 || ws_size < WS_END) { fprintf(stderr, "kernel_launch: unexpected n_in %d or ws_size %zu (< %zu)\n", n_in, ws_size, (size_t)WS_END); grid = -1; return; }
        int dev = 0, cus = 0, per_cu = 0;
        (void)hipGetDevice(&dev); (void)hipDeviceGetAttribute(&cus, hipDeviceAttributeMultiprocessorCount, dev);
        (void)hipFuncSetAttribute((const void*)fwd_kernel, hipFuncAttributeMaxDynamicSharedMemorySize, LDS_BYTES);
        (void)hipOccupancyMaxActiveBlocksPerMultiprocessor(&per_cu, (const void*)fwd_kernel, NTHREADS, LDS_BYTES);
        (void)hipGetLastError();
        if (per_cu < 1) { fprintf(stderr, "kernel_launch: occupancy query says %d blocks/CU\n", per_cu); per_cu = 1; }
        grid = cus;
    }
    if (grid < 0) return;
    Args a{};
    for (int i = 0; i < 21; ++i) a.in[i] = (const float*)d_in[i];
    a.out = (float*)d_out; a.ws = (unsigned char*)d_ws;
#if MK_ONE_LAUNCH
    (void)hipMemsetAsync(d_ws, 0, 16384, stream);
    a.ph_lo = 0; a.ph_hi = N_PHASES;
    void* args[] = {&a};
    hipError_t e = hipLaunchCooperativeKernel((const void*)fwd_kernel, dim3(grid), dim3(NTHREADS), args, LDS_BYTES, stream);
    if (e != hipSuccess) fprintf(stderr, "cooperative launch failed: %s (grid %d)\n", hipGetErrorString(e), grid);
#else
    for (int p = 0; p < N_PHASES; ++p) { a.ph_lo = p; a.ph_hi = p + 1; hipLaunchKernelGGL(fwd_kernel, dim3(grid), dim3(NTHREADS), LDS_BYTES, stream, a); }
#endif
}
```
